# Optimizing an MI355X kernel written in HIP

```python
import numpy as np
import jax
import jax.numpy as jnp
from jax import lax

D_MODEL = 1024
BATCH = 8
SEQ = 4096
DEPTH = 2

SWA_Q_HEADS = 8
SWA_KV_HEADS = 2
SWA_HEAD_DIM = 64
WINDOW = 128
ROT_DIM = SWA_HEAD_DIM // 4
ROPE_THETA = 500000.0

GDN_HEADS = 4
GDN_HEAD_DIM = 128
CONV_K = 4
GDN_CHUNK = 64

RET_HEADS = 4
RET_QK_DIM = 256
RET_V_DIM = 512
RET_CHUNK = 128
XPOS_THETA = 10000.0

N_GROUPS = 4
EXPERTS_PER_GROUP = 8
N_EXPERTS = N_GROUPS * EXPERTS_PER_GROUP
TOP_K = 2
D_EXPERT = 512
MOE_BLOCK = 128

EPS = 1e-6

SWA_Q_W = SWA_Q_HEADS * SWA_HEAD_DIM
SWA_KV_W = SWA_KV_HEADS * SWA_HEAD_DIM
GDN_W = GDN_HEADS * GDN_HEAD_DIM
EVEN_SPLITS = (SWA_Q_W, SWA_KV_W, SWA_KV_W, 3 * GDN_W, GDN_W, GDN_HEADS, GDN_HEADS)
EVEN_IN = SWA_Q_W + 2 * SWA_KV_W + 4 * GDN_W + 2 * GDN_HEADS
EVEN_MIX = SWA_Q_W + GDN_W
RET_QK_W = RET_HEADS * RET_QK_DIM
RET_V_W = RET_HEADS * RET_V_DIM
ODD_SPLITS = (RET_QK_W, RET_QK_W, RET_V_W, RET_V_W)
ODD_IN = 2 * RET_QK_W + 2 * RET_V_W
ODD_MIX = RET_V_W

kernel_name = 'hybrid_swa_gdn_retention_hmoe'


def _split(t, sizes):
    cuts = np.cumsum(np.asarray(sizes))[:-1].tolist()
    return jnp.split(t, cuts, axis=-1)


def rms_norm(x, gain=None):
    xf = x.astype(jnp.float32)
    y = xf * lax.rsqrt(jnp.mean(jnp.square(xf), axis=-1, keepdims=True) + EPS)
    if gain is not None:
        y = y * gain.astype(jnp.float32)
    return y.astype(x.dtype)


def l2_norm(x):
    xf = x.astype(jnp.float32)
    return xf * lax.rsqrt(jnp.sum(xf * xf, axis=-1, keepdims=True) + EPS)


def partial_rope(x, pos):
    half = ROT_DIM // 2
    inv_freq = 1.0 / (ROPE_THETA ** (jnp.arange(half, dtype=jnp.float32) * 2.0 / ROT_DIM))
    ang = pos[:, None] * inv_freq[None, :]
    cos = jnp.cos(ang)[None, :, None, :].astype(x.dtype)
    sin = jnp.sin(ang)[None, :, None, :].astype(x.dtype)
    x1 = x[..., :half]
    x2 = x[..., half:ROT_DIM]
    return jnp.concatenate([x1 * cos - x2 * sin, x2 * cos + x1 * sin, x[..., ROT_DIM:]], axis=-1)


def xpos_rotate(x, pos):
    half = x.shape[-1] // 2
    freq = 1.0 / (XPOS_THETA ** jnp.linspace(0.0, 1.0, half, dtype=jnp.float32))
    ang = pos[:, None] * freq[None, :]
    cos = jnp.cos(ang)[None, :, None, :].astype(x.dtype)
    sin = jnp.sin(ang)[None, :, None, :].astype(x.dtype)
    x1 = x[..., 0::2]
    x2 = x[..., 1::2]
    return jnp.stack([x1 * cos - x2 * sin, x2 * cos + x1 * sin], axis=-1).reshape(x.shape)


def causal_depthwise_conv(x, w):
    k_len, ch = w.shape
    return lax.conv_general_dilated(x, w[:, None, :], window_strides=(1,), padding=[(k_len - 1, 0)],
                                    dimension_numbers=('NWC', 'WIO', 'NWC'), feature_group_count=ch)


def sliding_window_attention(q, k, v, sinks):
    bsz, s, hq, dh = q.shape
    hkv = k.shape[2]
    grp = hq // hkv
    n = s // WINDOW
    qb = q.reshape(bsz, n, WINDOW, hkv, grp, dh)

    def band(t):
        t = t.reshape(bsz, n, WINDOW, hkv, dh)
        prev = jnp.pad(t, ((0, 0), (1, 0), (0, 0), (0, 0), (0, 0)))[:, :-1]
        return jnp.concatenate([prev, t], axis=2)

    kb, vb = band(k), band(v)
    scores = jnp.einsum('bnqhgd,bnkhd->bhgnqk', qb, kb).astype(jnp.float32) * (dh ** -0.5)
    blk = jnp.arange(n)[:, None] * WINDOW
    qpos = blk + jnp.arange(WINDOW)[None, :]
    kpos = blk - WINDOW + jnp.arange(2 * WINDOW)[None, :]
    rel = qpos[:, :, None] - kpos[:, None, :]
    mask = (rel >= 0) & (rel < WINDOW) & (kpos[:, None, :] >= 0)
    scores = jnp.where(mask, scores, -jnp.inf)
    sink = jnp.broadcast_to(sinks.astype(jnp.float32).reshape(1, hkv, grp, 1, 1, 1), scores.shape[:-1] + (1,))
    probs = jax.nn.softmax(jnp.concatenate([scores, sink], axis=-1), axis=-1)[..., :-1]
    out = jnp.einsum('bhgnqk,bnkhd->bnqhgd', probs.astype(v.dtype), vb)
    return out.reshape(bsz, s, hq * dh)


def gated_delta_rule(q, k, v, beta, g):
    bsz, s, h, dk = q.shape
    dv = v.shape[-1]
    c = GDN_CHUNK
    n = s // c

    def to_chunks(t):
        t = t.reshape((bsz, n, c, h) + t.shape[3:])
        return jnp.moveaxis(t, 3, 1)

    q, k, v, beta, g = map(to_chunks, (q, k, v, beta, g))
    g = jnp.cumsum(g, axis=-1)
    incl = jnp.tril(jnp.ones((c, c), dtype=bool))
    strict = jnp.tril(jnp.ones((c, c), dtype=bool), -1)
    decay = jnp.exp(jnp.where(incl, g[..., :, None] - g[..., None, :], -jnp.inf))
    kb = k * beta[..., None]
    lower = jnp.where(strict, jnp.einsum('bhnid,bhnjd->bhnij', kb, k) * decay, 0.0)
    eye = jnp.eye(c, dtype=jnp.float32)
    t_inv = lax.linalg.triangular_solve(eye + lower, jnp.broadcast_to(eye, lower.shape),
                                        left_side=True, lower=True)
    u = t_inv @ (v * beta[..., None])
    w = t_inv @ (kb * jnp.exp(g)[..., None])
    intra = jnp.einsum('bhnid,bhnjd->bhnij', q, k) * decay
    q_dec = q * jnp.exp(g)[..., None]
    g_last = g[..., -1]
    k_dec = k * jnp.exp(g_last[..., None] - g)[..., None]
    xs = tuple(jnp.moveaxis(t, 2, 0) for t in (u, w, intra, q_dec, k_dec, jnp.exp(g_last)))

    def step(state, inp):
        u_c, w_c, a_c, qd_c, kd_c, gl_c = inp
        v_new = u_c - jnp.einsum('bhck,bhkv->bhcv', w_c, state)
        out = jnp.einsum('bhck,bhkv->bhcv', qd_c, state) + jnp.einsum('bhij,bhjv->bhiv', a_c, v_new)
        state = state * gl_c[..., None, None] + jnp.einsum('bhck,bhcv->bhkv', kd_c, v_new)
        return state, out

    state0 = jnp.zeros((bsz, h, dk, dv), jnp.float32)
    _, out = lax.scan(step, state0, xs)
    return jnp.transpose(out, (1, 0, 3, 2, 4)).reshape(bsz, s, h, dv)


def multiscale_retention(q, k, v):
    bsz, s, h, dk = q.shape
    dv = v.shape[-1]
    c = RET_CHUNK
    n = s // c
    log_gamma = jnp.log(1.0 - 2.0 ** (-5.0 - jnp.arange(h, dtype=jnp.float32)))
    idx = jnp.arange(c, dtype=jnp.float32)
    rel = idx[:, None] - idx[None, :]
    decay = jnp.exp(jnp.where(rel >= 0, rel * log_gamma[:, None, None], -jnp.inf))
    xi = jnp.exp((idx + 1.0) * log_gamma[:, None])[..., None]
    zeta = jnp.exp((c - 1.0 - idx) * log_gamma[:, None])[..., None]
    gamma_c = jnp.exp(c * log_gamma)[:, None, None]

    def to_chunks(t):
        return jnp.transpose(t.reshape(bsz, n, c, h, t.shape[-1]), (1, 0, 3, 2, 4))

    def step(state, inp):
        q_c, k_c, v_c = inp
        inner = jnp.einsum('bhik,bhjk->bhij', q_c, k_c) * decay
        out = jnp.einsum('bhij,bhjv->bhiv', inner, v_c) + jnp.einsum('bhik,bhkv->bhiv', q_c, state) * xi
        state = state * gamma_c + jnp.einsum('bhjk,bhjv->bhkv', k_c * zeta, v_c)
        return state, out

    state0 = jnp.zeros((bsz, h, dk, dv), jnp.float32)
    _, out = lax.scan(step, state0, (to_chunks(q), to_chunks(k), to_chunks(v)))
    return jnp.transpose(out, (1, 0, 3, 2, 4)).reshape(bsz, s, h, dv)


def attn_delta_mixer(h, pos, w_in, conv_w, a_log, dt_bias, q_gain, k_gain, sinks, gdn_gain, w_out):
    bsz, s, _ = h.shape
    aq, ak, av, bqkv, bz, ba, bb = _split(h @ w_in, EVEN_SPLITS)
    q = rms_norm(aq.reshape(bsz, s, SWA_Q_HEADS, SWA_HEAD_DIM), q_gain)
    k = rms_norm(ak.reshape(bsz, s, SWA_KV_HEADS, SWA_HEAD_DIM), k_gain)
    v = av.reshape(bsz, s, SWA_KV_HEADS, SWA_HEAD_DIM)
    y_a = sliding_window_attention(partial_rope(q, pos), partial_rope(k, pos), v, sinks)
    qkv = jax.nn.silu(causal_depthwise_conv(bqkv, conv_w))
    bq, bk, bv = jnp.split(qkv, 3, axis=-1)
    head_shape = (bsz, s, GDN_HEADS, GDN_HEAD_DIM)
    bq = l2_norm(bq.reshape(head_shape)) * (GDN_HEAD_DIM ** -0.5)
    bk = l2_norm(bk.reshape(head_shape))
    bv = bv.reshape(head_shape).astype(jnp.float32)
    beta = jax.nn.sigmoid(bb.astype(jnp.float32))
    g = -jnp.exp(a_log.astype(jnp.float32)) * jax.nn.softplus(ba.astype(jnp.float32) + dt_bias.astype(jnp.float32))
    o = gated_delta_rule(bq, bk, bv, beta, g)
    o = rms_norm(o, gdn_gain).astype(h.dtype) * jax.nn.silu(bz.reshape(head_shape))
    y_b = o.reshape(bsz, s, GDN_W)
    return jnp.concatenate([y_a, y_b], axis=-1) @ w_out


def retention_mixer(h, pos, w_in, w_out):
    bsz, s, _ = h.shape
    q, k, v, z = _split(h @ w_in, ODD_SPLITS)
    qk_shape = (bsz, s, RET_HEADS, RET_QK_DIM)
    q = xpos_rotate(q.reshape(qk_shape), pos).astype(jnp.float32)
    k = xpos_rotate(k.reshape(qk_shape), pos).astype(jnp.float32) * (RET_QK_DIM ** -0.5)
    v = v.reshape(bsz, s, RET_HEADS, RET_V_DIM).astype(jnp.float32)
    o = rms_norm(multiscale_retention(q, k, v)).astype(h.dtype).reshape(bsz, s, ODD_MIX)
    return (jax.nn.silu(z) * o) @ w_out


def hierarchical_moe(x, w_rg, b_rg, w_re, b_re, w_gate, w_up, w_down):
    bsz, s, d = x.shape
    xt = x.reshape(-1, d)
    n_tok = xt.shape[0]
    n_assign = n_tok * TOP_K
    grp_prob = jax.nn.softmax((xt @ w_rg).astype(jnp.float32) + b_rg.astype(jnp.float32), axis=-1)
    grp_p, grp_idx = lax.top_k(grp_prob, 1)
    exp_logits = ((xt @ w_re).astype(jnp.float32) + b_re.astype(jnp.float32)).reshape(n_tok, N_GROUPS, EXPERTS_PER_GROUP)
    exp_logits = exp_logits[jnp.arange(n_tok), grp_idx[:, 0]]
    exp_p, exp_idx = lax.top_k(jax.nn.softmax(exp_logits, axis=-1), TOP_K)
    gates = grp_p * exp_p / jnp.sum(exp_p, axis=-1, keepdims=True)
    expert_id = (grp_idx * EXPERTS_PER_GROUP + exp_idx).reshape(-1)
    token_id = jnp.repeat(jnp.arange(n_tok), TOP_K)
    order = jnp.argsort(expert_id)
    e_sorted = expert_id[order]
    tok_sorted = token_id[order]
    gate_sorted = gates.reshape(-1)[order]
    counts = jnp.bincount(expert_id, length=N_EXPERTS)
    start = jnp.cumsum(counts) - counts
    padded = (counts + MOE_BLOCK - 1) // MOE_BLOCK * MOE_BLOCK
    padded_end = jnp.cumsum(padded)
    dest = padded_end[e_sorted] - padded[e_sorted] + jnp.arange(n_assign) - start[e_sorted]
    n_rows = n_assign + N_EXPERTS * MOE_BLOCK
    n_blocks = n_rows // MOE_BLOCK
    x_rows = jnp.zeros((n_rows, d), x.dtype).at[dest].set(xt[tok_sorted])
    block_expert = jnp.minimum(jnp.searchsorted(padded_end, jnp.arange(n_blocks) * MOE_BLOCK, side='right'), N_EXPERTS - 1)

    def expert_block(args):
        xb, e = args
        hid = jax.nn.silu(xb @ w_gate[e]) * (xb @ w_up[e])
        return hid @ w_down[e]

    y_rows = lax.map(expert_block, (x_rows.reshape(n_blocks, MOE_BLOCK, d), block_expert)).reshape(n_rows, d)
    y = jnp.zeros((n_tok, d), x.dtype).at[tok_sorted].add(y_rows[dest] * gate_sorted[:, None].astype(x.dtype))
    return y.reshape(bsz, s, d)


def setup_inputs(seed: int = 0) -> dict:
    key = jax.random.key(seed)
    ks = jax.random.split(key, 24)
    f32 = jnp.float32
    n_even = (DEPTH + 1) // 2
    n_odd = DEPTH // 2

    def normal(k, shape, scale):
        return jax.random.normal(k, shape, f32) * scale

    def gain(k, shape):
        return 1.0 + 0.02 * jax.random.normal(k, shape, f32)

    dt = jnp.exp(jax.random.uniform(ks[5], (n_even, GDN_HEADS), f32, np.log(1e-3), np.log(1e-1)))
    return {
        'x': normal(ks[0], (BATCH, SEQ, D_MODEL), 1.0),
        'ln_mix_even': gain(ks[1], (n_even, D_MODEL)),
        'w_in_even': normal(ks[2], (n_even, D_MODEL, EVEN_IN), D_MODEL ** -0.5),
        'conv_w_even': normal(ks[3], (n_even, CONV_K, 3 * GDN_W), CONV_K ** -0.5),
        'a_log_even': jnp.log(jax.random.uniform(ks[4], (n_even, GDN_HEADS), f32, 1.0, 16.0)),
        'dt_bias_even': dt + jnp.log(-jnp.expm1(-dt)),
        'q_gain_even': gain(ks[6], (n_even, SWA_HEAD_DIM)),
        'k_gain_even': gain(ks[7], (n_even, SWA_HEAD_DIM)),
        'sinks_even': normal(ks[8], (n_even, SWA_Q_HEADS), 1.0),
        'gdn_gain_even': gain(ks[9], (n_even, GDN_HEAD_DIM)),
        'w_out_even': normal(ks[10], (n_even, EVEN_MIX, D_MODEL), EVEN_MIX ** -0.5),
        'ln_mix_odd': gain(ks[11], (n_odd, D_MODEL)),
        'w_in_odd': normal(ks[12], (n_odd, D_MODEL, ODD_IN), D_MODEL ** -0.5),
        'w_out_odd': normal(ks[13], (n_odd, ODD_MIX, D_MODEL), ODD_MIX ** -0.5),
        'ln_ffn': gain(ks[14], (DEPTH, D_MODEL)),
        'w_router_group': normal(ks[15], (DEPTH, D_MODEL, N_GROUPS), D_MODEL ** -0.5),
        'b_router_group': normal(ks[16], (DEPTH, N_GROUPS), 0.01),
        'w_router_expert': normal(ks[17], (DEPTH, D_MODEL, N_EXPERTS), D_MODEL ** -0.5),
        'b_router_expert': normal(ks[18], (DEPTH, N_EXPERTS), 0.01),
        'w_gate': normal(ks[19], (DEPTH, N_EXPERTS, D_MODEL, D_EXPERT), D_MODEL ** -0.5),
        'w_up': normal(ks[20], (DEPTH, N_EXPERTS, D_MODEL, D_EXPERT), D_MODEL ** -0.5),
        'w_down': normal(ks[21], (DEPTH, N_EXPERTS, D_EXPERT, D_MODEL), D_EXPERT ** -0.5),
    }


def reference(x, ln_mix_even, w_in_even, conv_w_even, a_log_even, dt_bias_even, q_gain_even, k_gain_even,
              sinks_even, gdn_gain_even, w_out_even, ln_mix_odd, w_in_odd, w_out_odd, ln_ffn,
              w_router_group, b_router_group, w_router_expert, b_router_expert, w_gate, w_up, w_down):
    pos = jnp.arange(x.shape[1], dtype=jnp.float32)
    for layer in range(DEPTH):
        i = layer // 2
        if layer % 2 == 0:
            x = x + attn_delta_mixer(rms_norm(x, ln_mix_even[i]), pos, w_in_even[i], conv_w_even[i],
                                     a_log_even[i], dt_bias_even[i], q_gain_even[i], k_gain_even[i],
                                     sinks_even[i], gdn_gain_even[i], w_out_even[i])
        else:
            x = x + retention_mixer(rms_norm(x, ln_mix_odd[i]), pos, w_in_odd[i], w_out_odd[i])
        x = x + hierarchical_moe(rms_norm(x, ln_ffn[layer]), w_router_group[layer], b_router_group[layer],
                                 w_router_expert[layer], b_router_expert[layer], w_gate[layer],
                                 w_up[layer], w_down[layer])
    return x
```

```cpp
#include <hip/hip_runtime.h>
#include <hip/hip_cooperative_groups.h>
#include <cstdio>
#include <cstdint>
namespace cg = cooperative_groups;

#define LAS __attribute__((address_space(3)))
typedef unsigned short bf16_t;
typedef short bf16x8 __attribute__((ext_vector_type(8)));
typedef float f32x4 __attribute__((ext_vector_type(4)));
typedef float f32x2 __attribute__((ext_vector_type(2)));
typedef unsigned u32x4 __attribute__((ext_vector_type(4)));
typedef unsigned u32x2 __attribute__((ext_vector_type(2)));

constexpr int NB = 8, SEQ = 4096, D = 1024, T = NB * SEQ;
constexpr int EVEN_IN = 2824, N0 = 2816;
constexpr int ODD_IN = 6144;
constexpr int NEXP = 32, DEXP = 512;
constexpr int ROWS_PAD = 73728;
constexpr float EPS = 1e-6f;
constexpr int NWAVES = 8, NTHREADS = 512;
constexpr int LDS_BYTES = 163840;

constexpr size_t MiB = 1u << 20;
constexpr size_t WS_CTL = 0;
constexpr size_t WS_WIN0 = 1 * MiB;
constexpr size_t WS_WOUT0 = 7 * MiB;
constexpr size_t WS_WIN1 = 9 * MiB;
constexpr size_t WS_WOUT1 = 21 * MiB;
constexpr size_t WS_X = 25 * MiB;
constexpr size_t WS_XB1 = WS_X;
constexpr size_t WS_XB2 = WS_X + 64 * MiB;
constexpr size_t WS_H1 = WS_X;
constexpr size_t WS_INNER = WS_X;
constexpr size_t WS_KZT = WS_X + 32 * MiB;
constexpr size_t WS_SM = 121 * MiB;
constexpr size_t WS_BAB = WS_SM;
constexpr size_t WS_RE = WS_SM + 1 * MiB;
constexpr size_t WS_RG = WS_RE + 256 * 1024;
constexpr size_t WS_RS = WS_RG + 256 * 1024;
constexpr size_t WS_RP = WS_RS + 256 * 1024;
constexpr size_t WS_SSQ = WS_SM + 2 * MiB;
constexpr size_t WS_GL = WS_SM + 6 * MiB;
constexpr size_t WS_BC = WS_SM + 7 * MiB;
constexpr size_t WS_A = 129 * MiB;
constexpr size_t WS_PROJ0 = WS_A;
constexpr size_t WS_HMIX0 = WS_A + 176 * MiB;
constexpr size_t WS_GU = WS_A + 240 * MiB;
constexpr size_t WS_GW = WS_A + 272 * MiB;
constexpr size_t WS_GQD = WS_A + 304 * MiB;
constexpr size_t WS_GKDT = WS_A + 336 * MiB;
constexpr size_t WS_GA = WS_A + 368 * MiB;
constexpr size_t WS_XN = WS_A;
constexpr size_t WS_XROWS = WS_A + 64 * MiB;
constexpr size_t WS_HID = WS_A + 208 * MiB;
constexpr size_t WS_PROJ1 = WS_A;
constexpr size_t WS_END = 513 * MiB;

__device__ __forceinline__ float bf2f(unsigned b) { return __uint_as_float(b << 16); }
typedef __bf16 bf16x2_t __attribute__((ext_vector_type(2)));
__device__ __forceinline__ unsigned cvt_pk_bf16(float lo, float hi) { f32x2 v = {lo, hi}; bf16x2_t b = __builtin_convertvector(v, bf16x2_t); return __builtin_bit_cast(unsigned, b); }
__device__ __forceinline__ unsigned short f2bf(float f) { return (unsigned short)(cvt_pk_bf16(f, 0.f) & 0xffffu); }
__device__ __forceinline__ float lo_bf(unsigned w) { return __uint_as_float(w << 16); }
__device__ __forceinline__ float hi_bf(unsigned w) { return __uint_as_float(w & 0xffff0000u); }
__device__ __forceinline__ float silu_f(float x) { return x / (1.0f + __expf(-x)); }
__device__ __forceinline__ float sigmoid_f(float x) { return 1.0f / (1.0f + __expf(-x)); }
__device__ __forceinline__ f32x4 mfma16(bf16x8 a, bf16x8 b, f32x4 c) { return __builtin_amdgcn_mfma_f32_16x16x32_bf16(a, b, c, 0, 0, 0); }
__device__ __forceinline__ bf16x8 mk8(u32x2 lo, u32x2 hi) { u32x4 v; v.x = lo.x; v.y = lo.y; v.z = hi.x; v.w = hi.y; return __builtin_bit_cast(bf16x8, v); }
__device__ __forceinline__ bf16x8 mk8f(f32x4 a, f32x4 b) { u32x4 v; v.x = cvt_pk_bf16(a[0], a[1]); v.y = cvt_pk_bf16(a[2], a[3]); v.z = cvt_pk_bf16(b[0], b[1]); v.w = cvt_pk_bf16(b[2], b[3]); return __builtin_bit_cast(bf16x8, v); }
__device__ __forceinline__ float wave_sum(float v) {
#pragma unroll
    for (int o = 1; o < 64; o <<= 1) v += __shfl_xor(v, o);
    return v;
}
__device__ __forceinline__ void sincos_rev(float ang, float& s, float& c) {
    float r = ang * 0.15915494309189535f; r = r - floorf(r);
    s = __builtin_amdgcn_sinf(r); c = __builtin_amdgcn_cosf(r);
}

namespace pg8 {
constexpr int BM = 256, BK = 64, HALF = 128, HTB = HALF * BK * 2, STAGE_BYTES = 8 * HTB, NXCD = 8, WGM = 8;
__device__ __forceinline__ int lds_byte(int r, int c) { const int st = (r >> 4) * 2 + (c >> 5), rr = r & 15, cc = c & 31, ob = rr * 64 + cc * 2; return st * 1024 + (ob ^ (((ob >> 9) & 1) << 5)); }
__device__ __forceinline__ void stage_rc(int b, int& R, int& C) { const int st = b / 1024, sb = b % 1024, swz = sb ^ (((sb >> 9) & 1) << 5); R = (st >> 1) * 16 + swz / 64; C = (st & 1) * 32 + (swz % 64) / 2; }
__device__ __forceinline__ int perm32(int rho) { const int n = rho >> 4, i = rho & 15; return 8 * (i >> 2) + 4 * n + (i & 3); }

struct Unit { size_t aoff, boff; int pm, pn; };
struct Gemm { const bf16_t* A; const bf16_t* Bt; int lda, K; };

struct DenseOrder {
    int nM, nN, nwg, G, c, lda, K;
    __device__ void init(int M, int N, int G_, int c_, int lda_, int K_) { nM = M / BM; nN = N / BM; nwg = nM * nN; G = G_; c = c_; lda = lda_; K = K_; }
    __device__ bool next(int i, Unit& u) const {
        const long L = (long)i * G + c; if (L >= nwg) return false;
        int wgid = (int)L; { const int q = nwg / NXCD, r = nwg % NXCD, xcd = wgid % NXCD, off = wgid / NXCD; wgid = (xcd < r ? xcd * (q + 1) : r * (q + 1) + (xcd - r) * q) + off; }
        const int nig = WGM * nN, gid = wgid / nig, fm = gid * WGM, gsz = (nM - fm) < WGM ? (nM - fm) : WGM;
        u.pm = fm + ((wgid % nig) % gsz); u.pn = (wgid % nig) / gsz;
        u.aoff = (size_t)u.pm * BM * lda * 2; u.boff = (size_t)u.pn * BM * K * 2; return true;
    }
};
struct GroupedOrder {
    const LAS int* tile_e; int ntiles, G, c, lda, K; size_t estride;
    __device__ bool next(int i, Unit& u) const {
        const int L = i * G + c; if (L >= ntiles * 4) return false;
        const int rt = L >> 2, pn = L & 3; const int e = tile_e[rt];
        u.pm = rt; u.pn = pn; u.aoff = (size_t)rt * BM * lda * 2; u.boff = (size_t)e * estride + (size_t)pn * BM * K * 2; return true;
    }
};

struct EpiBf16 {
    static constexpr bool PERM = true;
    bf16_t* O; int ldc;
    __device__ __forceinline__ void operator()(const f32x4 (&acc)[2][2][4][2], const Unit& u, int wr, int wc, int fr, int fq) const {
        const int row0 = u.pm * BM + wr * 64 + fr; const int col0 = u.pn * BM + wc * 32 + 8 * fq;
#pragma unroll
        for (int ai = 0; ai < 2; ++ai)
#pragma unroll
            for (int m = 0; m < 4; ++m) { bf16_t* rowp = O + (size_t)(row0 + ai * HALF + m * 16) * ldc + col0;
#pragma unroll
                for (int bj = 0; bj < 2; ++bj) { const f32x4 v0 = acc[ai][bj][m][0], v1 = acc[ai][bj][m][1];
                    u32x4 w; w.x = cvt_pk_bf16(v0[0], v0[1]); w.y = cvt_pk_bf16(v0[2], v0[3]); w.z = cvt_pk_bf16(v1[0], v1[1]); w.w = cvt_pk_bf16(v1[2], v1[3]);
                    *(u32x4*)(rowp + bj * HALF) = w; } }
    }
};
struct EpiResF32 {
    static constexpr bool PERM = false;
    const float* base; float* out; int ldc;
    __device__ __forceinline__ void operator()(const f32x4 (&acc)[2][2][4][2], const Unit& u, int wr, int wc, int fr, int fq) const {
        const int row0 = u.pm * BM + wr * 64 + fr, col0 = u.pn * BM + wc * 32 + 4 * fq;
#pragma unroll
        for (int ai = 0; ai < 2; ++ai)
#pragma unroll
            for (int m = 0; m < 4; ++m) { const size_t off = (size_t)(row0 + ai * HALF + m * 16) * ldc + col0;
#pragma unroll
                for (int bj = 0; bj < 2; ++bj)
#pragma unroll
                    for (int n = 0; n < 2; ++n) { const f32x4 b = *(const f32x4*)(base + off + bj * HALF + n * 16); *(f32x4*)(out + off + bj * HALF + n * 16) = b + acc[ai][bj][m][n]; } }
    }
};
struct EpiSwiGLU {
    static constexpr bool PERM = false;
    bf16_t* H;
    __device__ __forceinline__ void operator()(const f32x4 (&acc)[2][2][4][2], const Unit& u, int wr, int wc, int fr, int fq) const {
        const int row0 = u.pm * BM + wr * 64 + fr;
#pragma unroll
        for (int ai = 0; ai < 2; ++ai)
#pragma unroll
            for (int m = 0; m < 4; ++m) { bf16_t* rowp = H + (size_t)(row0 + ai * HALF + m * 16) * DEXP;
#pragma unroll
                for (int bj = 0; bj < 2; ++bj) { const f32x4 g = acc[ai][bj][m][0], up = acc[ai][bj][m][1];
                    const int hc = 16 * (8 * u.pn + 4 * bj + wc) + 4 * fq;
                    u32x2 w; w.x = cvt_pk_bf16(silu_f(g[0]) * up[0], silu_f(g[1]) * up[1]); w.y = cvt_pk_bf16(silu_f(g[2]) * up[2], silu_f(g[3]) * up[3]);
                    *(u32x2*)(rowp + hc) = w; } }
    }
};

template <class Epi, class Sched>
__device__ __forceinline__ void gemm_phase(LAS unsigned char* lds, const Gemm g, const Sched& S, const Epi& E) {
    const int tid = threadIdx.x, wid = __builtin_amdgcn_readfirstlane(tid >> 6), lane = tid & 63, wr = wid >> 2, wc = wid & 3, fr = lane & 15, fq = lane >> 4;
    const int K = g.K, nt = K / BK;
    unsigned voffA[2], voffB[2];
#pragma unroll
    for (int i = 0; i < 2; ++i) { int R, C; stage_rc(tid * 16 + i * 8192, R, C); const int Rb = Epi::PERM ? ((R & ~31) + perm32(R & 31)) : R;
        voffA[i] = (unsigned)(R * g.lda + C) * 2u; voffB[i] = (unsigned)(Rb * K + C) * 2u; }
    const size_t kstep = (size_t)(BK * 2);
    const size_t hstepA = (size_t)HALF * g.lda * 2, hstepB = (size_t)HALF * K * 2;
    const unsigned ldsw = (unsigned)wid * 1024u;
    const int aoff = lds_byte(wr * 64 + fr, fq * 8), boff = lds_byte(wc * 32 + fr, fq * 8);
#define PG8_SA(b, h) (((b) * 2 + (h)) * HTB)
#define PG8_SB(b, h) ((4 + (b) * 2 + (h)) * HTB)
#define PG8_STAGE(bufoff, gbase, voff) do { _Pragma("unroll") for (int _i = 0; _i < 2; ++_i) \
        __builtin_amdgcn_global_load_lds((const unsigned*)((const char*)(gbase) + (voff)[_i]), (LAS unsigned*)(lds + (bufoff) + ldsw + _i * 8192), 16, 0, 0); } while (0)
#define PG8_LDA(dst, b, h) do { _Pragma("unroll") for (int m = 0; m < 4; ++m) _Pragma("unroll") for (int k = 0; k < 2; ++k) dst[m][k] = *(const LAS bf16x8*)(lds + PG8_SA(b, h) + aoff + m * 2048 + k * 1024); } while (0)
#define PG8_LDB(dst, b, h) do { _Pragma("unroll") for (int n = 0; n < 2; ++n) _Pragma("unroll") for (int k = 0; k < 2; ++k) dst[n][k] = *(const LAS bf16x8*)(lds + PG8_SB(b, h) + boff + n * 2048 + k * 1024); } while (0)
#define PG8_MMA(ai, bj, At, Bt) do { __builtin_amdgcn_s_setprio(1); _Pragma("unroll") for (int m = 0; m < 4; ++m) _Pragma("unroll") for (int n = 0; n < 2; ++n) _Pragma("unroll") for (int k = 0; k < 2; ++k) \
        acc[ai][bj][m][n] = __builtin_amdgcn_mfma_f32_16x16x32_bf16(Bt[n][k], At[m][k], acc[ai][bj][m][n], 0, 0, 0); __builtin_amdgcn_s_setprio(0); } while (0)
#define PG8_WAIT_V(n) asm volatile("s_waitcnt vmcnt(" #n ")" ::: "memory")
#define PG8_WAIT_L(n) asm volatile("s_waitcnt lgkmcnt(" #n ")" ::: "memory")
#define PG8_BAR __builtin_amdgcn_s_barrier()
#define PG8_SCHED __builtin_amdgcn_sched_barrier(0)
    Unit cur, nxt; int ui = 0;
    if (!S.next(0, cur)) return;
    f32x4 acc[2][2][4][2];
#pragma unroll
    for (int a = 0; a < 2; ++a)
#pragma unroll
        for (int b = 0; b < 2; ++b)
#pragma unroll
            for (int m = 0; m < 4; ++m)
#pragma unroll
                for (int n = 0; n < 2; ++n) acc[a][b][m][n] = (f32x4){0.f, 0.f, 0.f, 0.f};
    bf16x8 At[4][2], B0[2][2], B1[2][2];
    const char* cA = (const char*)g.A + cur.aoff; const char* cB = (const char*)g.Bt + cur.boff;
    PG8_STAGE(PG8_SB(0, 0), cB, voffB); PG8_STAGE(PG8_SB(0, 1), cB + hstepB, voffB); PG8_STAGE(PG8_SA(0, 0), cA, voffA); PG8_STAGE(PG8_SA(0, 1), cA + hstepA, voffA);
    if (wr == 1) PG8_BAR;
    PG8_WAIT_V(2); PG8_BAR;
    PG8_STAGE(PG8_SB(1, 0), cB + kstep, voffB); PG8_STAGE(PG8_SA(1, 0), cA + kstep, voffA); PG8_STAGE(PG8_SB(1, 1), cB + hstepB + kstep, voffB);
    PG8_WAIT_V(6); PG8_BAR;
    for (;;) {
        const bool has_next = S.next(ui + 1, nxt);
        const char* nA = has_next ? (const char*)g.A + nxt.aoff : cA; const char* nB = has_next ? (const char*)g.Bt + nxt.boff : cB;
        for (int t = 0; t < nt; t += 2) {
            const bool last = (t == nt - 2);
            const char* a1 = cA + (size_t)(t + 1) * kstep;
            const char* a2 = last ? nA : cA + (size_t)(t + 2) * kstep; const char* b2 = last ? nB : cB + (size_t)(t + 2) * kstep;
            const char* a3 = a2 + kstep; const char* b3 = b2 + kstep;
            PG8_LDB(B0, 0, 0); PG8_LDB(B1, 0, 1); PG8_SCHED; PG8_LDA(At, 0, 0); PG8_STAGE(PG8_SA(1, 1), a1 + hstepA, voffA);
            PG8_WAIT_V(8); PG8_WAIT_L(0); PG8_BAR; PG8_MMA(0, 0, At, B0); PG8_MMA(0, 1, At, B1); PG8_BAR; PG8_SCHED;
            PG8_LDA(At, 0, 1); PG8_STAGE(PG8_SB(0, 0), b2, voffB); PG8_STAGE(PG8_SB(0, 1), b2 + hstepB, voffB); PG8_STAGE(PG8_SA(0, 0), a2, voffA);
            PG8_WAIT_V(8); PG8_WAIT_L(0); PG8_BAR; PG8_MMA(1, 0, At, B0); PG8_MMA(1, 1, At, B1); PG8_BAR; PG8_SCHED;
            PG8_LDB(B0, 1, 0); PG8_LDB(B1, 1, 1); PG8_SCHED; PG8_LDA(At, 1, 0); PG8_STAGE(PG8_SA(0, 1), a2 + hstepA, voffA);
            PG8_WAIT_V(8); PG8_WAIT_L(0); PG8_BAR; PG8_MMA(0, 0, At, B0); PG8_MMA(0, 1, At, B1); PG8_BAR; PG8_SCHED;
            PG8_LDA(At, 1, 1); PG8_STAGE(PG8_SB(1, 0), b3, voffB); PG8_STAGE(PG8_SB(1, 1), b3 + hstepB, voffB); PG8_STAGE(PG8_SA(1, 0), a3, voffA);
            PG8_WAIT_V(8); PG8_WAIT_L(0); PG8_BAR; PG8_MMA(1, 0, At, B0); PG8_MMA(1, 1, At, B1); PG8_BAR; PG8_SCHED;
        }
        if (wr == 0) PG8_BAR;
        E(acc, cur, wr, wc, fr, fq);
        if (!has_next) break;
#pragma unroll
        for (int a = 0; a < 2; ++a)
#pragma unroll
            for (int b = 0; b < 2; ++b)
#pragma unroll
                for (int m = 0; m < 4; ++m)
#pragma unroll
                    for (int n = 0; n < 2; ++n) acc[a][b][m][n] = (f32x4){0.f, 0.f, 0.f, 0.f};
        cur = nxt; cA = nA; cB = nB; ++ui;
        if (wr == 1) PG8_BAR;
    }
    PG8_WAIT_V(0);
    PG8_BAR;
#undef PG8_SA
#undef PG8_SB
#undef PG8_STAGE
#undef PG8_LDA
#undef PG8_LDB
#undef PG8_MMA
#undef PG8_WAIT_V
#undef PG8_WAIT_L
#undef PG8_BAR
#undef PG8_SCHED
}
}

#define XB_TMO      128
#define XB_XCNT(j)  (256  + 64 * (j))
#define XB_XSUB(j)  (1280 + 64 * (j))
#define XB_XGEN(j)  (2304 + 64 * (j))
#define XB_TOP      3328
#define XB_TOPGEN   3392
#define XCD_BAR_WORDS 3456
#define XB_SPIN_CAP (1u << 18)
__device__ __forceinline__ unsigned xb_ld(unsigned* p)              { return __hip_atomic_load(p, __ATOMIC_RELAXED, __HIP_MEMORY_SCOPE_AGENT); }
__device__ __forceinline__ unsigned xb_add(unsigned* p, unsigned v) { return __hip_atomic_fetch_add(p, v, __ATOMIC_RELAXED, __HIP_MEMORY_SCOPE_AGENT); }
__device__ __forceinline__ unsigned xb_xcc_id() { return (unsigned)__builtin_amdgcn_s_getreg((3 << 11) | 20) & 0xFu; }
#define XB_SPIN(cond, bar) do { unsigned _sp = 0; while (cond) { __builtin_amdgcn_s_sleep(1); \
    if ((++_sp & 255u) == 0u) { if (xb_ld(&(bar)[XB_TMO])) break; if (_sp > XB_SPIN_CAP) { atomicAdd(&(bar)[XB_TMO], 1u); break; } } } } while (0)
struct XcdBarrier { unsigned* bar; unsigned x; volatile LAS unsigned* st; };
__device__ __forceinline__ XcdBarrier xcd_barrier_post(unsigned* bar, volatile LAS unsigned* st) {
    XcdBarrier b; b.bar = bar; b.x = xb_xcc_id(); b.st = st;
    if (threadIdx.x == 0) (void)xb_add(&bar[XB_XCNT(b.x)], 1u);
    return b;
}
__device__ __forceinline__ void xcd_barrier_complete(unsigned* bar, unsigned x, unsigned& nloc, unsigned& nx) {
    const unsigned G = gridDim.x * gridDim.y * gridDim.z;
    unsigned sum, cnt, mine, sp = 0u;
    for (;;) {
        sum = 0u; cnt = 0u; mine = 0u;
#pragma unroll
        for (unsigned j = 0; j < 16; ++j) { const unsigned c = xb_ld(&bar[XB_XCNT(j)]); sum += c; cnt += (c > 0u) ? 1u : 0u; mine = (j == x) ? c : mine; }
        if (sum == G) break;
        __builtin_amdgcn_s_sleep(1);
        if ((++sp & 255u) == 0u) { if (xb_ld(&bar[XB_TMO])) break; if (sp > XB_SPIN_CAP) { atomicAdd(&bar[XB_TMO], 1u); break; } }
    }
    nloc = mine > 0u ? mine : 1u; nx = cnt > 0u ? cnt : 1u;
}
__device__ __forceinline__ void xcd_barrier(const XcdBarrier& b) {
    asm volatile("s_waitcnt vmcnt(0)" ::: "memory");
    __syncthreads();
    if (threadIdx.x == 0) {
        unsigned* bar = b.bar;
        __builtin_amdgcn_s_waitcnt(0);
        unsigned nloc = b.st[0], nx = b.st[1];
        if (nloc == 0u) { xcd_barrier_complete(bar, b.x, nloc, nx); b.st[0] = nloc; b.st[1] = nx; }
        const unsigned old = xb_add(&bar[XB_XSUB(b.x)], 1u);
        const unsigned gen = old / nloc;
        if (old + 1u == (gen + 1u) * nloc) {
            __builtin_amdgcn_fence(__ATOMIC_RELEASE, "agent");
            asm volatile("s_waitcnt vmcnt(0)" ::: "memory");
            const unsigned og = xb_add(&bar[XB_TOP], 1u);
            const unsigned tg = og / nx;
            if (og + 1u == (tg + 1u) * nx) xb_add(&bar[XB_TOPGEN], 1u);
            else XB_SPIN(xb_ld(&bar[XB_TOPGEN]) == tg, bar);
            __builtin_amdgcn_fence(__ATOMIC_ACQUIRE, "agent");
            xb_add(&bar[XB_XGEN(b.x)], 1u);
            asm volatile("s_waitcnt vmcnt(0)" ::: "memory");
        } else {
            XB_SPIN(xb_ld(&bar[XB_XGEN(b.x)]) == gen, bar);
            __builtin_amdgcn_fence(__ATOMIC_ACQUIRE, "agent");
            asm volatile("s_waitcnt vmcnt(0)" ::: "memory");
        }
    }
    __syncthreads();
}

struct Args {
    const float* in[22];
    float* out; unsigned char* ws;
    int ph_lo, ph_hi;
};
enum { I_X = 0, I_LNE, I_WINE, I_CONVW, I_ALOG, I_DTB, I_QG, I_KG, I_SINK, I_GDNG, I_WOUTE, I_LNO, I_WINO, I_WOUTO, I_LNF, I_WRG, I_BRG, I_WRE, I_BRE, I_WG, I_WU, I_WD };

__device__ __forceinline__ void transpose_item(const float* W, int K, int ldw, int ncols, bf16_t* WT, int mode, LAS float* scr, int item, int lane) {
    const int nblk = ncols / 32, kb = item / nblk, nb = item % nblk, k0 = 64 * kb, n0 = 32 * nb;
#pragma unroll 8
    for (int i = 0; i < 32; ++i) { const int kk = 2 * i + (lane >> 5); scr[kk * 33 + (lane & 31)] = W[(size_t)(k0 + kk) * ldw + n0 + (lane & 31)]; }
    asm volatile("s_waitcnt lgkmcnt(0)" ::: "memory");
    const int c = lane & 7;
#pragma unroll
    for (int j = 0; j < 4; ++j) { const int n = (lane >> 3) + 8 * j; const LAS float* s = scr + (8 * c) * 33 + n;
        u32x4 o; o.x = cvt_pk_bf16(s[0 * 33], s[1 * 33]); o.y = cvt_pk_bf16(s[2 * 33], s[3 * 33]); o.z = cvt_pk_bf16(s[4 * 33], s[5 * 33]); o.w = cvt_pk_bf16(s[6 * 33], s[7 * 33]);
        const int ng = n0 + n; const int row = (mode == 0) ? ng : (32 * (ng >> 4) + (ng & 15) + (mode == 2 ? 16 : 0));
        *(u32x4*)(WT + (size_t)row * K + k0 + 8 * c) = o; }
    asm volatile("s_waitcnt lgkmcnt(0)" ::: "memory");
}
__device__ __forceinline__ void convert_moe(const Args& a, int layer, LAS float* scr, int gw, int ngw, int lane) {
    bf16_t* B1 = (bf16_t*)(a.ws + WS_XB1); bf16_t* B2 = (bf16_t*)(a.ws + WS_XB2);
    const float* wg = a.in[I_WG] + (size_t)layer * NEXP * D * DEXP; const float* wu = a.in[I_WU] + (size_t)layer * NEXP * D * DEXP; const float* wd = a.in[I_WD] + (size_t)layer * NEXP * DEXP * D;
    constexpr int IG = (D / 64) * (DEXP / 32);
    constexpr int ID = (DEXP / 64) * (D / 32);
    constexpr int PER_E = 2 * IG + ID;
    for (int it = gw; it < NEXP * PER_E; it += ngw) {
        const int e = it / PER_E; int r = it % PER_E;
        if (r < IG) { transpose_item(wg + (size_t)e * D * DEXP, D, DEXP, DEXP, B1 + (size_t)e * 1024 * 1024, 1, scr, r, lane); continue; } r -= IG;
        if (r < IG) { transpose_item(wu + (size_t)e * D * DEXP, D, DEXP, DEXP, B1 + (size_t)e * 1024 * 1024, 2, scr, r, lane); continue; } r -= IG;
        transpose_item(wd + (size_t)e * DEXP * D, DEXP, D, D, B2 + (size_t)e * 1024 * 512, 0, scr, r, lane);
    }
}

__device__ __forceinline__ void moe_route(const Args& a, int layer, LAS unsigned char* lds, int bid, int G, int tid, int lane, int wave) {
    LAS float* wT = (LAS float*)lds;
    LAS float* lng = (LAS float*)(lds + 147456);
    LAS float* bias = (LAS float*)(lds + 151552);
    LAS int* lcnt = (LAS int*)(lds + 151552 + 256);
    LAS int* lbase = lcnt + 32;
    LAS int* tokE = lbase + 32;
    LAS int* tokR = tokE + 256;
    const float* wrg = a.in[I_WRG] + (size_t)layer * D * 4; const float* wre = a.in[I_WRE] + (size_t)layer * D * 32;
    for (int i = tid; i < 4 * 1024; i += NTHREADS) { const int k = i >> 2, o = i & 3; wT[o * 1024 + k] = wrg[i]; }
    for (int i = tid; i < 32 * 1024; i += NTHREADS) { const int k = i >> 5, o = i & 31; wT[(4 + o) * 1024 + k] = wre[i]; }
    for (int i = tid; i < 1024; i += NTHREADS) lng[i] = a.in[I_LNF][layer * D + i];
    if (tid < 4) bias[tid] = a.in[I_BRG][layer * 4 + tid];
    if (tid >= 64 && tid < 96) bias[4 + tid - 64] = a.in[I_BRE][layer * 32 + tid - 64];
    const float* x = a.out;
    bf16_t* xn = (bf16_t*)(a.ws + WS_XN);
    int* RE = (int*)(a.ws + WS_RE); float* RG = (float*)(a.ws + WS_RG); int* RS = (int*)(a.ws + WS_RS);
    int* gcnt = (int*)(a.ws + WS_CTL) + layer * 32; int* BC = (int*)(a.ws + WS_BC);
    const int tsub = lane >> 4, l16 = lane & 15;
    for (int tile = bid; tile < T / 128; tile += G) {
        __syncthreads();
        if (tid < 32) lcnt[tid] = 0;
        __syncthreads();
        for (int iter = 0; iter < 4; ++iter) {
            const int tl = wave * 16 + iter * 4 + tsub, t = tile * 128 + tl;
            const f32x4* xr = (const f32x4*)(x + (size_t)t * D) + l16;
            f32x4 v[16]; float ss = 0.f;
#pragma unroll
            for (int j = 0; j < 16; ++j) { v[j] = xr[16 * j]; ss += (v[j][0] * v[j][0] + v[j][1] * v[j][1]) + (v[j][2] * v[j][2] + v[j][3] * v[j][3]); }
            ss += __shfl_xor(ss, 1); ss += __shfl_xor(ss, 2); ss += __shfl_xor(ss, 4); ss += __shfl_xor(ss, 8);
            const float rstd = rsqrtf(ss * (1.f / D) + EPS);
            unsigned long long* o8 = (unsigned long long*)(xn + (size_t)t * D) + l16;
#pragma unroll
            for (int j = 0; j < 16; ++j) { v[j] = v[j] * rstd * *((const LAS f32x4*)lng + l16 + 16 * j);
                o8[16 * j] = (unsigned long long)cvt_pk_bf16(v[j][0], v[j][1]) | ((unsigned long long)cvt_pk_bf16(v[j][2], v[j][3]) << 32); }
            LAS float* lgs = (LAS float*)(lds + 154624) + (wave * 4 + tsub) * 40;
#pragma unroll 2
            for (int o = 0; o < 36; ++o) { float acc = 0.f;
#pragma unroll
                for (int j = 0; j < 16; ++j) { const f32x4 w = *((const LAS f32x4*)(wT + o * 1024) + l16 + 16 * j); acc += (v[j][0] * w[0] + v[j][1] * w[1]) + (v[j][2] * w[2] + v[j][3] * w[3]); }
                acc += __shfl_xor(acc, 1); acc += __shfl_xor(acc, 2); acc += __shfl_xor(acc, 4); acc += __shfl_xor(acc, 8);
                if (l16 == 0) lgs[o] = acc + bias[o]; }
            asm volatile("s_waitcnt lgkmcnt(0)" ::: "memory");
            int gi = 0; float gm = lgs[0];
            for (int o = 1; o < 4; ++o) { const float lv = lgs[o]; if (lv > gm) { gm = lv; gi = o; } }
            float gs = 0.f;
            for (int o = 0; o < 4; ++o) gs += __expf(lgs[o] - gm);
            const float grp_p = 1.f / gs;
            const LAS float* le = lgs + 4 + 8 * gi;
            int e1 = 0; float m1 = le[0];
            for (int k = 1; k < 8; ++k) { const float lv = le[k]; if (lv > m1) { m1 = lv; e1 = k; } }
            int e2 = -1; float m2 = -3.0e38f;
            for (int k = 0; k < 8; ++k) { const float lv = le[k]; if (k != e1 && lv > m2) { m2 = lv; e2 = k; } }
            const float p2 = __expf(m2 - m1);
            const float g1 = grp_p / (1.f + p2), g2 = grp_p * p2 / (1.f + p2);
            if (l16 == 0) {
                const int ea = gi * 8 + e1, eb = gi * 8 + e2;
                RE[(size_t)t * 2] = ea; RE[(size_t)t * 2 + 1] = eb; RG[(size_t)t * 2] = g1; RG[(size_t)t * 2 + 1] = g2;
                tokE[tl * 2] = ea; tokE[tl * 2 + 1] = eb;
                atomicAdd((int*)(lcnt + ea), 1); atomicAdd((int*)(lcnt + eb), 1);
            }
        }
        __syncthreads();
        if (tid < 32) { const int c = lcnt[tid]; BC[tile * 32 + tid] = c; atomicAdd(gcnt + tid, c); }
        if (tid < 256) { const int e = tokE[tid]; int rank = 0; for (int j = 0; j < tid; ++j) rank += (tokE[j] == e) ? 1 : 0; RS[(size_t)tile * 256 + tid] = rank; }
    }
}
__device__ __forceinline__ void moe_tables(const Args& a, int layer, LAS int* tab, int tid) {
    __syncthreads();
    if (tid == 0) {
        const int* gcnt = (const int*)(a.ws + WS_CTL) + layer * 32; int t = 0;
        for (int e = 0; e < 32; ++e) { const int c = __hip_atomic_load(gcnt + e, __ATOMIC_RELAXED, __HIP_MEMORY_SCOPE_AGENT); const int nt = (c + 255) >> 8; tab[e] = t * 256; for (int i = 0; i < nt; ++i) tab[64 + t + i] = e; t += nt; }
        tab[32] = t;
    }
    __syncthreads();
}
__device__ __forceinline__ void moe_scatter(const Args& a, int layer, LAS unsigned char* lds, int bid, int G, int tid, int lane, int wave) {
    LAS int* tab = (LAS int*)(lds + 131072);
    LAS int* psum = (LAS int*)(lds + 131072 + 4096);
    moe_tables(a, layer, tab, tid);
    const bf16_t* xn = (const bf16_t*)(a.ws + WS_XN); bf16_t* xr = (bf16_t*)(a.ws + WS_XROWS);
    const int* RE = (const int*)(a.ws + WS_RE); const int* RS = (const int*)(a.ws + WS_RS); int* RP = (int*)(a.ws + WS_RP); const int* BC = (const int*)(a.ws + WS_BC);
    for (int tile = bid; tile < T / 128; tile += G) {
        __syncthreads();
        { const int e = tid & 31, part = tid >> 5; int sacc = 0; for (int b2 = part * 16; b2 < part * 16 + 16; ++b2) if (b2 < tile) sacc += BC[b2 * 32 + e]; psum[part * 32 + e] = sacc; }
        __syncthreads();
        if (tid < 32) { int sacc = 0; for (int p2 = 0; p2 < 16; ++p2) sacc += psum[p2 * 32 + tid]; psum[512 + tid] = sacc + tab[tid]; }
        __syncthreads();
        for (int i = 0; i < 16; ++i) {
            const int t = tile * 128 + wave * 16 + i;
            const int e0 = RE[(size_t)t * 2], e1 = RE[(size_t)t * 2 + 1];
            const int r0 = psum[512 + e0] + RS[(size_t)t * 2], r1 = psum[512 + e1] + RS[(size_t)t * 2 + 1];
            const u32x4* src = (const u32x4*)(xn + (size_t)t * D) + lane;
            const u32x4 v0 = src[0], v1 = src[64];
            u32x4* d0 = (u32x4*)(xr + (size_t)r0 * D) + lane; u32x4* d1 = (u32x4*)(xr + (size_t)r1 * D) + lane;
            d0[0] = v0; d0[64] = v1; d1[0] = v0; d1[64] = v1;
            if (lane == 0) { RP[(size_t)t * 2] = r0; RP[(size_t)t * 2 + 1] = r1; }
        }
    }
}
__device__ __forceinline__ void moe_gemm1(const Args& a, int layer, LAS unsigned char* lds, int bid, int G, int tid) {
    LAS int* tab = (LAS int*)(lds + 131072);
    moe_tables(a, layer, tab, tid);
    pg8::Gemm g{(const bf16_t*)(a.ws + WS_XROWS), (const bf16_t*)(a.ws + WS_XB1), D, D};
    pg8::GroupedOrder S{tab + 64, tab[32], G, bid, D, D, (size_t)1024 * 1024 * 2};
    pg8::EpiSwiGLU E{(bf16_t*)(a.ws + WS_HID)};
    pg8::gemm_phase(lds, g, S, E);
}
__device__ __forceinline__ void moe_gemm2(const Args& a, int layer, LAS unsigned char* lds, int bid, int G, int tid) {
    LAS int* tab = (LAS int*)(lds + 131072);
    moe_tables(a, layer, tab, tid);
    pg8::Gemm g{(const bf16_t*)(a.ws + WS_HID), (const bf16_t*)(a.ws + WS_XB2), DEXP, DEXP};
    pg8::GroupedOrder S{tab + 64, tab[32], G, bid, DEXP, DEXP, (size_t)1024 * 512 * 2};
    pg8::EpiBf16 E{(bf16_t*)(a.ws + WS_XROWS), D};
    pg8::gemm_phase(lds, g, S, E);
}
template <bool NORM>
__device__ __forceinline__ void moe_combine(const Args& a, const float* gain, bf16_t* hout, int gw, int ngw, int lane) {
    const bf16_t* y = (const bf16_t*)(a.ws + WS_XROWS);
    const int* RP = (const int*)(a.ws + WS_RP); const float* RG = (const float*)(a.ws + WS_RG);
    f32x4 gn[4];
    if (NORM) {
#pragma unroll
        for (int j = 0; j < 4; ++j) gn[j] = *((const f32x4*)gain + lane + 64 * j);
    }
    for (int t = gw; t < T; t += ngw) {
        const int p0 = RP[(size_t)t * 2], p1 = RP[(size_t)t * 2 + 1]; const float g0 = RG[(size_t)t * 2], g1 = RG[(size_t)t * 2 + 1];
        f32x4* xr = (f32x4*)(a.out + (size_t)t * D) + lane;
        const u32x2* y0 = (const u32x2*)(y + (size_t)p0 * D) + lane; const u32x2* y1 = (const u32x2*)(y + (size_t)p1 * D) + lane;
        f32x4 v[4]; float s = 0.f;
#pragma unroll
        for (int j = 0; j < 4; ++j) { v[j] = xr[64 * j]; const u32x2 a0 = y0[64 * j], a1 = y1[64 * j];
            v[j][0] += g0 * lo_bf(a0.x) + g1 * lo_bf(a1.x); v[j][1] += g0 * hi_bf(a0.x) + g1 * hi_bf(a1.x); v[j][2] += g0 * lo_bf(a0.y) + g1 * lo_bf(a1.y); v[j][3] += g0 * hi_bf(a0.y) + g1 * hi_bf(a1.y);
            xr[64 * j] = v[j]; s += (v[j][0] * v[j][0] + v[j][1] * v[j][1]) + (v[j][2] * v[j][2] + v[j][3] * v[j][3]); }
        if (NORM) {
            const float rstd = rsqrtf(wave_sum(s) * (1.f / D) + EPS);
            unsigned long long* o8 = (unsigned long long*)(hout + (size_t)t * D) + lane;
#pragma unroll
            for (int j = 0; j < 4; ++j) { const f32x4 w = v[j] * rstd * gn[j]; o8[64 * j] = (unsigned long long)cvt_pk_bf16(w[0], w[1]) | ((unsigned long long)cvt_pk_bf16(w[2], w[3]) << 32); }
        }
    }
}


__device__ __forceinline__ void ck_add(const void* p, size_t bytes, unsigned* dst, int gthread, int nthread) {
    const u32x4* q = (const u32x4*)p; const size_t n = bytes / 16; unsigned acc = 0u;
    for (size_t i = gthread; i < n; i += nthread) { const u32x4 v = q[i]; acc += v.x + v.y * 3u + v.z * 5u + v.w * 7u + (unsigned)i * 0x9E3779B1u * (v.x ^ v.w); }
#pragma unroll
    for (int o = 1; o < 64; o <<= 1) acc += __shfl_xor(acc, o);
    if ((threadIdx.x & 63) == 0) atomicAdd(dst, acc);
}
constexpr int NPHASE = 20;
#ifndef PHHI
#define PHHI NPHASE
#endif
#define CKB(off, bytes) ck_add(ws + (off), (size_t)(bytes), ckd, bid * NTHREADS + tid, G * NTHREADS)

__global__ void __launch_bounds__(NTHREADS, 2) fwd_kernel(Args args) {
    extern __shared__ __attribute__((aligned(16))) unsigned char lds_raw[];
    LAS unsigned char* lds = (LAS unsigned char*)lds_raw;
    const int tid = threadIdx.x, lane = tid & 63, wave = __builtin_amdgcn_readfirstlane(tid >> 6);
    const int G = gridDim.x, bid = blockIdx.x;
    const int gw = bid * NWAVES + wave, ngw = G * NWAVES;
    unsigned char* ws = args.ws;
    const int lo = args.ph_lo, hi = args.ph_hi;
    cg::grid_group grid = cg::this_grid();
    if (tid < 4) ((LAS unsigned*)(lds + LDS_BYTES - 16))[tid] = 0u;
    __syncthreads();
    const XcdBarrier xbar = xcd_barrier_post((unsigned*)(ws + WS_CTL) + 1024, (volatile LAS unsigned*)(lds + LDS_BYTES - 16));
#ifndef ONLYP
#define ONLYP -1
#endif
#define IN(k) ((ONLYP < 0 || ONLYP == (k)) && lo <= (k) && (k) < hi)
#ifndef SKIPLO
#define SKIPLO 100
#define SKIPHI 100
#endif
#define RUN(k) (IN(k) && !((k) >= SKIPLO && (k) <= SKIPHI))
#define SEAM(k) do { if (IN(k) && IN((k) + 1)) { if ((k) == 0) { asm volatile("s_waitcnt vmcnt(0)" ::: "memory"); grid.sync(); __builtin_amdgcn_fence(__ATOMIC_ACQUIRE, "agent"); asm volatile("s_waitcnt vmcnt(0)" ::: "memory"); __syncthreads(); } else xcd_barrier(xbar); } else __syncthreads(); } while (0)

    if (RUN(0)) {
        LAS float* scr = (LAS float*)(lds + wave * 8448);
        {
            constexpr int I0 = (D / 64) * (N0 / 32), I1 = (D / 64) * (D / 32), I2 = (D / 64) * (ODD_IN / 32), I3 = (2048 / 64) * (D / 32);
            for (int it = gw; it < I0 + I1 + I2 + I3; it += ngw) {
                int r = it;
                if (r < I0) { transpose_item(args.in[I_WINE], D, EVEN_IN, N0, (bf16_t*)(ws + WS_WIN0), 0, scr, r, lane); continue; } r -= I0;
                if (r < I1) { transpose_item(args.in[I_WOUTE], D, D, D, (bf16_t*)(ws + WS_WOUT0), 0, scr, r, lane); continue; } r -= I1;
                if (r < I2) { transpose_item(args.in[I_WINO], D, ODD_IN, ODD_IN, (bf16_t*)(ws + WS_WIN1), 0, scr, r, lane); continue; } r -= I2;
                transpose_item(args.in[I_WOUTO], 2048, D, D, (bf16_t*)(ws + WS_WOUT1), 0, scr, r, lane);
            }
        }
        convert_moe(args, 0, scr, gw, ngw, lane);
        LAS float* wab = (LAS float*)(lds + 72 * 1024);
        __syncthreads();
        for (int i = tid; i < 8 * 1024; i += NTHREADS) { const int k = i >> 3, o = i & 7; wab[o * 1024 + k] = args.in[I_WINE][(size_t)k * EVEN_IN + N0 + o]; }
        __syncthreads();
        const float* x = args.in[I_X]; const float* gain = args.in[I_LNE];
        bf16_t* h0 = (bf16_t*)(ws + WS_HMIX0); float* bab = (float*)(ws + WS_BAB);
        f32x4 gn[4];
#pragma unroll
        for (int j = 0; j < 4; ++j) gn[j] = *((const f32x4*)gain + lane + 64 * j);
        for (int m = gw; m < T; m += ngw) {
            const f32x4* xr = (const f32x4*)(x + (size_t)m * D) + lane;
            f32x4 v[4]; float s = 0.f;
#pragma unroll
            for (int j = 0; j < 4; ++j) { v[j] = xr[64 * j]; s += (v[j][0] * v[j][0] + v[j][1] * v[j][1]) + (v[j][2] * v[j][2] + v[j][3] * v[j][3]); }
            const float rstd = rsqrtf(wave_sum(s) * (1.f / D) + EPS);
            float p[8];
#pragma unroll
            for (int o = 0; o < 8; ++o) p[o] = 0.f;
            unsigned long long* o8 = (unsigned long long*)(h0 + (size_t)m * D) + lane;
#pragma unroll
            for (int j = 0; j < 4; ++j) { v[j] = v[j] * rstd * gn[j];
                o8[64 * j] = (unsigned long long)cvt_pk_bf16(v[j][0], v[j][1]) | ((unsigned long long)cvt_pk_bf16(v[j][2], v[j][3]) << 32);
#pragma unroll
                for (int o = 0; o < 8; ++o) { const f32x4 w = *((const LAS f32x4*)(wab + o * 1024) + lane + 64 * j); p[o] += (v[j][0] * w[0] + v[j][1] * w[1]) + (v[j][2] * w[2] + v[j][3] * w[3]); } }
#pragma unroll
            for (int o = 0; o < 8; ++o) p[o] = wave_sum(p[o]);
            if (lane == 0) { *(f32x4*)(bab + (size_t)m * 8) = (f32x4){p[0], p[1], p[2], p[3]}; *(f32x4*)(bab + (size_t)m * 8 + 4) = (f32x4){p[4], p[5], p[6], p[7]}; }
        }
    }
    SEAM(0);

    if (RUN(1)) {
        pg8::Gemm g{(const bf16_t*)(ws + WS_HMIX0), (const bf16_t*)(ws + WS_WIN0), D, D};
        pg8::DenseOrder S; S.init(T, N0, G, bid, D, D);
        pg8::EpiBf16 E{(bf16_t*)(ws + WS_PROJ0), N0};
        pg8::gemm_phase(lds, g, S, E);
    }
    SEAM(1);

    if (RUN(2)) {
        const bf16_t* proj0 = (const bf16_t*)(ws + WS_PROJ0);
        const float* bab = (const float*)(ws + WS_BAB);
        const float* convw = args.in[I_CONVW];
        bf16_t* gUT = (bf16_t*)(ws + WS_GU); bf16_t* gW = (bf16_t*)(ws + WS_GW); bf16_t* gQD = (bf16_t*)(ws + WS_GQD); bf16_t* gKDT = (bf16_t*)(ws + WS_GKDT); bf16_t* gA = (bf16_t*)(ws + WS_GA);
        float* gGL = (float*)(ws + WS_GL);
        LAS bf16_t* Kb = (LAS bf16_t*)(lds);
        LAS bf16_t* Qb = (LAS bf16_t*)(lds + 17408);
        LAS float* Rm = (LAS float*)(lds + 34816);
        LAS float* Lm = (LAS float*)(lds + 100352);
        LAS float* gcs = (LAS float*)(lds + 116736);
        LAS float* bts = gcs + 64;
        const int fr = lane & 15, fq = lane >> 4;
        for (int item = bid; item < 2048; item += G) {
            const int b = item >> 8, n = (item >> 2) & 63, h = item & 3;
            const int t0 = b * SEQ + n * 64;
            if (wave == 0) {
                const int t = t0 + lane;
                const float a = bab[(size_t)t * 8 + h] + args.in[I_DTB][h], bb = bab[(size_t)t * 8 + 4 + h];
                const float sp = fmaxf(a, 0.f) + log1pf(__expf(-fabsf(a)));
                float gv = -__expf(args.in[I_ALOG][h]) * sp;
#pragma unroll
                for (int o = 1; o < 64; o <<= 1) { const float y = __shfl_up(gv, o); if (lane >= o) gv += y; }
                gcs[lane] = gv; bts[lane] = sigmoid_f(bb);
            }
            __syncthreads();
            {
                const int r = tid >> 3, d0 = (tid & 7) * 16;
                const float gc = gcs[r], beta = bts[r], glast = gcs[63];
                float qkv[3][16];
#pragma unroll
                for (int p = 0; p < 3; ++p) {
                    const int col = 768 + p * 512 + h * 128 + d0, wc0 = p * 512 + h * 128 + d0;
                    float acc[16];
#pragma unroll
                    for (int d = 0; d < 16; ++d) acc[d] = 0.f;
#pragma unroll
                    for (int j = 0; j < 4; ++j) {
                        const int srow = n * 64 + r - 3 + j;
                        if (srow >= 0) {
                            const u32x4* px = (const u32x4*)(proj0 + (size_t)(b * SEQ + srow) * N0 + col);
                            const u32x4 x0 = px[0], x1 = px[1];
                            const f32x4* pw = (const f32x4*)(convw + j * 1536 + wc0);
                            const f32x4 w0 = pw[0], w1 = pw[1], w2 = pw[2], w3 = pw[3];
                            acc[0] += w0[0] * lo_bf(x0.x); acc[1] += w0[1] * hi_bf(x0.x); acc[2] += w0[2] * lo_bf(x0.y); acc[3] += w0[3] * hi_bf(x0.y);
                            acc[4] += w1[0] * lo_bf(x0.z); acc[5] += w1[1] * hi_bf(x0.z); acc[6] += w1[2] * lo_bf(x0.w); acc[7] += w1[3] * hi_bf(x0.w);
                            acc[8] += w2[0] * lo_bf(x1.x); acc[9] += w2[1] * hi_bf(x1.x); acc[10] += w2[2] * lo_bf(x1.y); acc[11] += w2[3] * hi_bf(x1.y);
                            acc[12] += w3[0] * lo_bf(x1.z); acc[13] += w3[1] * hi_bf(x1.z); acc[14] += w3[2] * lo_bf(x1.w); acc[15] += w3[3] * hi_bf(x1.w);
                        }
                    }
#pragma unroll
                    for (int d = 0; d < 16; ++d) qkv[p][d] = silu_f(acc[d]);
                }
                float sq = 0.f, sk = 0.f;
#pragma unroll
                for (int d = 0; d < 16; ++d) { sq += qkv[0][d] * qkv[0][d]; sk += qkv[1][d] * qkv[1][d]; }
                sq += __shfl_xor(sq, 1); sq += __shfl_xor(sq, 2); sq += __shfl_xor(sq, 4);
                sk += __shfl_xor(sk, 1); sk += __shfl_xor(sk, 2); sk += __shfl_xor(sk, 4);
                const float qinv = rsqrtf(sq + EPS) * 0.08838834764831845f, kinv = rsqrtf(sk + EPS);
                const float eg = __expf(gc), ekd = __expf(glast - gc);
                u32x4 kw0, kw1, qw0, qw1, qd0, qd1;
                float kk[16], qq[16];
#pragma unroll
                for (int d = 0; d < 16; ++d) { kk[d] = qkv[1][d] * kinv; qq[d] = qkv[0][d] * qinv; }
                kw0.x = cvt_pk_bf16(kk[0], kk[1]); kw0.y = cvt_pk_bf16(kk[2], kk[3]); kw0.z = cvt_pk_bf16(kk[4], kk[5]); kw0.w = cvt_pk_bf16(kk[6], kk[7]);
                kw1.x = cvt_pk_bf16(kk[8], kk[9]); kw1.y = cvt_pk_bf16(kk[10], kk[11]); kw1.z = cvt_pk_bf16(kk[12], kk[13]); kw1.w = cvt_pk_bf16(kk[14], kk[15]);
                qw0.x = cvt_pk_bf16(qq[0], qq[1]); qw0.y = cvt_pk_bf16(qq[2], qq[3]); qw0.z = cvt_pk_bf16(qq[4], qq[5]); qw0.w = cvt_pk_bf16(qq[6], qq[7]);
                qw1.x = cvt_pk_bf16(qq[8], qq[9]); qw1.y = cvt_pk_bf16(qq[10], qq[11]); qw1.z = cvt_pk_bf16(qq[12], qq[13]); qw1.w = cvt_pk_bf16(qq[14], qq[15]);
                *(LAS u32x4*)(Kb + r * 136 + d0) = kw0; *(LAS u32x4*)(Kb + r * 136 + d0 + 8) = kw1;
                *(LAS u32x4*)(Qb + r * 136 + d0) = qw0; *(LAS u32x4*)(Qb + r * 136 + d0 + 8) = qw1;
#pragma unroll
                for (int d4 = 0; d4 < 4; ++d4) {
                    *(LAS f32x4*)(Rm + r * 256 + d0 + 4 * d4) = (f32x4){qkv[2][4 * d4] * beta, qkv[2][4 * d4 + 1] * beta, qkv[2][4 * d4 + 2] * beta, qkv[2][4 * d4 + 3] * beta};
                    const float bs = beta * eg;
                    *(LAS f32x4*)(Rm + r * 256 + 128 + d0 + 4 * d4) = (f32x4){kk[4 * d4] * bs, kk[4 * d4 + 1] * bs, kk[4 * d4 + 2] * bs, kk[4 * d4 + 3] * bs};
                }
                qd0.x = cvt_pk_bf16(qq[0] * eg, qq[1] * eg); qd0.y = cvt_pk_bf16(qq[2] * eg, qq[3] * eg); qd0.z = cvt_pk_bf16(qq[4] * eg, qq[5] * eg); qd0.w = cvt_pk_bf16(qq[6] * eg, qq[7] * eg);
                qd1.x = cvt_pk_bf16(qq[8] * eg, qq[9] * eg); qd1.y = cvt_pk_bf16(qq[10] * eg, qq[11] * eg); qd1.z = cvt_pk_bf16(qq[12] * eg, qq[13] * eg); qd1.w = cvt_pk_bf16(qq[14] * eg, qq[15] * eg);
                u32x4* pqd = (u32x4*)(gQD + ((size_t)item * 64 + r) * 128 + d0); pqd[0] = qd0; pqd[1] = qd1;
#pragma unroll
                for (int d = 0; d < 16; ++d) gKDT[((size_t)item * 128 + d0 + d) * 64 + r] = f2bf(kk[d] * ekd);
                if (tid == 0) gGL[(size_t)item * 32] = __expf(glast);
            }
            __syncthreads();
            {
                const int which = wave >> 2, mt = wave & 3;
                const LAS bf16_t* X = which ? Qb : Kb;
                for (int nt = 0; nt < 4; ++nt) {
                    f32x4 acc = (f32x4){0.f, 0.f, 0.f, 0.f};
                    if (nt <= mt) {
#pragma unroll
                        for (int s = 0; s < 4; ++s) {
                            const bf16x8 af = *(const LAS bf16x8*)(X + (16 * mt + fr) * 136 + 32 * s + 8 * fq);
                            const bf16x8 bfr = *(const LAS bf16x8*)(Kb + (16 * nt + fr) * 136 + 32 * s + 8 * fq);
                            acc = mfma16(af, bfr, acc);
                        }
                    }
                    const int j = 16 * nt + fr; const float gj = gcs[j];
#pragma unroll
                    for (int rg = 0; rg < 4; ++rg) {
                        const int i = 16 * mt + 4 * fq + rg;
                        const float dec = __expf(fminf(gcs[i] - gj, 0.f));
                        if (which == 0) Lm[i * 64 + j] = (i > j) ? bts[i] * acc[rg] * dec : 0.f;
                        else gA[((size_t)item * 64 + i) * 64 + j] = f2bf((i >= j) ? acc[rg] * dec : 0.f);
                    }
                }
            }
            __syncthreads();
            if (tid < 256) {
                const int c = tid;
                int vz = 0; asm volatile("" : "+v"(vz));
                const LAS float* Lv = Lm + vz;
                float U[64];
#pragma unroll
                for (int i = 0; i < 64; ++i) {
                    float s = Rm[i * 256 + c];
#pragma unroll
                    for (int j = 0; j < i; ++j) s -= Lv[i * 64 + j] * U[j];
                    U[i] = s;
                }
                if (c < 128) {
                    u32x4* pu = (u32x4*)(gUT + ((size_t)item * 128 + c) * 64);
#pragma unroll
                    for (int i8 = 0; i8 < 8; ++i8) { u32x4 o; o.x = cvt_pk_bf16(U[8 * i8], U[8 * i8 + 1]); o.y = cvt_pk_bf16(U[8 * i8 + 2], U[8 * i8 + 3]); o.z = cvt_pk_bf16(U[8 * i8 + 4], U[8 * i8 + 5]); o.w = cvt_pk_bf16(U[8 * i8 + 6], U[8 * i8 + 7]); pu[i8] = o; }
                } else {
#pragma unroll
                    for (int i = 0; i < 64; ++i) gW[((size_t)item * 64 + i) * 128 + (c - 128)] = f2bf(U[i]);
                }
            }
            __syncthreads();
        }
    }
    SEAM(2);

    if (RUN(3)) {
        const bf16_t* proj0 = (const bf16_t*)(ws + WS_PROJ0);
        bf16_t* mix0 = (bf16_t*)(ws + WS_HMIX0);
        const int fr = lane & 15, fq = lane >> 4;
        if (bid < 32) {
            const bf16_t* gUT = (const bf16_t*)(ws + WS_GU); const bf16_t* gW = (const bf16_t*)(ws + WS_GW); const bf16_t* gQD = (const bf16_t*)(ws + WS_GQD); const bf16_t* gKDT = (const bf16_t*)(ws + WS_GKDT); const bf16_t* gA = (const bf16_t*)(ws + WS_GA);
            const float* gGL = (const float*)(ws + WS_GL);
            const int b = bid >> 2, h = bid & 3;
            constexpr int BUFB = 62464;
            LAS bf16_t* Obuf = (LAS bf16_t*)(lds + 2 * BUFB);
            LAS float* part = (LAS float*)(lds + 2 * BUFB + 17408);
            const int wrow0 = tid >> 4, wch = tid & 15;
            const int krow0 = tid >> 3, kch = tid & 7;
            u32x4 pw[2], pq[2], pk[2], pa; u32x2 pu[4]; u32x4 pz0, pz1;
            f32x4 Sacc[8];
#pragma unroll
            for (int k = 0; k < 8; ++k) Sacc[k] = (f32x4){0.f, 0.f, 0.f, 0.f};
            f32x4 gn[4];
#pragma unroll
            for (int j = 0; j < 4; ++j) gn[j] = *(const f32x4*)(args.in[I_GDNG] + (tid & 7) * 16 + 4 * j);
#define GDN_LOAD(itm) do { const size_t _it = (size_t)(itm); \
                pw[0] = *(const u32x4*)(gW + (_it * 64 + wrow0) * 128 + wch * 8); pw[1] = *(const u32x4*)(gW + (_it * 64 + wrow0 + 32) * 128 + wch * 8); \
                pq[0] = *(const u32x4*)(gQD + (_it * 64 + wrow0) * 128 + wch * 8); pq[1] = *(const u32x4*)(gQD + (_it * 64 + wrow0 + 32) * 128 + wch * 8); \
                pk[0] = *(const u32x4*)(gKDT + (_it * 128 + krow0) * 64 + kch * 8); pk[1] = *(const u32x4*)(gKDT + (_it * 128 + krow0 + 64) * 64 + kch * 8); \
                pa = *(const u32x4*)(gA + (_it * 64 + krow0) * 64 + kch * 8); } while (0)
#define GDN_STORE(bufi) do { LAS bf16_t* _W = (LAS bf16_t*)(lds + (bufi) * BUFB); LAS bf16_t* _Q = _W + 64 * 136; LAS bf16_t* _K = _Q + 64 * 136; LAS bf16_t* _A = _K + 128 * 72; \
                *(LAS u32x4*)(_W + wrow0 * 136 + wch * 8) = pw[0]; *(LAS u32x4*)(_W + (wrow0 + 32) * 136 + wch * 8) = pw[1]; \
                *(LAS u32x4*)(_Q + wrow0 * 136 + wch * 8) = pq[0]; *(LAS u32x4*)(_Q + (wrow0 + 32) * 136 + wch * 8) = pq[1]; \
                *(LAS u32x4*)(_K + krow0 * 72 + kch * 8) = pk[0]; *(LAS u32x4*)(_K + (krow0 + 64) * 72 + kch * 8) = pk[1]; \
                *(LAS u32x4*)(_A + krow0 * 72 + kch * 8) = pa; } while (0)
            GDN_LOAD((b * 64 + 0) * 4 + h); GDN_STORE(0);
            __syncthreads();
            for (int n = 0; n < 64; ++n) {
                const int item = (b * 64 + n) * 4 + h, cur = n & 1;
                const int t0 = b * SEQ + n * 64;
                const LAS bf16_t* Wl = (const LAS bf16_t*)(lds + cur * BUFB); const LAS bf16_t* Ql = Wl + 64 * 136; const LAS bf16_t* Kl = Ql + 64 * 136; const LAS bf16_t* Al = Kl + 128 * 72;
                if (n + 1 < 64) GDN_LOAD(item + 4);
#pragma unroll
                for (int mt = 0; mt < 4; ++mt) pu[mt] = *(const u32x2*)(gUT + ((size_t)item * 128 + 16 * wave + fr) * 64 + 16 * mt + 4 * fq);
                { const u32x4* pz = (const u32x4*)(proj0 + (size_t)(t0 + (tid >> 3)) * N0 + 2304 + h * 128 + (tid & 7) * 16); pz0 = pz[0]; pz1 = pz[1]; }
                const float glv = gGL[(size_t)item * 32];
                bf16x8 Sb[4];
#pragma unroll
                for (int s = 0; s < 4; ++s) Sb[s] = mk8f(Sacc[2 * s], Sacc[2 * s + 1]);
                f32x4 WS[4], QS[4];
#pragma unroll
                for (int mt = 0; mt < 4; ++mt) { WS[mt] = (f32x4){0.f, 0.f, 0.f, 0.f}; QS[mt] = (f32x4){0.f, 0.f, 0.f, 0.f};
#pragma unroll
                    for (int s = 0; s < 4; ++s) {
                        const LAS bf16_t* pwf = Wl + (16 * mt + fr) * 136 + 32 * s + 4 * fq;
                        WS[mt] = mfma16(mk8(*(const LAS u32x2*)pwf, *(const LAS u32x2*)(pwf + 16)), Sb[s], WS[mt]);
                        const LAS bf16_t* pqf = Ql + (16 * mt + fr) * 136 + 32 * s + 4 * fq;
                        QS[mt] = mfma16(mk8(*(const LAS u32x2*)pqf, *(const LAS u32x2*)(pqf + 16)), Sb[s], QS[mt]);
                    } }
                f32x4 vn[4];
#pragma unroll
                for (int mt = 0; mt < 4; ++mt) { vn[mt][0] = lo_bf(pu[mt].x) - WS[mt][0]; vn[mt][1] = hi_bf(pu[mt].x) - WS[mt][1]; vn[mt][2] = lo_bf(pu[mt].y) - WS[mt][2]; vn[mt][3] = hi_bf(pu[mt].y) - WS[mt][3]; }
                bf16x8 Vb[2];
                Vb[0] = mk8f(vn[0], vn[1]); Vb[1] = mk8f(vn[2], vn[3]);
#pragma unroll
                for (int mt = 0; mt < 4; ++mt)
#pragma unroll
                    for (int s2 = 0; s2 < 2; ++s2) { const LAS bf16_t* paf = Al + (16 * mt + fr) * 72 + 32 * s2 + 4 * fq;
                        QS[mt] = mfma16(mk8(*(const LAS u32x2*)paf, *(const LAS u32x2*)(paf + 16)), Vb[s2], QS[mt]); }
#pragma unroll
                for (int kt = 0; kt < 8; ++kt) { Sacc[kt] = Sacc[kt] * glv;
#pragma unroll
                    for (int s2 = 0; s2 < 2; ++s2) { const LAS bf16_t* pkf = Kl + (16 * kt + fr) * 72 + 32 * s2 + 4 * fq;
                        Sacc[kt] = mfma16(mk8(*(const LAS u32x2*)pkf, *(const LAS u32x2*)(pkf + 16)), Vb[s2], Sacc[kt]); } }
#pragma unroll
                for (int mt = 0; mt < 4; ++mt)
#pragma unroll
                    for (int rg = 0; rg < 4; ++rg) { const int row = 16 * mt + 4 * fq + rg; const float v = QS[mt][rg]; float sq = v * v;
                        sq += __shfl_xor(sq, 1); sq += __shfl_xor(sq, 2); sq += __shfl_xor(sq, 4); sq += __shfl_xor(sq, 8);
                        if (fr == 0) part[wave * 64 + row] = sq;
                        Obuf[row * 136 + 16 * wave + fr] = f2bf(v); }
                if (n + 1 < 64) GDN_STORE(cur ^ 1);
                __syncthreads();
                {
                    const int r = tid >> 3, c0 = (tid & 7) * 16;
                    float ss = 0.f;
#pragma unroll
                    for (int w = 0; w < 8; ++w) ss += part[w * 64 + r];
                    const float rstd = rsqrtf(ss * (1.f / 128.f) + EPS);
                    const u32x4 o0 = *(const LAS u32x4*)(Obuf + r * 136 + c0), o1 = *(const LAS u32x4*)(Obuf + r * 136 + c0 + 8);
                    float ov[16], zv[16];
                    ov[0] = lo_bf(o0.x); ov[1] = hi_bf(o0.x); ov[2] = lo_bf(o0.y); ov[3] = hi_bf(o0.y); ov[4] = lo_bf(o0.z); ov[5] = hi_bf(o0.z); ov[6] = lo_bf(o0.w); ov[7] = hi_bf(o0.w);
                    ov[8] = lo_bf(o1.x); ov[9] = hi_bf(o1.x); ov[10] = lo_bf(o1.y); ov[11] = hi_bf(o1.y); ov[12] = lo_bf(o1.z); ov[13] = hi_bf(o1.z); ov[14] = lo_bf(o1.w); ov[15] = hi_bf(o1.w);
                    zv[0] = lo_bf(pz0.x); zv[1] = hi_bf(pz0.x); zv[2] = lo_bf(pz0.y); zv[3] = hi_bf(pz0.y); zv[4] = lo_bf(pz0.z); zv[5] = hi_bf(pz0.z); zv[6] = lo_bf(pz0.w); zv[7] = hi_bf(pz0.w);
                    zv[8] = lo_bf(pz1.x); zv[9] = hi_bf(pz1.x); zv[10] = lo_bf(pz1.y); zv[11] = hi_bf(pz1.y); zv[12] = lo_bf(pz1.z); zv[13] = hi_bf(pz1.z); zv[14] = lo_bf(pz1.w); zv[15] = hi_bf(pz1.w);
#pragma unroll
                    for (int d = 0; d < 16; ++d) ov[d] = ov[d] * rstd * gn[d >> 2][d & 3] * silu_f(zv[d]);
                    u32x4 w0, w1;
                    w0.x = cvt_pk_bf16(ov[0], ov[1]); w0.y = cvt_pk_bf16(ov[2], ov[3]); w0.z = cvt_pk_bf16(ov[4], ov[5]); w0.w = cvt_pk_bf16(ov[6], ov[7]);
                    w1.x = cvt_pk_bf16(ov[8], ov[9]); w1.y = cvt_pk_bf16(ov[10], ov[11]); w1.z = cvt_pk_bf16(ov[12], ov[13]); w1.w = cvt_pk_bf16(ov[14], ov[15]);
                    u32x4* po = (u32x4*)(mix0 + (size_t)(t0 + r) * D + 512 + h * 128 + c0); po[0] = w0; po[1] = w1;
                }
                __syncthreads();
            }
#undef GDN_LOAD
#undef GDN_STORE
        } else {
            LAS bf16_t* Ks = (LAS bf16_t*)(lds);
            LAS bf16_t* Vt = (LAS bf16_t*)(lds + 27648);
            const float* qgain = args.in[I_QG]; const float* kgain = args.in[I_KG];
            const int nbk = G - 32;
            for (int it = bid - 32; it < 1024; it += nbk) {
                const int b = it >> 7, qb = (it >> 1) & 63, hk = it & 1;
                const int t0 = b * SEQ + qb * 64;
                __syncthreads();
#pragma unroll
                for (int i3 = 0; i3 < 3; ++i3) {
                    const int task = tid + NTHREADS * i3, key = task >> 3, dg = task & 7;
                    const int kp = qb * 64 - 128 + key;
                    u32x4 kr = (u32x4){0u, 0u, 0u, 0u}, vr = (u32x4){0u, 0u, 0u, 0u};
                    if (kp >= 0) { const bf16_t* pr = proj0 + (size_t)(b * SEQ + kp) * N0 + hk * 64 + 8 * dg; kr = *(const u32x4*)(pr + 512); vr = *(const u32x4*)(pr + 640); }
                    float kv[8];
                    kv[0] = lo_bf(kr.x); kv[1] = hi_bf(kr.x); kv[2] = lo_bf(kr.y); kv[3] = hi_bf(kr.y); kv[4] = lo_bf(kr.z); kv[5] = hi_bf(kr.z); kv[6] = lo_bf(kr.w); kv[7] = hi_bf(kr.w);
                    float ss = 0.f;
#pragma unroll
                    for (int i = 0; i < 8; ++i) ss += kv[i] * kv[i];
                    ss += __shfl_xor(ss, 1); ss += __shfl_xor(ss, 2); ss += __shfl_xor(ss, 4);
                    const float rstd = rsqrtf(ss * (1.f / 64.f) + EPS);
                    const f32x4 g0 = *(const f32x4*)(kgain + 8 * dg), g1 = *(const f32x4*)(kgain + 8 * dg + 4);
                    kv[0] *= rstd * g0[0]; kv[1] *= rstd * g0[1]; kv[2] *= rstd * g0[2]; kv[3] *= rstd * g0[3]; kv[4] *= rstd * g1[0]; kv[5] *= rstd * g1[1]; kv[6] *= rstd * g1[2]; kv[7] *= rstd * g1[3];
                    float pv[8];
#pragma unroll
                    for (int i = 0; i < 8; ++i) pv[i] = __shfl_xor(kv[i], 1);
                    if (dg < 2) {
#pragma unroll
                        for (int i = 0; i < 8; ++i) { float sn, cs; sincos_rev((float)kp * exp2f(-2.36644607f * (float)i), sn, cs);
                            kv[i] = (dg == 0) ? (kv[i] * cs - pv[i] * sn) : (kv[i] * cs + pv[i] * sn); }
                    }
                    u32x4 kw; kw.x = cvt_pk_bf16(kv[0], kv[1]); kw.y = cvt_pk_bf16(kv[2], kv[3]); kw.z = cvt_pk_bf16(kv[4], kv[5]); kw.w = cvt_pk_bf16(kv[6], kv[7]);
                    *(LAS u32x4*)(Ks + key * 72 + 8 * dg) = kw;
                    Vt[(8 * dg + 0) * 200 + key] = (bf16_t)(vr.x & 0xffffu); Vt[(8 * dg + 1) * 200 + key] = (bf16_t)(vr.x >> 16);
                    Vt[(8 * dg + 2) * 200 + key] = (bf16_t)(vr.y & 0xffffu); Vt[(8 * dg + 3) * 200 + key] = (bf16_t)(vr.y >> 16);
                    Vt[(8 * dg + 4) * 200 + key] = (bf16_t)(vr.z & 0xffffu); Vt[(8 * dg + 5) * 200 + key] = (bf16_t)(vr.z >> 16);
                    Vt[(8 * dg + 6) * 200 + key] = (bf16_t)(vr.w & 0xffffu); Vt[(8 * dg + 7) * 200 + key] = (bf16_t)(vr.w >> 16);
                }
                __syncthreads();
                const int g = wave >> 1, qs = wave & 1, hq = hk * 4 + g;
                const float sinkv = args.in[I_SINK][hq];
#pragma unroll
                for (int j2 = 0; j2 < 2; ++j2) {
                    const int qrow = 32 * qs + 16 * j2 + fr;
                    const int tq = t0 + qrow, qpos = qb * 64 + qrow;
                    bf16x8 Qf[2];
                    {
                        const u32x4 r0 = *(const u32x4*)(proj0 + (size_t)tq * N0 + hq * 64 + 8 * fq), r1 = *(const u32x4*)(proj0 + (size_t)tq * N0 + hq * 64 + 32 + 8 * fq);
                        float q0[8], q1[8];
                        q0[0] = lo_bf(r0.x); q0[1] = hi_bf(r0.x); q0[2] = lo_bf(r0.y); q0[3] = hi_bf(r0.y); q0[4] = lo_bf(r0.z); q0[5] = hi_bf(r0.z); q0[6] = lo_bf(r0.w); q0[7] = hi_bf(r0.w);
                        q1[0] = lo_bf(r1.x); q1[1] = hi_bf(r1.x); q1[2] = lo_bf(r1.y); q1[3] = hi_bf(r1.y); q1[4] = lo_bf(r1.z); q1[5] = hi_bf(r1.z); q1[6] = lo_bf(r1.w); q1[7] = hi_bf(r1.w);
                        float ss = 0.f;
#pragma unroll
                        for (int i = 0; i < 8; ++i) ss += q0[i] * q0[i] + q1[i] * q1[i];
                        ss += __shfl_xor(ss, 16); ss += __shfl_xor(ss, 32);
                        const float rstd = rsqrtf(ss * (1.f / 64.f) + EPS) * 0.125f;
#pragma unroll
                        for (int i = 0; i < 8; ++i) { q0[i] *= rstd * qgain[8 * fq + i]; q1[i] *= rstd * qgain[32 + 8 * fq + i]; }
                        float pv[8];
#pragma unroll
                        for (int i = 0; i < 8; ++i) pv[i] = __shfl_xor(q0[i], 16);
                        if (fq < 2) {
#pragma unroll
                            for (int i = 0; i < 8; ++i) { float sn, cs; sincos_rev((float)qpos * exp2f(-2.36644607f * (float)i), sn, cs);
                                q0[i] = (fq == 0) ? (q0[i] * cs - pv[i] * sn) : (q0[i] * cs + pv[i] * sn); }
                        }
                        u32x4 w0, w1;
                        w0.x = cvt_pk_bf16(q0[0], q0[1]); w0.y = cvt_pk_bf16(q0[2], q0[3]); w0.z = cvt_pk_bf16(q0[4], q0[5]); w0.w = cvt_pk_bf16(q0[6], q0[7]);
                        w1.x = cvt_pk_bf16(q1[0], q1[1]); w1.y = cvt_pk_bf16(q1[2], q1[3]); w1.z = cvt_pk_bf16(q1[4], q1[5]); w1.w = cvt_pk_bf16(q1[6], q1[7]);
                        Qf[0] = __builtin_bit_cast(bf16x8, w0); Qf[1] = __builtin_bit_cast(bf16x8, w1);
                    }
                    float mrun = sinkv, lrun = (fq == 0) ? 1.f : 0.f;
                    f32x4 Oa[4];
#pragma unroll
                    for (int dt = 0; dt < 4; ++dt) Oa[dt] = (f32x4){0.f, 0.f, 0.f, 0.f};
#pragma unroll
                    for (int kt = 0; kt < 3; ++kt) {
                        f32x4 sc[4];
                        float tmax = -1e30f;
#pragma unroll
                        for (int mt = 0; mt < 4; ++mt) { sc[mt] = (f32x4){0.f, 0.f, 0.f, 0.f};
#pragma unroll
                            for (int s = 0; s < 2; ++s) sc[mt] = mfma16(*(const LAS bf16x8*)(Ks + (64 * kt + 16 * mt + fr) * 72 + 32 * s + 8 * fq), Qf[s], sc[mt]);
#pragma unroll
                            for (int rg = 0; rg < 4; ++rg) { const int key = 64 * kt + 16 * mt + 4 * fq + rg; const int rel = 128 + qrow - key; const int kp = qb * 64 - 128 + key;
                                const bool ok = (rel >= 0) && (rel < 128) && (kp >= 0);
                                sc[mt][rg] = ok ? sc[mt][rg] : -1e30f; tmax = fmaxf(tmax, sc[mt][rg]); } }
                        tmax = fmaxf(tmax, __shfl_xor(tmax, 16)); tmax = fmaxf(tmax, __shfl_xor(tmax, 32));
                        const float mnew = fmaxf(mrun, tmax), alpha = __expf(mrun - mnew);
                        float ps = 0.f;
#pragma unroll
                        for (int mt = 0; mt < 4; ++mt)
#pragma unroll
                            for (int rg = 0; rg < 4; ++rg) { const float p = (sc[mt][rg] > -1e29f) ? __expf(sc[mt][rg] - mnew) : 0.f; sc[mt][rg] = p; ps += p; }
                        lrun = lrun * alpha + ps; mrun = mnew;
                        bf16x8 Pb[2]; Pb[0] = mk8f(sc[0], sc[1]); Pb[1] = mk8f(sc[2], sc[3]);
#pragma unroll
                        for (int dt = 0; dt < 4; ++dt) { Oa[dt] = Oa[dt] * alpha;
#pragma unroll
                            for (int s2 = 0; s2 < 2; ++s2) { const LAS bf16_t* pvf = Vt + (16 * dt + fr) * 200 + 64 * kt + 32 * s2 + 4 * fq;
                                Oa[dt] = mfma16(mk8(*(const LAS u32x2*)pvf, *(const LAS u32x2*)(pvf + 16)), Pb[s2], Oa[dt]); } }
                    }
                    lrun += __shfl_xor(lrun, 16); lrun += __shfl_xor(lrun, 32);
                    const float inv = 1.f / lrun;
#pragma unroll
                    for (int dt = 0; dt < 4; ++dt) { u32x2 w; w.x = cvt_pk_bf16(Oa[dt][0] * inv, Oa[dt][1] * inv); w.y = cvt_pk_bf16(Oa[dt][2] * inv, Oa[dt][3] * inv);
                        *(u32x2*)(mix0 + (size_t)tq * D + hq * 64 + 16 * dt + 4 * fq) = w; }
                }
            }
        }
    }
    SEAM(3);

    if (RUN(4)) {
        pg8::Gemm g{(const bf16_t*)(ws + WS_HMIX0), (const bf16_t*)(ws + WS_WOUT0), D, D};
        pg8::DenseOrder S; S.init(T, D, G, bid, D, D);
        pg8::EpiResF32 E{args.in[I_X], args.out, D};
        pg8::gemm_phase(lds, g, S, E);
    }
    SEAM(4);

    if (RUN(5)) moe_route(args, 0, lds, bid, G, tid, lane, wave);
    SEAM(5);
    if (RUN(6)) moe_scatter(args, 0, lds, bid, G, tid, lane, wave);
    SEAM(6);
    if (RUN(7)) moe_gemm1(args, 0, lds, bid, G, tid);
    SEAM(7);
    if (RUN(8)) moe_gemm2(args, 0, lds, bid, G, tid);
    SEAM(8);
    if (RUN(9)) moe_combine<true>(args, args.in[I_LNO], (bf16_t*)(ws + WS_H1), gw, ngw, lane);
    SEAM(9);

    if (RUN(10)) {
        pg8::Gemm g{(const bf16_t*)(ws + WS_H1), (const bf16_t*)(ws + WS_WIN1), D, D};
        pg8::DenseOrder S; S.init(T, ODD_IN, G, bid, D, D);
        pg8::EpiBf16 E{(bf16_t*)(ws + WS_PROJ1), ODD_IN};
        pg8::gemm_phase(lds, g, S, E);
    }
    SEAM(10);

    if (RUN(11)) {
        bf16_t* proj1 = (bf16_t*)(ws + WS_PROJ1); bf16_t* inner = (bf16_t*)(ws + WS_INNER); bf16_t* kzT = (bf16_t*)(ws + WS_KZT);
        LAS bf16_t* Qs = (LAS bf16_t*)lds;
        LAS bf16_t* Ks = (LAS bf16_t*)(lds + 67584);
        const int fr = lane & 15, fq = lane >> 4;
        for (int item = bid; item < 1024; item += G) {
            const int b = item >> 7, n = (item >> 2) & 31, h = item & 3;
            const int t0 = b * SEQ + n * 128;
            const float l2g = logf(1.0f - exp2f(-5.0f - (float)h)) * 1.4426950408889634f;
            __syncthreads();
            {
                const int r = tid >> 2, seg = tid & 3;
                const float pos = (float)(n * 128 + r);
                bf16_t* pq = proj1 + (size_t)(t0 + r) * ODD_IN + h * 256 + 64 * seg;
#pragma unroll 2
                for (int c8 = 0; c8 < 8; ++c8) {
                    const u32x4 qr = *(const u32x4*)(pq + 8 * c8), kr = *(const u32x4*)(pq + 1024 + 8 * c8);
                    unsigned qw[4] = {qr.x, qr.y, qr.z, qr.w}, kw[4] = {kr.x, kr.y, kr.z, kr.w};
#pragma unroll
                    for (int pp = 0; pp < 4; ++pp) {
                        const int i = 32 * seg + 4 * c8 + pp;
                        float sn, cs; sincos_rev(pos * exp2f(-0.10462765655f * (float)i), sn, cs);
                        const float q1 = lo_bf(qw[pp]), q2 = hi_bf(qw[pp]), k1 = lo_bf(kw[pp]) * 0.0625f, k2 = hi_bf(kw[pp]) * 0.0625f;
                        qw[pp] = cvt_pk_bf16(q1 * cs - q2 * sn, q2 * cs + q1 * sn);
                        kw[pp] = cvt_pk_bf16(k1 * cs - k2 * sn, k2 * cs + k1 * sn);
                    }
                    const u32x4 qo = (u32x4){qw[0], qw[1], qw[2], qw[3]}, ko = (u32x4){kw[0], kw[1], kw[2], kw[3]};
                    *(u32x4*)(pq + 8 * c8) = qo;
                    *(LAS u32x4*)(Qs + r * 264 + 64 * seg + 8 * c8) = qo;
                    *(LAS u32x4*)(Ks + r * 264 + 64 * seg + 8 * c8) = ko;
                }
            }
            __syncthreads();
            {
                const int i = 16 * wave + fr;
                for (int jt = 0; jt < 8; ++jt) {
                    f32x4 acc = (f32x4){0.f, 0.f, 0.f, 0.f};
                    if (jt <= wave) {
#pragma unroll
                        for (int s = 0; s < 8; ++s)
                            acc = mfma16(*(const LAS bf16x8*)(Ks + (16 * jt + fr) * 264 + 32 * s + 8 * fq), *(const LAS bf16x8*)(Qs + (16 * wave + fr) * 264 + 32 * s + 8 * fq), acc);
                    }
                    float vv[4];
#pragma unroll
                    for (int rg = 0; rg < 4; ++rg) { const int j = 16 * jt + 4 * fq + rg; vv[rg] = (i >= j) ? acc[rg] * exp2f((float)(i - j) * l2g) : 0.f; }
                    u32x2 w; w.x = cvt_pk_bf16(vv[0], vv[1]); w.y = cvt_pk_bf16(vv[2], vv[3]);
                    *(u32x2*)(inner + ((size_t)item * 128 + i) * 128 + 16 * jt + 4 * fq) = w;
                }
            }
            {
                const int d = tid >> 1, half = tid & 1;
                u32x4* po = (u32x4*)(kzT + ((size_t)item * 256 + d) * 128 + 64 * half);
#pragma unroll
                for (int i8 = 0; i8 < 8; ++i8) {
                    float kv[8];
#pragma unroll
                    for (int e = 0; e < 8; ++e) { const int r = 64 * half + 8 * i8 + e; kv[e] = bf2f((unsigned)Ks[r * 264 + d]) * exp2f((float)(127 - r) * l2g); }
                    u32x4 o; o.x = cvt_pk_bf16(kv[0], kv[1]); o.y = cvt_pk_bf16(kv[2], kv[3]); o.z = cvt_pk_bf16(kv[4], kv[5]); o.w = cvt_pk_bf16(kv[6], kv[7]);
                    po[i8] = o;
                }
            }
        }
    }
    SEAM(11);

    if (RUN(12)) {
        bf16_t* proj1 = (bf16_t*)(ws + WS_PROJ1); const bf16_t* inner = (const bf16_t*)(ws + WS_INNER); const bf16_t* kzT = (const bf16_t*)(ws + WS_KZT);
        float* SSQ = (float*)(ws + WS_SSQ);
        LAS bf16_t* Vt = (LAS bf16_t*)lds;
        LAS bf16_t* St = (LAS bf16_t*)(lds + 17408);
        const int fr = lane & 15, fq = lane >> 4;
        for (int wi = bid; wi < 256; wi += G) {
            const int xcd = wi & 7, jj = wi >> 3, bh = xcd * 4 + (jj >> 3), sl = jj & 7, b = bh >> 2, h = bh & 3;
            const float l2g = logf(1.0f - exp2f(-5.0f - (float)h)) * 1.4426950408889634f;
            const float gC = exp2f(128.0f * l2g);
            const float xi = exp2f((float)(16 * wave + fr + 1) * l2g);
            f32x4 Sacc[2][4];
#pragma unroll
            for (int mt = 0; mt < 2; ++mt)
#pragma unroll
                for (int nt = 0; nt < 4; ++nt) Sacc[mt][nt] = (f32x4){0.f, 0.f, 0.f, 0.f};
            __syncthreads();
            for (int i = tid; i < 64 * 264 / 2; i += NTHREADS) ((LAS unsigned*)St)[i] = 0u;
            const int vr = tid >> 2, vcs = tid & 3;
            const size_t vcol = 2048 + h * 512 + 64 * sl;
            u32x4 pv0, pv1;
            { const u32x4* pvp = (const u32x4*)(proj1 + (size_t)(b * SEQ + vr) * ODD_IN + vcol + 16 * vcs); pv0 = pvp[0]; pv1 = pvp[1]; }
#define RET_VSTORE() do { const unsigned _w[8] = {pv0.x, pv0.y, pv0.z, pv0.w, pv1.x, pv1.y, pv1.z, pv1.w}; \
                _Pragma("unroll") for (int _e = 0; _e < 8; ++_e) { Vt[(16 * vcs + 2 * _e) * 136 + vr] = (bf16_t)(_w[_e] & 0xffffu); Vt[(16 * vcs + 2 * _e + 1) * 136 + vr] = (bf16_t)(_w[_e] >> 16); } } while (0)
            RET_VSTORE();
            __syncthreads();
            for (int n = 0; n < 32; ++n) {
                const int item = (b * 32 + n) * 4 + h, t0 = b * SEQ + n * 128;
                const int ti = t0 + 16 * wave + fr;
                if (n + 1 < 32) { const u32x4* pvp = (const u32x4*)(proj1 + (size_t)(t0 + 128 + vr) * ODD_IN + vcol + 16 * vcs); pv0 = pvp[0]; pv1 = pvp[1]; }
                f32x4 ac[4], ai[4];
#pragma unroll
                for (int ct = 0; ct < 4; ++ct) { ac[ct] = (f32x4){0.f, 0.f, 0.f, 0.f}; ai[ct] = (f32x4){0.f, 0.f, 0.f, 0.f}; }
                {
                    const bf16_t* pq = proj1 + (size_t)ti * ODD_IN + h * 256 + 8 * fq;
                    bf16x8 qf[8];
#pragma unroll
                    for (int s = 0; s < 8; ++s) qf[s] = *(const bf16x8*)(pq + 32 * s);
#pragma unroll
                    for (int s = 0; s < 8; ++s)
#pragma unroll
                        for (int ct = 0; ct < 4; ++ct) ac[ct] = mfma16(*(const LAS bf16x8*)(St + (16 * ct + fr) * 264 + 32 * s + 8 * fq), qf[s], ac[ct]);
                }
                {
                    const bf16_t* pin = inner + ((size_t)item * 128 + 16 * wave + fr) * 128 + 8 * fq;
                    bf16x8 nf[4];
#pragma unroll
                    for (int s = 0; s < 4; ++s) nf[s] = *(const bf16x8*)(pin + 32 * s);
#pragma unroll
                    for (int s = 0; s < 4; ++s)
#pragma unroll
                        for (int ct = 0; ct < 4; ++ct) ai[ct] = mfma16(*(const LAS bf16x8*)(Vt + (16 * ct + fr) * 136 + 32 * s + 8 * fq), nf[s], ai[ct]);
                }
                {
                    float ssq = 0.f;
                    bf16_t* po = proj1 + (size_t)ti * ODD_IN + vcol + 4 * fq;
#pragma unroll
                    for (int ct = 0; ct < 4; ++ct) {
                        const u32x2 zr = *(const u32x2*)(po + 2048 + 16 * ct);
                        f32x4 o = ai[ct] + ac[ct] * xi;
                        ssq += (o[0] * o[0] + o[1] * o[1]) + (o[2] * o[2] + o[3] * o[3]);
                        u32x2 w; w.x = cvt_pk_bf16(o[0] * silu_f(lo_bf(zr.x)), o[1] * silu_f(hi_bf(zr.x))); w.y = cvt_pk_bf16(o[2] * silu_f(lo_bf(zr.y)), o[3] * silu_f(hi_bf(zr.y)));
                        *(u32x2*)(po + 16 * ct) = w;
                    }
                    ssq += __shfl_xor(ssq, 16); ssq += __shfl_xor(ssq, 32);
                    if (fq == 0) SSQ[((size_t)(h * 8 + sl)) * T + ti] = ssq;
                }
                {
                    const bf16_t* pk = kzT + ((size_t)item * 256 + 32 * wave + fr) * 128 + 8 * fq;
#pragma unroll
                    for (int mt = 0; mt < 2; ++mt) {
                        bf16x8 kf[4];
#pragma unroll
                        for (int s = 0; s < 4; ++s) kf[s] = *(const bf16x8*)(pk + (size_t)mt * 16 * 128 + 32 * s);
#pragma unroll
                        for (int nt = 0; nt < 4; ++nt) { Sacc[mt][nt] = Sacc[mt][nt] * gC;
#pragma unroll
                            for (int s = 0; s < 4; ++s) Sacc[mt][nt] = mfma16(kf[s], *(const LAS bf16x8*)(Vt + (16 * nt + fr) * 136 + 32 * s + 8 * fq), Sacc[mt][nt]); }
                    }
                }
                __syncthreads();
#pragma unroll
                for (int mt = 0; mt < 2; ++mt)
#pragma unroll
                    for (int nt = 0; nt < 4; ++nt) { u32x2 w; w.x = cvt_pk_bf16(Sacc[mt][nt][0], Sacc[mt][nt][1]); w.y = cvt_pk_bf16(Sacc[mt][nt][2], Sacc[mt][nt][3]);
                        *(LAS u32x2*)(St + (16 * nt + fr) * 264 + 32 * wave + 16 * mt + 4 * fq) = w; }
                if (n + 1 < 32) RET_VSTORE();
                __syncthreads();
            }
#undef RET_VSTORE
        }
    }
    SEAM(12);

    if (RUN(13)) {
        bf16_t* proj1 = (bf16_t*)(ws + WS_PROJ1); const float* SSQ = (const float*)(ws + WS_SSQ);
        for (int t = gw; t < T; t += ngw) {
#pragma unroll
            for (int j = 0; j < 4; ++j) {
                float ssum = 0.f;
#pragma unroll
                for (int q8 = 0; q8 < 8; ++q8) ssum += SSQ[((size_t)(j * 8 + q8)) * T + t];
                const float rstd = rsqrtf(ssum * (1.f / 512.f) + EPS);
                u32x4* p = (u32x4*)(proj1 + (size_t)t * ODD_IN + 2048 + j * 512) + lane;
                const u32x4 v = *p; u32x4 o;
                o.x = cvt_pk_bf16(lo_bf(v.x) * rstd, hi_bf(v.x) * rstd); o.y = cvt_pk_bf16(lo_bf(v.y) * rstd, hi_bf(v.y) * rstd);
                o.z = cvt_pk_bf16(lo_bf(v.z) * rstd, hi_bf(v.z) * rstd); o.w = cvt_pk_bf16(lo_bf(v.w) * rstd, hi_bf(v.w) * rstd);
                *p = o;
            }
        }
        convert_moe(args, 1, (LAS float*)(lds + wave * 8448), gw, ngw, lane);
    }
    SEAM(13);

    if (RUN(14)) {
        pg8::Gemm g{(const bf16_t*)(ws + WS_PROJ1) + 2048, (const bf16_t*)(ws + WS_WOUT1), ODD_IN, 2048};
        pg8::DenseOrder S; S.init(T, D, G, bid, ODD_IN, 2048);
        pg8::EpiResF32 E{args.out, args.out, D};
        pg8::gemm_phase(lds, g, S, E);
    }
    SEAM(14);

    if (RUN(15)) moe_route(args, 1, lds, bid, G, tid, lane, wave);
    SEAM(15);
    if (RUN(16)) moe_scatter(args, 1, lds, bid, G, tid, lane, wave);
    SEAM(16);
    if (RUN(17)) moe_gemm1(args, 1, lds, bid, G, tid);
    SEAM(17);
    if (RUN(18)) moe_gemm2(args, 1, lds, bid, G, tid);
    SEAM(18);
    if (RUN(19)) moe_combine<false>(args, nullptr, nullptr, gw, ngw, lane);
#ifdef CKPROBE
    {
        xcd_barrier(xbar);
        unsigned* ckd = (unsigned*)(ws + WS_CTL) + 256;
        CKPROBE;
        xcd_barrier(xbar);
        const unsigned c = xb_ld(ckd);
        const float f = (float)((c >> 4) & 0xFFFFu) + 1.0f;
        f32x4* o = (f32x4*)args.out; for (size_t i = (size_t)bid * NTHREADS + tid; i < (size_t)T * D / 4; i += (size_t)G * NTHREADS) o[i] = (f32x4){f, f, f, f};
    }
#endif
#undef IN
#undef SEAM
}

extern "C" void kernel_launch(void* const* d_in, const int* in_sizes, int n_in, void* d_out, int out_size, void* d_ws, size_t ws_size, hipStream_t stream) {
    static int grid = 0;
    if (grid == 0) {
        if (n_in != 22 || in_sizes[0] != T * D || out_size != T * D || ws_size < WS_END) { fprintf(stderr, "kernel_launch: unexpected shapes / workspace (n_in %d, ws %zu, need %zu)\n", n_in, ws_size, (size_t)WS_END); grid = -1; return; }
        int dev = 0, cus = 0, per_cu = 0;
        (void)hipGetDevice(&dev); (void)hipDeviceGetAttribute(&cus, hipDeviceAttributeMultiprocessorCount, dev);
        if (hipFuncSetAttribute((const void*)fwd_kernel, hipFuncAttributeMaxDynamicSharedMemorySize, LDS_BYTES) != hipSuccess) { fprintf(stderr, "kernel_launch: hipFuncSetAttribute failed\n"); grid = -1; return; }
        if (hipOccupancyMaxActiveBlocksPerMultiprocessor(&per_cu, (const void*)fwd_kernel, NTHREADS, LDS_BYTES) != hipSuccess || per_cu < 1) { fprintf(stderr, "kernel_launch: occupancy query says %d\n", per_cu); grid = -1; return; }
        (void)hipGetLastError();
        grid = cus;
    }
    if (grid < 0) return;
    (void)hipMemsetAsync((char*)d_ws + WS_CTL, 0, 32768, stream);
    Args a{};
    for (int i = 0; i < 22; ++i) a.in[i] = (const float*)d_in[i];
    a.out = (float*)d_out; a.ws = (unsigned char*)d_ws; a.ph_lo = 0; a.ph_hi = PHHI;
    void* kargs[] = {&a};
    hipError_t e = hipLaunchCooperativeKernel((const void*)fwd_kernel, dim3(grid), dim3(NTHREADS), kargs, LDS_BYTES, stream);
    if (e != hipSuccess) fprintf(stderr, "kernel_launch: cooperative launch failed: %s (grid %d)\n", hipGetErrorString(e), grid);
}
```

```cpp
#include <hip/hip_runtime.h>
#include <hip/hip_cooperative_groups.h>
#include <cstdio>
#include <cstdint>
namespace cg = cooperative_groups;

#define LAS __attribute__((address_space(3)))
typedef unsigned short bf16_t;
typedef short bf16x8 __attribute__((ext_vector_type(8)));
typedef float f32x4 __attribute__((ext_vector_type(4)));
typedef float f32x2 __attribute__((ext_vector_type(2)));
typedef unsigned u32x4 __attribute__((ext_vector_type(4)));
typedef unsigned u32x2 __attribute__((ext_vector_type(2)));

constexpr int NB = 8, SEQ = 4096, D = 1024, T = NB * SEQ;
constexpr int EVEN_IN = 2824, N0 = 2816;
constexpr int ODD_IN = 6144;
constexpr int NEXP = 32, DEXP = 512;
constexpr int ROWS_PAD = 73728;
constexpr float EPS = 1e-6f;
constexpr int NWAVES = 8, NTHREADS = 512;
constexpr int LDS_BYTES = 163840;

constexpr size_t MiB = 1u << 20;
constexpr size_t WS_CTL = 0;
constexpr size_t WS_WIN0 = 1 * MiB;
constexpr size_t WS_WOUT0 = 7 * MiB;
constexpr size_t WS_WIN1 = 9 * MiB;
constexpr size_t WS_WOUT1 = 21 * MiB;
constexpr size_t WS_X = 25 * MiB;
constexpr size_t WS_XB1 = WS_X;
constexpr size_t WS_XB2 = WS_X + 64 * MiB;
constexpr size_t WS_H1 = WS_X;
constexpr size_t WS_INNER = WS_X;
constexpr size_t WS_KZT = WS_X + 32 * MiB;
constexpr size_t WS_SM = 121 * MiB;
constexpr size_t WS_BAB = WS_SM;
constexpr size_t WS_RE = WS_SM + 1 * MiB;
constexpr size_t WS_RG = WS_RE + 256 * 1024;
constexpr size_t WS_RS = WS_RG + 256 * 1024;
constexpr size_t WS_RP = WS_RS + 256 * 1024;
constexpr size_t WS_SSQ = WS_SM + 2 * MiB;
constexpr size_t WS_GL = WS_SM + 6 * MiB;
constexpr size_t WS_BC = WS_SM + 7 * MiB;
constexpr size_t WS_A = 129 * MiB;
constexpr size_t WS_PROJ0 = WS_A;
constexpr size_t WS_HMIX0 = WS_A + 176 * MiB;
constexpr size_t WS_GU = WS_A + 240 * MiB;
constexpr size_t WS_GW = WS_A + 272 * MiB;
constexpr size_t WS_GQD = WS_A + 304 * MiB;
constexpr size_t WS_GKDT = WS_A + 336 * MiB;
constexpr size_t WS_GA = WS_A + 368 * MiB;
constexpr size_t WS_XN = WS_A;
constexpr size_t WS_XROWS = WS_A + 64 * MiB;
constexpr size_t WS_HID = WS_A + 208 * MiB;
constexpr size_t WS_PROJ1 = WS_A;
constexpr size_t WS_END = 513 * MiB;

__device__ __forceinline__ float bf2f(unsigned b) { return __uint_as_float(b << 16); }
typedef __bf16 bf16x2_t __attribute__((ext_vector_type(2)));
__device__ __forceinline__ unsigned cvt_pk_bf16(float lo, float hi) { f32x2 v = {lo, hi}; bf16x2_t b = __builtin_convertvector(v, bf16x2_t); return __builtin_bit_cast(unsigned, b); }
__device__ __forceinline__ unsigned short f2bf(float f) { return (unsigned short)(cvt_pk_bf16(f, 0.f) & 0xffffu); }
__device__ __forceinline__ float lo_bf(unsigned w) { return __uint_as_float(w << 16); }
__device__ __forceinline__ float hi_bf(unsigned w) { return __uint_as_float(w & 0xffff0000u); }
__device__ __forceinline__ float silu_f(float x) { return x / (1.0f + __expf(-x)); }
__device__ __forceinline__ float sigmoid_f(float x) { return 1.0f / (1.0f + __expf(-x)); }
__device__ __forceinline__ f32x4 mfma16(bf16x8 a, bf16x8 b, f32x4 c) { return __builtin_amdgcn_mfma_f32_16x16x32_bf16(a, b, c, 0, 0, 0); }
__device__ __forceinline__ bf16x8 mk8(u32x2 lo, u32x2 hi) { u32x4 v; v.x = lo.x; v.y = lo.y; v.z = hi.x; v.w = hi.y; return __builtin_bit_cast(bf16x8, v); }
__device__ __forceinline__ bf16x8 mk8f(f32x4 a, f32x4 b) { u32x4 v; v.x = cvt_pk_bf16(a[0], a[1]); v.y = cvt_pk_bf16(a[2], a[3]); v.z = cvt_pk_bf16(b[0], b[1]); v.w = cvt_pk_bf16(b[2], b[3]); return __builtin_bit_cast(bf16x8, v); }
__device__ __forceinline__ float wave_sum(float v) {
#pragma unroll
    for (int o = 1; o < 64; o <<= 1) v += __shfl_xor(v, o);
    return v;
}
__device__ __forceinline__ void sincos_rev(float ang, float& s, float& c) {
    float r = ang * 0.15915494309189535f; r = r - floorf(r);
    s = __builtin_amdgcn_sinf(r); c = __builtin_amdgcn_cosf(r);
}

namespace pg8 {
constexpr int BM = 256, BK = 64, HALF = 128, HTB = HALF * BK * 2, STAGE_BYTES = 8 * HTB, NXCD = 8, WGM = 8;
__device__ __forceinline__ int lds_byte(int r, int c) { const int st = (r >> 4) * 2 + (c >> 5), rr = r & 15, cc = c & 31, ob = rr * 64 + cc * 2; return st * 1024 + (ob ^ (((ob >> 9) & 1) << 5)); }
__device__ __forceinline__ void stage_rc(int b, int& R, int& C) { const int st = b / 1024, sb = b % 1024, swz = sb ^ (((sb >> 9) & 1) << 5); R = (st >> 1) * 16 + swz / 64; C = (st & 1) * 32 + (swz % 64) / 2; }
__device__ __forceinline__ int perm32(int rho) { const int n = rho >> 4, i = rho & 15; return 8 * (i >> 2) + 4 * n + (i & 3); }

struct Unit { size_t aoff, boff; int pm, pn; };
struct Gemm { const bf16_t* A; const bf16_t* Bt; int lda, K; };

struct DenseOrder {
    int nM, nN, nwg, G, c, lda, K;
    __device__ void init(int M, int N, int G_, int c_, int lda_, int K_) { nM = M / BM; nN = N / BM; nwg = nM * nN; G = G_; c = c_; lda = lda_; K = K_; }
    __device__ bool next(int i, Unit& u) const {
        const long L = (long)i * G + c; if (L >= nwg) return false;
        int wgid = (int)L; { const int q = nwg / NXCD, r = nwg % NXCD, xcd = wgid % NXCD, off = wgid / NXCD; wgid = (xcd < r ? xcd * (q + 1) : r * (q + 1) + (xcd - r) * q) + off; }
        const int nig = WGM * nN, gid = wgid / nig, fm = gid * WGM, gsz = (nM - fm) < WGM ? (nM - fm) : WGM;
        u.pm = fm + ((wgid % nig) % gsz); u.pn = (wgid % nig) / gsz;
        u.aoff = (size_t)u.pm * BM * lda * 2; u.boff = (size_t)u.pn * BM * K * 2; return true;
    }
};
struct GroupedOrder {
    const LAS int* tile_e; int ntiles, G, c, lda, K; size_t estride;
    __device__ bool next(int i, Unit& u) const {
        const int L = i * G + c; if (L >= ntiles * 4) return false;
        const int rt = L >> 2, pn = L & 3; const int e = tile_e[rt];
        u.pm = rt; u.pn = pn; u.aoff = (size_t)rt * BM * lda * 2; u.boff = (size_t)e * estride + (size_t)pn * BM * K * 2; return true;
    }
};

struct EpiBf16 {
    static constexpr bool PERM = true;
    bf16_t* O; int ldc;
    __device__ __forceinline__ void operator()(const f32x4 (&acc)[2][2][4][2], const Unit& u, int wr, int wc, int fr, int fq) const {
        const int row0 = u.pm * BM + wr * 64 + fr; const int col0 = u.pn * BM + wc * 32 + 8 * fq;
#pragma unroll
        for (int ai = 0; ai < 2; ++ai)
#pragma unroll
            for (int m = 0; m < 4; ++m) { bf16_t* rowp = O + (size_t)(row0 + ai * HALF + m * 16) * ldc + col0;
#pragma unroll
                for (int bj = 0; bj < 2; ++bj) { const f32x4 v0 = acc[ai][bj][m][0], v1 = acc[ai][bj][m][1];
                    u32x4 w; w.x = cvt_pk_bf16(v0[0], v0[1]); w.y = cvt_pk_bf16(v0[2], v0[3]); w.z = cvt_pk_bf16(v1[0], v1[1]); w.w = cvt_pk_bf16(v1[2], v1[3]);
                    *(u32x4*)(rowp + bj * HALF) = w; } }
    }
};
struct EpiResF32 {
    static constexpr bool PERM = false;
    const float* base; float* out; int ldc;
    __device__ __forceinline__ void operator()(const f32x4 (&acc)[2][2][4][2], const Unit& u, int wr, int wc, int fr, int fq) const {
        const int row0 = u.pm * BM + wr * 64 + fr, col0 = u.pn * BM + wc * 32 + 4 * fq;
#pragma unroll
        for (int ai = 0; ai < 2; ++ai)
#pragma unroll
            for (int m = 0; m < 4; ++m) { const size_t off = (size_t)(row0 + ai * HALF + m * 16) * ldc + col0;
#pragma unroll
                for (int bj = 0; bj < 2; ++bj)
#pragma unroll
                    for (int n = 0; n < 2; ++n) { const f32x4 b = *(const f32x4*)(base + off + bj * HALF + n * 16); *(f32x4*)(out + off + bj * HALF + n * 16) = b + acc[ai][bj][m][n]; } }
    }
};
struct EpiSwiGLU {
    static constexpr bool PERM = false;
    bf16_t* H;
    __device__ __forceinline__ void operator()(const f32x4 (&acc)[2][2][4][2], const Unit& u, int wr, int wc, int fr, int fq) const {
        const int row0 = u.pm * BM + wr * 64 + fr;
#pragma unroll
        for (int ai = 0; ai < 2; ++ai)
#pragma unroll
            for (int m = 0; m < 4; ++m) { bf16_t* rowp = H + (size_t)(row0 + ai * HALF + m * 16) * DEXP;
#pragma unroll
                for (int bj = 0; bj < 2; ++bj) { const f32x4 g = acc[ai][bj][m][0], up = acc[ai][bj][m][1];
                    const int hc = 16 * (8 * u.pn + 4 * bj + wc) + 4 * fq;
                    u32x2 w; w.x = cvt_pk_bf16(silu_f(g[0]) * up[0], silu_f(g[1]) * up[1]); w.y = cvt_pk_bf16(silu_f(g[2]) * up[2], silu_f(g[3]) * up[3]);
                    *(u32x2*)(rowp + hc) = w; } }
    }
};

template <class Epi, class Sched>
__device__ __forceinline__ void gemm_phase(LAS unsigned char* lds, const Gemm g, const Sched& S, const Epi& E) {
    const int tid = threadIdx.x, wid = __builtin_amdgcn_readfirstlane(tid >> 6), lane = tid & 63, wr = wid >> 2, wc = wid & 3, fr = lane & 15, fq = lane >> 4;
    const int K = g.K, nt = K / BK;
    unsigned voffA[2], voffB[2];
#pragma unroll
    for (int i = 0; i < 2; ++i) { int R, C; stage_rc(tid * 16 + i * 8192, R, C); const int Rb = Epi::PERM ? ((R & ~31) + perm32(R & 31)) : R;
        voffA[i] = (unsigned)(R * g.lda + C) * 2u; voffB[i] = (unsigned)(Rb * K + C) * 2u; }
    const size_t kstep = (size_t)(BK * 2);
    const size_t hstepA = (size_t)HALF * g.lda * 2, hstepB = (size_t)HALF * K * 2;
    const unsigned ldsw = (unsigned)wid * 1024u;
    const int aoff = lds_byte(wr * 64 + fr, fq * 8), boff = lds_byte(wc * 32 + fr, fq * 8);
#define PG8_SA(b, h) (((b) * 2 + (h)) * HTB)
#define PG8_SB(b, h) ((4 + (b) * 2 + (h)) * HTB)
#define PG8_STAGE(bufoff, gbase, voff) do { _Pragma("unroll") for (int _i = 0; _i < 2; ++_i) \
        __builtin_amdgcn_global_load_lds((const unsigned*)((const char*)(gbase) + (voff)[_i]), (LAS unsigned*)(lds + (bufoff) + ldsw + _i * 8192), 16, 0, 0); } while (0)
#define PG8_LDA(dst, b, h) do { _Pragma("unroll") for (int m = 0; m < 4; ++m) _Pragma("unroll") for (int k = 0; k < 2; ++k) dst[m][k] = *(const LAS bf16x8*)(lds + PG8_SA(b, h) + aoff + m * 2048 + k * 1024); } while (0)
#define PG8_LDB(dst, b, h) do { _Pragma("unroll") for (int n = 0; n < 2; ++n) _Pragma("unroll") for (int k = 0; k < 2; ++k) dst[n][k] = *(const LAS bf16x8*)(lds + PG8_SB(b, h) + boff + n * 2048 + k * 1024); } while (0)
#define PG8_MMA(ai, bj, At, Bt) do { __builtin_amdgcn_s_setprio(1); _Pragma("unroll") for (int m = 0; m < 4; ++m) _Pragma("unroll") for (int n = 0; n < 2; ++n) _Pragma("unroll") for (int k = 0; k < 2; ++k) \
        acc[ai][bj][m][n] = __builtin_amdgcn_mfma_f32_16x16x32_bf16(Bt[n][k], At[m][k], acc[ai][bj][m][n], 0, 0, 0); __builtin_amdgcn_s_setprio(0); } while (0)
#define PG8_WAIT_V(n) asm volatile("s_waitcnt vmcnt(" #n ")" ::: "memory")
#define PG8_WAIT_L(n) asm volatile("s_waitcnt lgkmcnt(" #n ")" ::: "memory")
#define PG8_BAR __builtin_amdgcn_s_barrier()
#define PG8_SCHED __builtin_amdgcn_sched_barrier(0)
    Unit cur, nxt; int ui = 0;
    if (!S.next(0, cur)) return;
    f32x4 acc[2][2][4][2];
#pragma unroll
    for (int a = 0; a < 2; ++a)
#pragma unroll
        for (int b = 0; b < 2; ++b)
#pragma unroll
            for (int m = 0; m < 4; ++m)
#pragma unroll
                for (int n = 0; n < 2; ++n) acc[a][b][m][n] = (f32x4){0.f, 0.f, 0.f, 0.f};
    bf16x8 At[4][2], B0[2][2], B1[2][2];
    const char* cA = (const char*)g.A + cur.aoff; const char* cB = (const char*)g.Bt + cur.boff;
    PG8_STAGE(PG8_SB(0, 0), cB, voffB); PG8_STAGE(PG8_SB(0, 1), cB + hstepB, voffB); PG8_STAGE(PG8_SA(0, 0), cA, voffA); PG8_STAGE(PG8_SA(0, 1), cA + hstepA, voffA);
    if (wr == 1) PG8_BAR;
    PG8_WAIT_V(2); PG8_BAR;
    PG8_STAGE(PG8_SB(1, 0), cB + kstep, voffB); PG8_STAGE(PG8_SA(1, 0), cA + kstep, voffA); PG8_STAGE(PG8_SB(1, 1), cB + hstepB + kstep, voffB);
    PG8_WAIT_V(6); PG8_BAR;
    for (;;) {
        const bool has_next = S.next(ui + 1, nxt);
        const char* nA = has_next ? (const char*)g.A + nxt.aoff : cA; const char* nB = has_next ? (const char*)g.Bt + nxt.boff : cB;
        for (int t = 0; t < nt; t += 2) {
            const bool last = (t == nt - 2);
            const char* a1 = cA + (size_t)(t + 1) * kstep;
            const char* a2 = last ? nA : cA + (size_t)(t + 2) * kstep; const char* b2 = last ? nB : cB + (size_t)(t + 2) * kstep;
            const char* a3 = a2 + kstep; const char* b3 = b2 + kstep;
            PG8_LDB(B0, 0, 0); PG8_LDB(B1, 0, 1); PG8_SCHED; PG8_LDA(At, 0, 0); PG8_STAGE(PG8_SA(1, 1), a1 + hstepA, voffA);
            PG8_WAIT_V(8); PG8_WAIT_L(0); PG8_BAR; PG8_MMA(0, 0, At, B0); PG8_MMA(0, 1, At, B1); PG8_BAR; PG8_SCHED;
            PG8_LDA(At, 0, 1); PG8_STAGE(PG8_SB(0, 0), b2, voffB); PG8_STAGE(PG8_SB(0, 1), b2 + hstepB, voffB); PG8_STAGE(PG8_SA(0, 0), a2, voffA);
            PG8_WAIT_V(8); PG8_WAIT_L(0); PG8_BAR; PG8_MMA(1, 0, At, B0); PG8_MMA(1, 1, At, B1); PG8_BAR; PG8_SCHED;
            PG8_LDB(B0, 1, 0); PG8_LDB(B1, 1, 1); PG8_SCHED; PG8_LDA(At, 1, 0); PG8_STAGE(PG8_SA(0, 1), a2 + hstepA, voffA);
            PG8_WAIT_V(8); PG8_WAIT_L(0); PG8_BAR; PG8_MMA(0, 0, At, B0); PG8_MMA(0, 1, At, B1); PG8_BAR; PG8_SCHED;
            PG8_LDA(At, 1, 1); PG8_STAGE(PG8_SB(1, 0), b3, voffB); PG8_STAGE(PG8_SB(1, 1), b3 + hstepB, voffB); PG8_STAGE(PG8_SA(1, 0), a3, voffA);
            PG8_WAIT_V(8); PG8_WAIT_L(0); PG8_BAR; PG8_MMA(1, 0, At, B0); PG8_MMA(1, 1, At, B1); PG8_BAR; PG8_SCHED;
        }
        if (wr == 0) PG8_BAR;
        E(acc, cur, wr, wc, fr, fq);
        if (!has_next) break;
#pragma unroll
        for (int a = 0; a < 2; ++a)
#pragma unroll
            for (int b = 0; b < 2; ++b)
#pragma unroll
                for (int m = 0; m < 4; ++m)
#pragma unroll
                    for (int n = 0; n < 2; ++n) acc[a][b][m][n] = (f32x4){0.f, 0.f, 0.f, 0.f};
        cur = nxt; cA = nA; cB = nB; ++ui;
        if (wr == 1) PG8_BAR;
    }
    PG8_WAIT_V(0);
    PG8_BAR;
#undef PG8_SA
#undef PG8_SB
#undef PG8_STAGE
#undef PG8_LDA
#undef PG8_LDB
#undef PG8_MMA
#undef PG8_WAIT_V
#undef PG8_WAIT_L
#undef PG8_BAR
#undef PG8_SCHED
}
}

#define XB_TMO      128
#define XB_XCNT(j)  (256  + 64 * (j))
#define XB_XSUB(j)  (1280 + 64 * (j))
#define XB_XGEN(j)  (2304 + 64 * (j))
#define XB_TOP      3328
#define XB_TOPGEN   3392
#define XCD_BAR_WORDS 3456
#define XB_SPIN_CAP (1u << 18)
__device__ __forceinline__ unsigned xb_ld(unsigned* p)              { return __hip_atomic_load(p, __ATOMIC_RELAXED, __HIP_MEMORY_SCOPE_AGENT); }
__device__ __forceinline__ unsigned xb_add(unsigned* p, unsigned v) { return __hip_atomic_fetch_add(p, v, __ATOMIC_RELAXED, __HIP_MEMORY_SCOPE_AGENT); }
__device__ __forceinline__ unsigned xb_xcc_id() { return (unsigned)__builtin_amdgcn_s_getreg((3 << 11) | 20) & 0xFu; }
#define XB_SPIN(cond, bar) do { unsigned _sp = 0; while (cond) { __builtin_amdgcn_s_sleep(1); \
    if ((++_sp & 255u) == 0u) { if (xb_ld(&(bar)[XB_TMO])) break; if (_sp > XB_SPIN_CAP) { atomicAdd(&(bar)[XB_TMO], 1u); break; } } } } while (0)
struct XcdBarrier { unsigned* bar; unsigned x; volatile LAS unsigned* st; };
__device__ __forceinline__ XcdBarrier xcd_barrier_post(unsigned* bar, volatile LAS unsigned* st) {
    XcdBarrier b; b.bar = bar; b.x = xb_xcc_id(); b.st = st;
    if (threadIdx.x == 0) (void)xb_add(&bar[XB_XCNT(b.x)], 1u);
    return b;
}
__device__ __forceinline__ void xcd_barrier_complete(unsigned* bar, unsigned x, unsigned& nloc, unsigned& nx) {
    const unsigned G = gridDim.x * gridDim.y * gridDim.z;
    unsigned sum, cnt, mine, sp = 0u;
    for (;;) {
        sum = 0u; cnt = 0u; mine = 0u;
#pragma unroll
        for (unsigned j = 0; j < 16; ++j) { const unsigned c = xb_ld(&bar[XB_XCNT(j)]); sum += c; cnt += (c > 0u) ? 1u : 0u; mine = (j == x) ? c : mine; }
        if (sum == G) break;
        __builtin_amdgcn_s_sleep(1);
        if ((++sp & 255u) == 0u) { if (xb_ld(&bar[XB_TMO])) break; if (sp > XB_SPIN_CAP) { atomicAdd(&bar[XB_TMO], 1u); break; } }
    }
    nloc = mine > 0u ? mine : 1u; nx = cnt > 0u ? cnt : 1u;
}
__device__ __forceinline__ void xcd_barrier(const XcdBarrier& b) {
    asm volatile("s_waitcnt vmcnt(0)" ::: "memory");
    __syncthreads();
    if (threadIdx.x == 0) {
        unsigned* bar = b.bar;
        __builtin_amdgcn_s_waitcnt(0);
        unsigned nloc = b.st[0], nx = b.st[1];
        if (nloc == 0u) { xcd_barrier_complete(bar, b.x, nloc, nx); b.st[0] = nloc; b.st[1] = nx; }
        const unsigned old = xb_add(&bar[XB_XSUB(b.x)], 1u);
        const unsigned gen = old / nloc;
        if (old + 1u == (gen + 1u) * nloc) {
            __builtin_amdgcn_fence(__ATOMIC_RELEASE, "agent");
            asm volatile("s_waitcnt vmcnt(0)" ::: "memory");
            const unsigned og = xb_add(&bar[XB_TOP], 1u);
            const unsigned tg = og / nx;
            if (og + 1u == (tg + 1u) * nx) xb_add(&bar[XB_TOPGEN], 1u);
            else XB_SPIN(xb_ld(&bar[XB_TOPGEN]) == tg, bar);
            __builtin_amdgcn_fence(__ATOMIC_ACQUIRE, "agent");
            xb_add(&bar[XB_XGEN(b.x)], 1u);
            asm volatile("s_waitcnt vmcnt(0)" ::: "memory");
        } else {
            XB_SPIN(xb_ld(&bar[XB_XGEN(b.x)]) == gen, bar);
            __builtin_amdgcn_fence(__ATOMIC_ACQUIRE, "agent");
            asm volatile("s_waitcnt vmcnt(0)" ::: "memory");
        }
    }
    __syncthreads();
}

struct Args {
    const float* in[22];
    float* out; unsigned char* ws;
    int ph_lo, ph_hi;
};
enum { I_X = 0, I_LNE, I_WINE, I_CONVW, I_ALOG, I_DTB, I_QG, I_KG, I_SINK, I_GDNG, I_WOUTE, I_LNO, I_WINO, I_WOUTO, I_LNF, I_WRG, I_BRG, I_WRE, I_BRE, I_WG, I_WU, I_WD };

__device__ __forceinline__ void transpose_item(const float* W, int K, int ldw, int ncols, bf16_t* WT, int mode, LAS float* scr, int item, int lane) {
    const int nblk = ncols / 32, kb = item / nblk, nb = item % nblk, k0 = 64 * kb, n0 = 32 * nb;
#pragma unroll 8
    for (int i = 0; i < 32; ++i) { const int kk = 2 * i + (lane >> 5); scr[kk * 33 + (lane & 31)] = W[(size_t)(k0 + kk) * ldw + n0 + (lane & 31)]; }
    asm volatile("s_waitcnt lgkmcnt(0)" ::: "memory");
    const int c = lane & 7;
#pragma unroll
    for (int j = 0; j < 4; ++j) { const int n = (lane >> 3) + 8 * j; const LAS float* s = scr + (8 * c) * 33 + n;
        u32x4 o; o.x = cvt_pk_bf16(s[0 * 33], s[1 * 33]); o.y = cvt_pk_bf16(s[2 * 33], s[3 * 33]); o.z = cvt_pk_bf16(s[4 * 33], s[5 * 33]); o.w = cvt_pk_bf16(s[6 * 33], s[7 * 33]);
        const int ng = n0 + n; const int row = (mode == 0) ? ng : (32 * (ng >> 4) + (ng & 15) + (mode == 2 ? 16 : 0));
        *(u32x4*)(WT + (size_t)row * K + k0 + 8 * c) = o; }
    asm volatile("s_waitcnt lgkmcnt(0)" ::: "memory");
}
__device__ __forceinline__ void convert_moe(const Args& a, int layer, LAS float* scr, int gw, int ngw, int lane) {
    bf16_t* B1 = (bf16_t*)(a.ws + WS_XB1); bf16_t* B2 = (bf16_t*)(a.ws + WS_XB2);
    const float* wg = a.in[I_WG] + (size_t)layer * NEXP * D * DEXP; const float* wu = a.in[I_WU] + (size_t)layer * NEXP * D * DEXP; const float* wd = a.in[I_WD] + (size_t)layer * NEXP * DEXP * D;
    constexpr int IG = (D / 64) * (DEXP / 32);
    constexpr int ID = (DEXP / 64) * (D / 32);
    constexpr int PER_E = 2 * IG + ID;
    for (int it = gw; it < NEXP * PER_E; it += ngw) {
        const int e = it / PER_E; int r = it % PER_E;
        if (r < IG) { transpose_item(wg + (size_t)e * D * DEXP, D, DEXP, DEXP, B1 + (size_t)e * 1024 * 1024, 1, scr, r, lane); continue; } r -= IG;
        if (r < IG) { transpose_item(wu + (size_t)e * D * DEXP, D, DEXP, DEXP, B1 + (size_t)e * 1024 * 1024, 2, scr, r, lane); continue; } r -= IG;
        transpose_item(wd + (size_t)e * DEXP * D, DEXP, D, D, B2 + (size_t)e * 1024 * 512, 0, scr, r, lane);
    }
}

__device__ __forceinline__ void moe_route(const Args& a, int layer, LAS unsigned char* lds, int bid, int G, int tid, int lane, int wave) {
    LAS float* wT = (LAS float*)lds;
    LAS float* lng = (LAS float*)(lds + 147456);
    LAS float* bias = (LAS float*)(lds + 151552);
    LAS int* lcnt = (LAS int*)(lds + 151552 + 256);
    LAS int* lbase = lcnt + 32;
    LAS int* tokE = lbase + 32;
    LAS int* tokR = tokE + 256;
    const float* wrg = a.in[I_WRG] + (size_t)layer * D * 4; const float* wre = a.in[I_WRE] + (size_t)layer * D * 32;
    for (int i = tid; i < 4 * 1024; i += NTHREADS) { const int k = i >> 2, o = i & 3; wT[o * 1024 + k] = wrg[i]; }
    for (int i = tid; i < 32 * 1024; i += NTHREADS) { const int k = i >> 5, o = i & 31; wT[(4 + o) * 1024 + k] = wre[i]; }
    for (int i = tid; i < 1024; i += NTHREADS) lng[i] = a.in[I_LNF][layer * D + i];
    if (tid < 4) bias[tid] = a.in[I_BRG][layer * 4 + tid];
    if (tid >= 64 && tid < 96) bias[4 + tid - 64] = a.in[I_BRE][layer * 32 + tid - 64];
    const float* x = a.out;
    bf16_t* xn = (bf16_t*)(a.ws + WS_XN);
    int* RE = (int*)(a.ws + WS_RE); float* RG = (float*)(a.ws + WS_RG); int* RS = (int*)(a.ws + WS_RS);
    int* gcnt = (int*)(a.ws + WS_CTL) + layer * 32; int* BC = (int*)(a.ws + WS_BC);
    const int tsub = lane >> 4, l16 = lane & 15;
    for (int tile = bid; tile < T / 128; tile += G) {
        __syncthreads();
        if (tid < 32) lcnt[tid] = 0;
        __syncthreads();
        for (int iter = 0; iter < 4; ++iter) {
            const int tl = wave * 16 + iter * 4 + tsub, t = tile * 128 + tl;
            const f32x4* xr = (const f32x4*)(x + (size_t)t * D) + l16;
            f32x4 v[16]; float ss = 0.f;
#pragma unroll
            for (int j = 0; j < 16; ++j) { v[j] = xr[16 * j]; ss += (v[j][0] * v[j][0] + v[j][1] * v[j][1]) + (v[j][2] * v[j][2] + v[j][3] * v[j][3]); }
            ss += __shfl_xor(ss, 1); ss += __shfl_xor(ss, 2); ss += __shfl_xor(ss, 4); ss += __shfl_xor(ss, 8);
            const float rstd = rsqrtf(ss * (1.f / D) + EPS);
            unsigned long long* o8 = (unsigned long long*)(xn + (size_t)t * D) + l16;
#pragma unroll
            for (int j = 0; j < 16; ++j) { v[j] = v[j] * rstd * *((const LAS f32x4*)lng + l16 + 16 * j);
                o8[16 * j] = (unsigned long long)cvt_pk_bf16(v[j][0], v[j][1]) | ((unsigned long long)cvt_pk_bf16(v[j][2], v[j][3]) << 32); }
            LAS float* lgs = (LAS float*)(lds + 154624) + (wave * 4 + tsub) * 40;
#pragma unroll 2
            for (int o = 0; o < 36; ++o) { float acc = 0.f;
#pragma unroll
                for (int j = 0; j < 16; ++j) { const f32x4 w = *((const LAS f32x4*)(wT + o * 1024) + l16 + 16 * j); acc += (v[j][0] * w[0] + v[j][1] * w[1]) + (v[j][2] * w[2] + v[j][3] * w[3]); }
                acc += __shfl_xor(acc, 1); acc += __shfl_xor(acc, 2); acc += __shfl_xor(acc, 4); acc += __shfl_xor(acc, 8);
                if (l16 == 0) lgs[o] = acc + bias[o]; }
            asm volatile("s_waitcnt lgkmcnt(0)" ::: "memory");
            int gi = 0; float gm = lgs[0];
            for (int o = 1; o < 4; ++o) { const float lv = lgs[o]; if (lv > gm) { gm = lv; gi = o; } }
            float gs = 0.f;
            for (int o = 0; o < 4; ++o) gs += __expf(lgs[o] - gm);
            const float grp_p = 1.f / gs;
            const LAS float* le = lgs + 4 + 8 * gi;
            int e1 = 0; float m1 = le[0];
            for (int k = 1; k < 8; ++k) { const float lv = le[k]; if (lv > m1) { m1 = lv; e1 = k; } }
            int e2 = -1; float m2 = -3.0e38f;
            for (int k = 0; k < 8; ++k) { const float lv = le[k]; if (k != e1 && lv > m2) { m2 = lv; e2 = k; } }
            const float p2 = __expf(m2 - m1);
            const float g1 = grp_p / (1.f + p2), g2 = grp_p * p2 / (1.f + p2);
            if (l16 == 0) {
                const int ea = gi * 8 + e1, eb = gi * 8 + e2;
                RE[(size_t)t * 2] = ea; RE[(size_t)t * 2 + 1] = eb; RG[(size_t)t * 2] = g1; RG[(size_t)t * 2 + 1] = g2;
                tokE[tl * 2] = ea; tokE[tl * 2 + 1] = eb;
                atomicAdd((int*)(lcnt + ea), 1); atomicAdd((int*)(lcnt + eb), 1);
            }
        }
        __syncthreads();
        if (tid < 32) { const int c = lcnt[tid]; BC[tile * 32 + tid] = c; atomicAdd(gcnt + tid, c); }
        if (tid < 256) { const int e = tokE[tid]; int rank = 0; for (int j = 0; j < tid; ++j) rank += (tokE[j] == e) ? 1 : 0; RS[(size_t)tile * 256 + tid] = rank; }
    }
}
__device__ __forceinline__ void moe_tables(const Args& a, int layer, LAS int* tab, int tid) {
    __syncthreads();
    if (tid == 0) {
        const int* gcnt = (const int*)(a.ws + WS_CTL) + layer * 32; int t = 0;
        for (int e = 0; e < 32; ++e) { const int c = __hip_atomic_load(gcnt + e, __ATOMIC_RELAXED, __HIP_MEMORY_SCOPE_AGENT); const int nt = (c + 255) >> 8; tab[e] = t * 256; for (int i = 0; i < nt; ++i) tab[64 + t + i] = e; t += nt; }
        tab[32] = t;
    }
    __syncthreads();
}
__device__ __forceinline__ void moe_scatter(const Args& a, int layer, LAS unsigned char* lds, int bid, int G, int tid, int lane, int wave) {
    LAS int* tab = (LAS int*)(lds + 131072);
    LAS int* psum = (LAS int*)(lds + 131072 + 4096);
    moe_tables(a, layer, tab, tid);
    const bf16_t* xn = (const bf16_t*)(a.ws + WS_XN); bf16_t* xr = (bf16_t*)(a.ws + WS_XROWS);
    const int* RE = (const int*)(a.ws + WS_RE); const int* RS = (const int*)(a.ws + WS_RS); int* RP = (int*)(a.ws + WS_RP); const int* BC = (const int*)(a.ws + WS_BC);
    for (int tile = bid; tile < T / 128; tile += G) {
        __syncthreads();
        { const int e = tid & 31, part = tid >> 5; int sacc = 0; for (int b2 = part * 16; b2 < part * 16 + 16; ++b2) if (b2 < tile) sacc += BC[b2 * 32 + e]; psum[part * 32 + e] = sacc; }
        __syncthreads();
        if (tid < 32) { int sacc = 0; for (int p2 = 0; p2 < 16; ++p2) sacc += psum[p2 * 32 + tid]; psum[512 + tid] = sacc + tab[tid]; }
        __syncthreads();
        for (int i = 0; i < 16; ++i) {
            const int t = tile * 128 + wave * 16 + i;
            const int e0 = RE[(size_t)t * 2], e1 = RE[(size_t)t * 2 + 1];
            const int r0 = psum[512 + e0] + RS[(size_t)t * 2], r1 = psum[512 + e1] + RS[(size_t)t * 2 + 1];
            const u32x4* src = (const u32x4*)(xn + (size_t)t * D) + lane;
            const u32x4 v0 = src[0], v1 = src[64];
            u32x4* d0 = (u32x4*)(xr + (size_t)r0 * D) + lane; u32x4* d1 = (u32x4*)(xr + (size_t)r1 * D) + lane;
            d0[0] = v0; d0[64] = v1; d1[0] = v0; d1[64] = v1;
            if (lane == 0) { RP[(size_t)t * 2] = r0; RP[(size_t)t * 2 + 1] = r1; }
        }
    }
}
__device__ __forceinline__ void moe_gemm1(const Args& a, int layer, LAS unsigned char* lds, int bid, int G, int tid) {
    LAS int* tab = (LAS int*)(lds + 131072);
    moe_tables(a, layer, tab, tid);
    pg8::Gemm g{(const bf16_t*)(a.ws + WS_XROWS), (const bf16_t*)(a.ws + WS_XB1), D, D};
    pg8::GroupedOrder S{tab + 64, tab[32], G, bid, D, D, (size_t)1024 * 1024 * 2};
    pg8::EpiSwiGLU E{(bf16_t*)(a.ws + WS_HID)};
    pg8::gemm_phase(lds, g, S, E);
}
__device__ __forceinline__ void moe_gemm2(const Args& a, int layer, LAS unsigned char* lds, int bid, int G, int tid) {
    LAS int* tab = (LAS int*)(lds + 131072);
    moe_tables(a, layer, tab, tid);
    pg8::Gemm g{(const bf16_t*)(a.ws + WS_HID), (const bf16_t*)(a.ws + WS_XB2), DEXP, DEXP};
    pg8::GroupedOrder S{tab + 64, tab[32], G, bid, DEXP, DEXP, (size_t)1024 * 512 * 2};
    pg8::EpiBf16 E{(bf16_t*)(a.ws + WS_XROWS), D};
    pg8::gemm_phase(lds, g, S, E);
}
template <bool NORM>
__device__ __forceinline__ void moe_combine(const Args& a, const float* gain, bf16_t* hout, int gw, int ngw, int lane) {
    const bf16_t* y = (const bf16_t*)(a.ws + WS_XROWS);
    const int* RP = (const int*)(a.ws + WS_RP); const float* RG = (const float*)(a.ws + WS_RG);
    f32x4 gn[4];
    if (NORM) {
#pragma unroll
        for (int j = 0; j < 4; ++j) gn[j] = *((const f32x4*)gain + lane + 64 * j);
    }
    for (int t = gw; t < T; t += ngw) {
        const int p0 = RP[(size_t)t * 2], p1 = RP[(size_t)t * 2 + 1]; const float g0 = RG[(size_t)t * 2], g1 = RG[(size_t)t * 2 + 1];
        f32x4* xr = (f32x4*)(a.out + (size_t)t * D) + lane;
        const u32x2* y0 = (const u32x2*)(y + (size_t)p0 * D) + lane; const u32x2* y1 = (const u32x2*)(y + (size_t)p1 * D) + lane;
        f32x4 v[4]; float s = 0.f;
#pragma unroll
        for (int j = 0; j < 4; ++j) { v[j] = xr[64 * j]; const u32x2 a0 = y0[64 * j], a1 = y1[64 * j];
            v[j][0] += g0 * lo_bf(a0.x) + g1 * lo_bf(a1.x); v[j][1] += g0 * hi_bf(a0.x) + g1 * hi_bf(a1.x); v[j][2] += g0 * lo_bf(a0.y) + g1 * lo_bf(a1.y); v[j][3] += g0 * hi_bf(a0.y) + g1 * hi_bf(a1.y);
            xr[64 * j] = v[j]; s += (v[j][0] * v[j][0] + v[j][1] * v[j][1]) + (v[j][2] * v[j][2] + v[j][3] * v[j][3]); }
        if (NORM) {
            const float rstd = rsqrtf(wave_sum(s) * (1.f / D) + EPS);
            unsigned long long* o8 = (unsigned long long*)(hout + (size_t)t * D) + lane;
#pragma unroll
            for (int j = 0; j < 4; ++j) { const f32x4 w = v[j] * rstd * gn[j]; o8[64 * j] = (unsigned long long)cvt_pk_bf16(w[0], w[1]) | ((unsigned long long)cvt_pk_bf16(w[2], w[3]) << 32); }
        }
    }
}


__device__ __forceinline__ void ck_add(const void* p, size_t bytes, unsigned* dst, int gthread, int nthread) {
    const u32x4* q = (const u32x4*)p; const size_t n = bytes / 16; unsigned acc = 0u;
    for (size_t i = gthread; i < n; i += nthread) { const u32x4 v = q[i]; acc += v.x + v.y * 3u + v.z * 5u + v.w * 7u + (unsigned)i * 0x9E3779B1u * (v.x ^ v.w); }
#pragma unroll
    for (int o = 1; o < 64; o <<= 1) acc += __shfl_xor(acc, o);
    if ((threadIdx.x & 63) == 0) atomicAdd(dst, acc);
}
__device__ __forceinline__ Args load_args() {
#if defined(__HIP_DEVICE_COMPILE__)
    const __attribute__((address_space(4))) Args* kap = (const __attribute__((address_space(4))) Args*)__builtin_amdgcn_kernarg_segment_ptr(); asm volatile("" : "+s"(kap));
    Args a;
#pragma unroll
    for (int i = 0; i < 22; ++i) a.in[i] = kap->in[i];
    a.out = kap->out; a.ws = kap->ws; a.ph_lo = kap->ph_lo; a.ph_hi = kap->ph_hi; return a;
#else
    return Args{};
#endif
}
constexpr int NPHASE = 20;
#define PHASE_IDS int tid_o = threadIdx.x; asm volatile("" : "+v"(tid_o)); const int tid = tid_o, lane = tid & 63, wave = __builtin_amdgcn_readfirstlane(tid >> 6); const int gw = bid * NWAVES + wave; (void)gw; (void)lane; \
    const Args args = load_args(); unsigned char* const ws = args.ws; (void)ws
#ifndef PHHI
#define PHHI NPHASE
#endif
#define CKB(off, bytes) ck_add(ws + (off), (size_t)(bytes), ckd, bid * NTHREADS + tid, G * NTHREADS)

__global__ void __launch_bounds__(NTHREADS, 2) fwd_kernel(Args args_) {
    extern __shared__ __attribute__((aligned(16))) unsigned char lds_raw[];
    LAS unsigned char* lds = (LAS unsigned char*)lds_raw;
    const int tid = threadIdx.x, lane = tid & 63, wave = __builtin_amdgcn_readfirstlane(tid >> 6);
    const int G = gridDim.x, bid = blockIdx.x;
    const int gw = bid * NWAVES + wave, ngw = G * NWAVES;
    unsigned char* ws = args_.ws;
    const int lo = args_.ph_lo, hi = args_.ph_hi;
    cg::grid_group grid = cg::this_grid();
    if (tid < 4) ((LAS unsigned*)(lds + LDS_BYTES - 16))[tid] = 0u;
    __syncthreads();
    const XcdBarrier xbar = xcd_barrier_post((unsigned*)(ws + WS_CTL) + 1024, (volatile LAS unsigned*)(lds + LDS_BYTES - 16));
#ifndef ONLYP
#define ONLYP -1
#endif
#define IN(k) ((ONLYP < 0 || ONLYP == (k)) && lo <= (k) && (k) < hi)
#ifndef SKIPLO
#define SKIPLO 100
#define SKIPHI 100
#endif
#define RUN(k) (IN(k) && !((k) >= SKIPLO && (k) <= SKIPHI))
#define SEAM(k) do { if (IN(k) && IN((k) + 1)) { if ((k) == 0) { asm volatile("s_waitcnt vmcnt(0)" ::: "memory"); grid.sync(); __builtin_amdgcn_fence(__ATOMIC_ACQUIRE, "agent"); asm volatile("s_waitcnt vmcnt(0)" ::: "memory"); __syncthreads(); } else xcd_barrier(xbar); } else __syncthreads(); } while (0)

    if (RUN(0)) { PHASE_IDS;
        LAS float* scr = (LAS float*)(lds + wave * 8448);
        {
            constexpr int I0 = (D / 64) * (N0 / 32);
            for (int it = gw; it < I0; it += ngw) transpose_item(args.in[I_WINE], D, EVEN_IN, N0, (bf16_t*)(ws + WS_WIN0), 0, scr, it, lane);
        }
        LAS float* wab = (LAS float*)(lds + 72 * 1024);
        __syncthreads();
        for (int i = tid; i < 8 * 1024; i += NTHREADS) { const int k = i >> 3, o = i & 7; wab[o * 1024 + k] = args.in[I_WINE][(size_t)k * EVEN_IN + N0 + o]; }
        __syncthreads();
        const float* x = args.in[I_X]; const float* gain = args.in[I_LNE];
        bf16_t* h0 = (bf16_t*)(ws + WS_HMIX0); float* bab = (float*)(ws + WS_BAB);
        f32x4 gn[4];
#pragma unroll
        for (int j = 0; j < 4; ++j) gn[j] = *((const f32x4*)gain + lane + 64 * j);
        for (int m = gw; m < T; m += ngw) {
            const f32x4* xr = (const f32x4*)(x + (size_t)m * D) + lane;
            f32x4 v[4]; float s = 0.f;
#pragma unroll
            for (int j = 0; j < 4; ++j) { v[j] = xr[64 * j]; s += (v[j][0] * v[j][0] + v[j][1] * v[j][1]) + (v[j][2] * v[j][2] + v[j][3] * v[j][3]); }
            const float rstd = rsqrtf(wave_sum(s) * (1.f / D) + EPS);
            float p[8];
#pragma unroll
            for (int o = 0; o < 8; ++o) p[o] = 0.f;
            unsigned long long* o8 = (unsigned long long*)(h0 + (size_t)m * D) + lane;
#pragma unroll
            for (int j = 0; j < 4; ++j) { v[j] = v[j] * rstd * gn[j];
                o8[64 * j] = (unsigned long long)cvt_pk_bf16(v[j][0], v[j][1]) | ((unsigned long long)cvt_pk_bf16(v[j][2], v[j][3]) << 32);
#pragma unroll
                for (int o = 0; o < 8; ++o) { const f32x4 w = *((const LAS f32x4*)(wab + o * 1024) + lane + 64 * j); p[o] += (v[j][0] * w[0] + v[j][1] * w[1]) + (v[j][2] * w[2] + v[j][3] * w[3]); } }
#pragma unroll
            for (int o = 0; o < 8; ++o) p[o] = wave_sum(p[o]);
            if (lane == 0) { *(f32x4*)(bab + (size_t)m * 8) = (f32x4){p[0], p[1], p[2], p[3]}; *(f32x4*)(bab + (size_t)m * 8 + 4) = (f32x4){p[4], p[5], p[6], p[7]}; }
        }
    }
    SEAM(0);

    if (RUN(1)) { PHASE_IDS;
        pg8::Gemm g{(const bf16_t*)(ws + WS_HMIX0), (const bf16_t*)(ws + WS_WIN0), D, D};
        pg8::DenseOrder S; S.init(T, N0, G, bid, D, D);
        pg8::EpiBf16 E{(bf16_t*)(ws + WS_PROJ0), N0};
        pg8::gemm_phase(lds, g, S, E);
    }
    SEAM(1);

    if (RUN(2)) { PHASE_IDS;
        const bf16_t* proj0 = (const bf16_t*)(ws + WS_PROJ0);
        const float* bab = (const float*)(ws + WS_BAB);
        const float* convw = args.in[I_CONVW];
        bf16_t* gUT = (bf16_t*)(ws + WS_GU); bf16_t* gW = (bf16_t*)(ws + WS_GW); bf16_t* gQD = (bf16_t*)(ws + WS_GQD); bf16_t* gKDT = (bf16_t*)(ws + WS_GKDT); bf16_t* gA = (bf16_t*)(ws + WS_GA);
        float* gGL = (float*)(ws + WS_GL);
        LAS bf16_t* Kb = (LAS bf16_t*)(lds);
        LAS bf16_t* Qb = (LAS bf16_t*)(lds + 17408);
        LAS float* Rm = (LAS float*)(lds + 34816);
        LAS float* Lm = (LAS float*)(lds + 100352);
        LAS float* gcs = (LAS float*)(lds + 116736);
        LAS float* bts = gcs + 64;
        const int fr = lane & 15, fq = lane >> 4;
        for (int item = bid; item < 2048; item += G) {
            const int b = item >> 8, n = (item >> 2) & 63, h = item & 3;
            const int t0 = b * SEQ + n * 64;
            if (wave == 0) {
                const int t = t0 + lane;
                const float a = bab[(size_t)t * 8 + h] + args.in[I_DTB][h], bb = bab[(size_t)t * 8 + 4 + h];
                const float sp = fmaxf(a, 0.f) + log1pf(__expf(-fabsf(a)));
                float gv = -__expf(args.in[I_ALOG][h]) * sp;
#pragma unroll
                for (int o = 1; o < 64; o <<= 1) { const float y = __shfl_up(gv, o); if (lane >= o) gv += y; }
                gcs[lane] = gv; bts[lane] = sigmoid_f(bb);
            }
            __syncthreads();
            {
                const int r = tid >> 3, d0 = (tid & 7) * 16;
                const float gc = gcs[r], beta = bts[r], glast = gcs[63];
                float qkv[3][16];
#pragma unroll
                for (int p = 0; p < 3; ++p) {
                    const int col = 768 + p * 512 + h * 128 + d0, wc0 = p * 512 + h * 128 + d0;
                    float acc[16];
#pragma unroll
                    for (int d = 0; d < 16; ++d) acc[d] = 0.f;
#pragma unroll
                    for (int j = 0; j < 4; ++j) {
                        const int srow = n * 64 + r - 3 + j;
                        if (srow >= 0) {
                            const u32x4* px = (const u32x4*)(proj0 + (size_t)(b * SEQ + srow) * N0 + col);
                            const u32x4 x0 = px[0], x1 = px[1];
                            const f32x4* pw = (const f32x4*)(convw + j * 1536 + wc0);
                            const f32x4 w0 = pw[0], w1 = pw[1], w2 = pw[2], w3 = pw[3];
                            acc[0] += w0[0] * lo_bf(x0.x); acc[1] += w0[1] * hi_bf(x0.x); acc[2] += w0[2] * lo_bf(x0.y); acc[3] += w0[3] * hi_bf(x0.y);
                            acc[4] += w1[0] * lo_bf(x0.z); acc[5] += w1[1] * hi_bf(x0.z); acc[6] += w1[2] * lo_bf(x0.w); acc[7] += w1[3] * hi_bf(x0.w);
                            acc[8] += w2[0] * lo_bf(x1.x); acc[9] += w2[1] * hi_bf(x1.x); acc[10] += w2[2] * lo_bf(x1.y); acc[11] += w2[3] * hi_bf(x1.y);
                            acc[12] += w3[0] * lo_bf(x1.z); acc[13] += w3[1] * hi_bf(x1.z); acc[14] += w3[2] * lo_bf(x1.w); acc[15] += w3[3] * hi_bf(x1.w);
                        }
                    }
#pragma unroll
                    for (int d = 0; d < 16; ++d) qkv[p][d] = silu_f(acc[d]);
                }
                float sq = 0.f, sk = 0.f;
#pragma unroll
                for (int d = 0; d < 16; ++d) { sq += qkv[0][d] * qkv[0][d]; sk += qkv[1][d] * qkv[1][d]; }
                sq += __shfl_xor(sq, 1); sq += __shfl_xor(sq, 2); sq += __shfl_xor(sq, 4);
                sk += __shfl_xor(sk, 1); sk += __shfl_xor(sk, 2); sk += __shfl_xor(sk, 4);
                const float qinv = rsqrtf(sq + EPS) * 0.08838834764831845f, kinv = rsqrtf(sk + EPS);
                const float eg = __expf(gc), ekd = __expf(glast - gc);
                u32x4 kw0, kw1, qw0, qw1, qd0, qd1;
                float kk[16], qq[16];
#pragma unroll
                for (int d = 0; d < 16; ++d) { kk[d] = qkv[1][d] * kinv; qq[d] = qkv[0][d] * qinv; }
                kw0.x = cvt_pk_bf16(kk[0], kk[1]); kw0.y = cvt_pk_bf16(kk[2], kk[3]); kw0.z = cvt_pk_bf16(kk[4], kk[5]); kw0.w = cvt_pk_bf16(kk[6], kk[7]);
                kw1.x = cvt_pk_bf16(kk[8], kk[9]); kw1.y = cvt_pk_bf16(kk[10], kk[11]); kw1.z = cvt_pk_bf16(kk[12], kk[13]); kw1.w = cvt_pk_bf16(kk[14], kk[15]);
                qw0.x = cvt_pk_bf16(qq[0], qq[1]); qw0.y = cvt_pk_bf16(qq[2], qq[3]); qw0.z = cvt_pk_bf16(qq[4], qq[5]); qw0.w = cvt_pk_bf16(qq[6], qq[7]);
                qw1.x = cvt_pk_bf16(qq[8], qq[9]); qw1.y = cvt_pk_bf16(qq[10], qq[11]); qw1.z = cvt_pk_bf16(qq[12], qq[13]); qw1.w = cvt_pk_bf16(qq[14], qq[15]);
                *(LAS u32x4*)(Kb + r * 136 + d0) = kw0; *(LAS u32x4*)(Kb + r * 136 + d0 + 8) = kw1;
                *(LAS u32x4*)(Qb + r * 136 + d0) = qw0; *(LAS u32x4*)(Qb + r * 136 + d0 + 8) = qw1;
#pragma unroll
                for (int d4 = 0; d4 < 4; ++d4) {
                    *(LAS f32x4*)(Rm + r * 256 + d0 + 4 * d4) = (f32x4){qkv[2][4 * d4] * beta, qkv[2][4 * d4 + 1] * beta, qkv[2][4 * d4 + 2] * beta, qkv[2][4 * d4 + 3] * beta};
                    const float bs = beta * eg;
                    *(LAS f32x4*)(Rm + r * 256 + 128 + d0 + 4 * d4) = (f32x4){kk[4 * d4] * bs, kk[4 * d4 + 1] * bs, kk[4 * d4 + 2] * bs, kk[4 * d4 + 3] * bs};
                }
                qd0.x = cvt_pk_bf16(qq[0] * eg, qq[1] * eg); qd0.y = cvt_pk_bf16(qq[2] * eg, qq[3] * eg); qd0.z = cvt_pk_bf16(qq[4] * eg, qq[5] * eg); qd0.w = cvt_pk_bf16(qq[6] * eg, qq[7] * eg);
                qd1.x = cvt_pk_bf16(qq[8] * eg, qq[9] * eg); qd1.y = cvt_pk_bf16(qq[10] * eg, qq[11] * eg); qd1.z = cvt_pk_bf16(qq[12] * eg, qq[13] * eg); qd1.w = cvt_pk_bf16(qq[14] * eg, qq[15] * eg);
                u32x4* pqd = (u32x4*)(gQD + ((size_t)item * 64 + r) * 128 + d0); pqd[0] = qd0; pqd[1] = qd1;
#pragma unroll
                for (int d = 0; d < 16; ++d) gKDT[((size_t)item * 128 + d0 + d) * 64 + r] = f2bf(kk[d] * ekd);
                if (tid == 0) gGL[(size_t)item * 32] = __expf(glast);
            }
            __syncthreads();
            {
                const int which = wave >> 2, mt = wave & 3;
                const LAS bf16_t* X = which ? Qb : Kb;
                for (int nt = 0; nt < 4; ++nt) {
                    f32x4 acc = (f32x4){0.f, 0.f, 0.f, 0.f};
                    if (nt <= mt) {
#pragma unroll
                        for (int s = 0; s < 4; ++s) {
                            const bf16x8 af = *(const LAS bf16x8*)(X + (16 * mt + fr) * 136 + 32 * s + 8 * fq);
                            const bf16x8 bfr = *(const LAS bf16x8*)(Kb + (16 * nt + fr) * 136 + 32 * s + 8 * fq);
                            acc = mfma16(af, bfr, acc);
                        }
                    }
                    const int j = 16 * nt + fr; const float gj = gcs[j];
#pragma unroll
                    for (int rg = 0; rg < 4; ++rg) {
                        const int i = 16 * mt + 4 * fq + rg;
                        const float dec = __expf(fminf(gcs[i] - gj, 0.f));
                        if (which == 0) Lm[i * 64 + j] = (i > j) ? bts[i] * acc[rg] * dec : 0.f;
                        else gA[((size_t)item * 64 + i) * 64 + j] = f2bf((i >= j) ? acc[rg] * dec : 0.f);
                    }
                }
            }
            __syncthreads();
            if (tid < 256) {
                const int c = tid;
                float U[64];
                int lnext = __builtin_bit_cast(int, Lm[lane]);
#pragma unroll
                for (int i = 0; i < 64; ++i) {
                    const int lrow = lnext;
                    if (i + 1 < 64) lnext = __builtin_bit_cast(int, Lm[(i + 1) * 64 + lane]);
                    float s0 = Rm[i * 256 + c], s1 = 0.f, s2 = 0.f, s3 = 0.f;
#pragma unroll
                    for (int j = 0; j < i; ++j) { const float l = __builtin_bit_cast(float, __builtin_amdgcn_readlane(lrow, j)); const float t = l * U[j]; if ((j & 3) == 0) s0 -= t; else if ((j & 3) == 1) s1 -= t; else if ((j & 3) == 2) s2 -= t; else s3 -= t; }
                    U[i] = (s0 + s1) + (s2 + s3);
                }
                if (c < 128) {
                    u32x4* pu = (u32x4*)(gUT + ((size_t)item * 128 + c) * 64);
#pragma unroll
                    for (int i8 = 0; i8 < 8; ++i8) { u32x4 o; o.x = cvt_pk_bf16(U[8 * i8], U[8 * i8 + 1]); o.y = cvt_pk_bf16(U[8 * i8 + 2], U[8 * i8 + 3]); o.z = cvt_pk_bf16(U[8 * i8 + 4], U[8 * i8 + 5]); o.w = cvt_pk_bf16(U[8 * i8 + 6], U[8 * i8 + 7]); pu[i8] = o; }
                } else {
#pragma unroll
                    for (int i = 0; i < 64; ++i) gW[((size_t)item * 64 + i) * 128 + (c - 128)] = f2bf(U[i]);
                }
            }
            __syncthreads();
        }
    }
    SEAM(2);

    if (RUN(3)) { PHASE_IDS;
        const bf16_t* proj0 = (const bf16_t*)(ws + WS_PROJ0);
        bf16_t* mix0 = (bf16_t*)(ws + WS_HMIX0);
        const int fr = lane & 15, fq = lane >> 4;
        if (bid < 32) {
            const bf16_t* gUT = (const bf16_t*)(ws + WS_GU); const bf16_t* gW = (const bf16_t*)(ws + WS_GW); const bf16_t* gQD = (const bf16_t*)(ws + WS_GQD); const bf16_t* gKDT = (const bf16_t*)(ws + WS_GKDT); const bf16_t* gA = (const bf16_t*)(ws + WS_GA);
            const float* gGL = (const float*)(ws + WS_GL);
            const int b = bid >> 2, h = bid & 3;
            constexpr int BUFB = 62464;
            LAS bf16_t* Obuf0 = (LAS bf16_t*)(lds + 2 * BUFB);
            const int wrow0 = tid >> 4, wch = tid & 15;
            const int krow0 = tid >> 3, kch = tid & 7;
            u32x4 pw[2], pq[2], pk[2], pa;
            u32x2 pu[4], pun[4]; u32x4 pz0, pz1; float glv, glvn = 0.f;
            f32x4 Sacc[8];
#pragma unroll
            for (int k = 0; k < 8; ++k) Sacc[k] = (f32x4){0.f, 0.f, 0.f, 0.f};
            LAS float* gnl = (LAS float*)(lds + 2 * BUFB + 2 * 17408);
            if (tid < 128) gnl[tid] = args.in[I_GDNG][tid];
#define GDN_LOAD(itm) do { const size_t _it = (size_t)(itm); \
                pw[0] = *(const u32x4*)(gW + (_it * 64 + wrow0) * 128 + wch * 8); pw[1] = *(const u32x4*)(gW + (_it * 64 + wrow0 + 32) * 128 + wch * 8); \
                pq[0] = *(const u32x4*)(gQD + (_it * 64 + wrow0) * 128 + wch * 8); pq[1] = *(const u32x4*)(gQD + (_it * 64 + wrow0 + 32) * 128 + wch * 8); \
                pk[0] = *(const u32x4*)(gKDT + (_it * 128 + krow0) * 64 + kch * 8); pk[1] = *(const u32x4*)(gKDT + (_it * 128 + krow0 + 64) * 64 + kch * 8); \
                pa = *(const u32x4*)(gA + (_it * 64 + krow0) * 64 + kch * 8); } while (0)
#define GDN_LOAD2(itm, U, GLV) do { const size_t _it = (size_t)(itm); \
                _Pragma("unroll") for (int mt = 0; mt < 4; ++mt) U[mt] = *(const u32x2*)(gUT + (_it * 128 + 16 * wave + fr) * 64 + 16 * mt + 4 * fq); \
                GLV = gGL[_it * 32]; } while (0)
#define GDN_STORE(bufi) do { LAS bf16_t* _W = (LAS bf16_t*)(lds + (bufi) * BUFB); LAS bf16_t* _Q = _W + 64 * 136; LAS bf16_t* _K = _Q + 64 * 136; LAS bf16_t* _A = _K + 128 * 72; \
                *(LAS u32x4*)(_W + wrow0 * 136 + wch * 8) = pw[0]; *(LAS u32x4*)(_W + (wrow0 + 32) * 136 + wch * 8) = pw[1]; \
                *(LAS u32x4*)(_Q + wrow0 * 136 + wch * 8) = pq[0]; *(LAS u32x4*)(_Q + (wrow0 + 32) * 136 + wch * 8) = pq[1]; \
                *(LAS u32x4*)(_K + krow0 * 72 + kch * 8) = pk[0]; *(LAS u32x4*)(_K + (krow0 + 64) * 72 + kch * 8) = pk[1]; \
                *(LAS u32x4*)(_A + krow0 * 72 + kch * 8) = pa; } while (0)
            GDN_LOAD((b * 64 + 0) * 4 + h); GDN_STORE(0);
            GDN_LOAD2((b * 64 + 0) * 4 + h, pu, glv);
            __syncthreads();
            for (int n = 0; n < 64; ++n) {
                const int item = (b * 64 + n) * 4 + h, cur = n & 1;
                const int t0 = b * SEQ + n * 64;
                const LAS bf16_t* Wl = (const LAS bf16_t*)(lds + cur * BUFB); const LAS bf16_t* Ql = Wl + 64 * 136; const LAS bf16_t* Kl = Ql + 64 * 136; const LAS bf16_t* Al = Kl + 128 * 72;
                LAS bf16_t* Obuf = Obuf0 + cur * (64 * 136);
                if (n + 1 < 64) { GDN_LOAD(item + 4); GDN_LOAD2(item + 4, pun, glvn); }
                { const u32x4* pz = (const u32x4*)(proj0 + (size_t)(t0 + (tid >> 3)) * N0 + 2304 + h * 128 + (tid & 7) * 16); pz0 = pz[0]; pz1 = pz[1]; }
                bf16x8 Sb[4];
#pragma unroll
                for (int s = 0; s < 4; ++s) Sb[s] = mk8f(Sacc[2 * s], Sacc[2 * s + 1]);
                f32x4 WS[4], QS[4];
#pragma unroll
                for (int mt = 0; mt < 4; ++mt) { WS[mt] = (f32x4){0.f, 0.f, 0.f, 0.f}; QS[mt] = (f32x4){0.f, 0.f, 0.f, 0.f};
#pragma unroll
                    for (int s = 0; s < 4; ++s) {
                        const LAS bf16_t* pwf = Wl + (16 * mt + fr) * 136 + 32 * s + 4 * fq;
                        WS[mt] = mfma16(mk8(*(const LAS u32x2*)pwf, *(const LAS u32x2*)(pwf + 16)), Sb[s], WS[mt]);
                        const LAS bf16_t* pqf = Ql + (16 * mt + fr) * 136 + 32 * s + 4 * fq;
                        QS[mt] = mfma16(mk8(*(const LAS u32x2*)pqf, *(const LAS u32x2*)(pqf + 16)), Sb[s], QS[mt]);
                    } }
                f32x4 vn[4];
#pragma unroll
                for (int mt = 0; mt < 4; ++mt) { vn[mt][0] = lo_bf(pu[mt].x) - WS[mt][0]; vn[mt][1] = hi_bf(pu[mt].x) - WS[mt][1]; vn[mt][2] = lo_bf(pu[mt].y) - WS[mt][2]; vn[mt][3] = hi_bf(pu[mt].y) - WS[mt][3]; }
                bf16x8 Vb[2];
                Vb[0] = mk8f(vn[0], vn[1]); Vb[1] = mk8f(vn[2], vn[3]);
#pragma unroll
                for (int mt = 0; mt < 4; ++mt)
#pragma unroll
                    for (int s2 = 0; s2 < 2; ++s2) { const LAS bf16_t* paf = Al + (16 * mt + fr) * 72 + 32 * s2 + 4 * fq;
                        QS[mt] = mfma16(mk8(*(const LAS u32x2*)paf, *(const LAS u32x2*)(paf + 16)), Vb[s2], QS[mt]); }
#pragma unroll
                for (int kt = 0; kt < 8; ++kt) { Sacc[kt] = Sacc[kt] * glv;
#pragma unroll
                    for (int s2 = 0; s2 < 2; ++s2) { const LAS bf16_t* pkf = Kl + (16 * kt + fr) * 72 + 32 * s2 + 4 * fq;
                        Sacc[kt] = mfma16(mk8(*(const LAS u32x2*)pkf, *(const LAS u32x2*)(pkf + 16)), Vb[s2], Sacc[kt]); } }
#pragma unroll
                for (int mt = 0; mt < 4; ++mt)
#pragma unroll
                    for (int rg = 0; rg < 4; ++rg) Obuf[(16 * mt + 4 * fq + rg) * 136 + 16 * wave + fr] = f2bf(QS[mt][rg]);
                if (n + 1 < 64) GDN_STORE(cur ^ 1);
                __syncthreads();
                {
                    const int r = tid >> 3, c0 = (tid & 7) * 16;
                    const u32x4 o0 = *(const LAS u32x4*)(Obuf + r * 136 + c0), o1 = *(const LAS u32x4*)(Obuf + r * 136 + c0 + 8);
                    float ov[16], zv[16];
                    ov[0] = lo_bf(o0.x); ov[1] = hi_bf(o0.x); ov[2] = lo_bf(o0.y); ov[3] = hi_bf(o0.y); ov[4] = lo_bf(o0.z); ov[5] = hi_bf(o0.z); ov[6] = lo_bf(o0.w); ov[7] = hi_bf(o0.w);
                    ov[8] = lo_bf(o1.x); ov[9] = hi_bf(o1.x); ov[10] = lo_bf(o1.y); ov[11] = hi_bf(o1.y); ov[12] = lo_bf(o1.z); ov[13] = hi_bf(o1.z); ov[14] = lo_bf(o1.w); ov[15] = hi_bf(o1.w);
                    float ss = 0.f;
#pragma unroll
                    for (int d = 0; d < 16; ++d) ss += ov[d] * ov[d];
                    ss += __shfl_xor(ss, 1); ss += __shfl_xor(ss, 2); ss += __shfl_xor(ss, 4);
                    const float rstd = rsqrtf(ss * (1.f / 128.f) + EPS);
                    zv[0] = lo_bf(pz0.x); zv[1] = hi_bf(pz0.x); zv[2] = lo_bf(pz0.y); zv[3] = hi_bf(pz0.y); zv[4] = lo_bf(pz0.z); zv[5] = hi_bf(pz0.z); zv[6] = lo_bf(pz0.w); zv[7] = hi_bf(pz0.w);
                    zv[8] = lo_bf(pz1.x); zv[9] = hi_bf(pz1.x); zv[10] = lo_bf(pz1.y); zv[11] = hi_bf(pz1.y); zv[12] = lo_bf(pz1.z); zv[13] = hi_bf(pz1.z); zv[14] = lo_bf(pz1.w); zv[15] = hi_bf(pz1.w);
#pragma unroll
                    for (int d = 0; d < 16; ++d) ov[d] = ov[d] * rstd * gnl[c0 + d] * silu_f(zv[d]);
                    u32x4 w0, w1;
                    w0.x = cvt_pk_bf16(ov[0], ov[1]); w0.y = cvt_pk_bf16(ov[2], ov[3]); w0.z = cvt_pk_bf16(ov[4], ov[5]); w0.w = cvt_pk_bf16(ov[6], ov[7]);
                    w1.x = cvt_pk_bf16(ov[8], ov[9]); w1.y = cvt_pk_bf16(ov[10], ov[11]); w1.z = cvt_pk_bf16(ov[12], ov[13]); w1.w = cvt_pk_bf16(ov[14], ov[15]);
                    u32x4* po = (u32x4*)(mix0 + (size_t)(t0 + r) * D + 512 + h * 128 + c0); po[0] = w0; po[1] = w1;
                }
#pragma unroll
                for (int mt = 0; mt < 4; ++mt) pu[mt] = pun[mt];
                glv = glvn;
            }
#undef GDN_LOAD2
#undef GDN_LOAD
#undef GDN_STORE
        } else {
            LAS bf16_t* Ks = (LAS bf16_t*)(lds);
            LAS bf16_t* Vt = (LAS bf16_t*)(lds + 27648);
            const float* qgain = args.in[I_QG]; const float* kgain = args.in[I_KG];
            const int nbk = G - 32;
            for (int it = bid - 32; it < 1024; it += nbk) {
                const int b = it >> 7, qb = (it >> 1) & 63, hk = it & 1;
                const int t0 = b * SEQ + qb * 64;
                __syncthreads();
#pragma unroll
                for (int i3 = 0; i3 < 3; ++i3) {
                    const int task = tid + NTHREADS * i3, key = task >> 3, dg = task & 7;
                    const int kp = qb * 64 - 128 + key;
                    u32x4 kr = (u32x4){0u, 0u, 0u, 0u}, vr = (u32x4){0u, 0u, 0u, 0u};
                    if (kp >= 0) { const bf16_t* pr = proj0 + (size_t)(b * SEQ + kp) * N0 + hk * 64 + 8 * dg; kr = *(const u32x4*)(pr + 512); vr = *(const u32x4*)(pr + 640); }
                    float kv[8];
                    kv[0] = lo_bf(kr.x); kv[1] = hi_bf(kr.x); kv[2] = lo_bf(kr.y); kv[3] = hi_bf(kr.y); kv[4] = lo_bf(kr.z); kv[5] = hi_bf(kr.z); kv[6] = lo_bf(kr.w); kv[7] = hi_bf(kr.w);
                    float ss = 0.f;
#pragma unroll
                    for (int i = 0; i < 8; ++i) ss += kv[i] * kv[i];
                    ss += __shfl_xor(ss, 1); ss += __shfl_xor(ss, 2); ss += __shfl_xor(ss, 4);
                    const float rstd = rsqrtf(ss * (1.f / 64.f) + EPS);
                    const f32x4 g0 = *(const f32x4*)(kgain + 8 * dg), g1 = *(const f32x4*)(kgain + 8 * dg + 4);
                    kv[0] *= rstd * g0[0]; kv[1] *= rstd * g0[1]; kv[2] *= rstd * g0[2]; kv[3] *= rstd * g0[3]; kv[4] *= rstd * g1[0]; kv[5] *= rstd * g1[1]; kv[6] *= rstd * g1[2]; kv[7] *= rstd * g1[3];
                    float pv[8];
#pragma unroll
                    for (int i = 0; i < 8; ++i) pv[i] = __shfl_xor(kv[i], 1);
                    if (dg < 2) {
#pragma unroll
                        for (int i = 0; i < 8; ++i) { float sn, cs; sincos_rev((float)kp * exp2f(-2.36644607f * (float)i), sn, cs);
                            kv[i] = (dg == 0) ? (kv[i] * cs - pv[i] * sn) : (kv[i] * cs + pv[i] * sn); }
                    }
                    u32x4 kw; kw.x = cvt_pk_bf16(kv[0], kv[1]); kw.y = cvt_pk_bf16(kv[2], kv[3]); kw.z = cvt_pk_bf16(kv[4], kv[5]); kw.w = cvt_pk_bf16(kv[6], kv[7]);
                    *(LAS u32x4*)(Ks + key * 72 + 8 * dg) = kw;
                    Vt[(8 * dg + 0) * 200 + key] = (bf16_t)(vr.x & 0xffffu); Vt[(8 * dg + 1) * 200 + key] = (bf16_t)(vr.x >> 16);
                    Vt[(8 * dg + 2) * 200 + key] = (bf16_t)(vr.y & 0xffffu); Vt[(8 * dg + 3) * 200 + key] = (bf16_t)(vr.y >> 16);
                    Vt[(8 * dg + 4) * 200 + key] = (bf16_t)(vr.z & 0xffffu); Vt[(8 * dg + 5) * 200 + key] = (bf16_t)(vr.z >> 16);
                    Vt[(8 * dg + 6) * 200 + key] = (bf16_t)(vr.w & 0xffffu); Vt[(8 * dg + 7) * 200 + key] = (bf16_t)(vr.w >> 16);
                }
                __syncthreads();
                const int g = wave >> 1, qs = wave & 1, hq = hk * 4 + g;
                const float sinkv = args.in[I_SINK][hq];
#pragma unroll
                for (int j2 = 0; j2 < 2; ++j2) {
                    const int qrow = 32 * qs + 16 * j2 + fr;
                    const int tq = t0 + qrow, qpos = qb * 64 + qrow;
                    bf16x8 Qf[2];
                    {
                        const u32x4 r0 = *(const u32x4*)(proj0 + (size_t)tq * N0 + hq * 64 + 8 * fq), r1 = *(const u32x4*)(proj0 + (size_t)tq * N0 + hq * 64 + 32 + 8 * fq);
                        float q0[8], q1[8];
                        q0[0] = lo_bf(r0.x); q0[1] = hi_bf(r0.x); q0[2] = lo_bf(r0.y); q0[3] = hi_bf(r0.y); q0[4] = lo_bf(r0.z); q0[5] = hi_bf(r0.z); q0[6] = lo_bf(r0.w); q0[7] = hi_bf(r0.w);
                        q1[0] = lo_bf(r1.x); q1[1] = hi_bf(r1.x); q1[2] = lo_bf(r1.y); q1[3] = hi_bf(r1.y); q1[4] = lo_bf(r1.z); q1[5] = hi_bf(r1.z); q1[6] = lo_bf(r1.w); q1[7] = hi_bf(r1.w);
                        float ss = 0.f;
#pragma unroll
                        for (int i = 0; i < 8; ++i) ss += q0[i] * q0[i] + q1[i] * q1[i];
                        ss += __shfl_xor(ss, 16); ss += __shfl_xor(ss, 32);
                        const float rstd = rsqrtf(ss * (1.f / 64.f) + EPS) * 0.125f;
#pragma unroll
                        for (int i = 0; i < 8; ++i) { q0[i] *= rstd * qgain[8 * fq + i]; q1[i] *= rstd * qgain[32 + 8 * fq + i]; }
                        float pv[8];
#pragma unroll
                        for (int i = 0; i < 8; ++i) pv[i] = __shfl_xor(q0[i], 16);
                        if (fq < 2) {
#pragma unroll
                            for (int i = 0; i < 8; ++i) { float sn, cs; sincos_rev((float)qpos * exp2f(-2.36644607f * (float)i), sn, cs);
                                q0[i] = (fq == 0) ? (q0[i] * cs - pv[i] * sn) : (q0[i] * cs + pv[i] * sn); }
                        }
                        u32x4 w0, w1;
                        w0.x = cvt_pk_bf16(q0[0], q0[1]); w0.y = cvt_pk_bf16(q0[2], q0[3]); w0.z = cvt_pk_bf16(q0[4], q0[5]); w0.w = cvt_pk_bf16(q0[6], q0[7]);
                        w1.x = cvt_pk_bf16(q1[0], q1[1]); w1.y = cvt_pk_bf16(q1[2], q1[3]); w1.z = cvt_pk_bf16(q1[4], q1[5]); w1.w = cvt_pk_bf16(q1[6], q1[7]);
                        Qf[0] = __builtin_bit_cast(bf16x8, w0); Qf[1] = __builtin_bit_cast(bf16x8, w1);
                    }
                    float mrun = sinkv, lrun = (fq == 0) ? 1.f : 0.f;
                    f32x4 Oa[4];
#pragma unroll
                    for (int dt = 0; dt < 4; ++dt) Oa[dt] = (f32x4){0.f, 0.f, 0.f, 0.f};
#pragma unroll
                    for (int kt = 0; kt < 3; ++kt) {
                        f32x4 sc[4];
                        float tmax = -1e30f;
#pragma unroll
                        for (int mt = 0; mt < 4; ++mt) { sc[mt] = (f32x4){0.f, 0.f, 0.f, 0.f};
#pragma unroll
                            for (int s = 0; s < 2; ++s) sc[mt] = mfma16(*(const LAS bf16x8*)(Ks + (64 * kt + 16 * mt + fr) * 72 + 32 * s + 8 * fq), Qf[s], sc[mt]);
#pragma unroll
                            for (int rg = 0; rg < 4; ++rg) { const int key = 64 * kt + 16 * mt + 4 * fq + rg; const int rel = 128 + qrow - key; const int kp = qb * 64 - 128 + key;
                                const bool ok = (rel >= 0) && (rel < 128) && (kp >= 0);
                                sc[mt][rg] = ok ? sc[mt][rg] : -1e30f; tmax = fmaxf(tmax, sc[mt][rg]); } }
                        tmax = fmaxf(tmax, __shfl_xor(tmax, 16)); tmax = fmaxf(tmax, __shfl_xor(tmax, 32));
                        const float mnew = fmaxf(mrun, tmax), alpha = __expf(mrun - mnew);
                        float ps = 0.f;
#pragma unroll
                        for (int mt = 0; mt < 4; ++mt)
#pragma unroll
                            for (int rg = 0; rg < 4; ++rg) { const float p = (sc[mt][rg] > -1e29f) ? __expf(sc[mt][rg] - mnew) : 0.f; sc[mt][rg] = p; ps += p; }
                        lrun = lrun * alpha + ps; mrun = mnew;
                        bf16x8 Pb[2]; Pb[0] = mk8f(sc[0], sc[1]); Pb[1] = mk8f(sc[2], sc[3]);
#pragma unroll
                        for (int dt = 0; dt < 4; ++dt) { Oa[dt] = Oa[dt] * alpha;
#pragma unroll
                            for (int s2 = 0; s2 < 2; ++s2) { const LAS bf16_t* pvf = Vt + (16 * dt + fr) * 200 + 64 * kt + 32 * s2 + 4 * fq;
                                Oa[dt] = mfma16(mk8(*(const LAS u32x2*)pvf, *(const LAS u32x2*)(pvf + 16)), Pb[s2], Oa[dt]); } }
                    }
                    lrun += __shfl_xor(lrun, 16); lrun += __shfl_xor(lrun, 32);
                    const float inv = 1.f / lrun;
#pragma unroll
                    for (int dt = 0; dt < 4; ++dt) { u32x2 w; w.x = cvt_pk_bf16(Oa[dt][0] * inv, Oa[dt][1] * inv); w.y = cvt_pk_bf16(Oa[dt][2] * inv, Oa[dt][3] * inv);
                        *(u32x2*)(mix0 + (size_t)tq * D + hq * 64 + 16 * dt + 4 * fq) = w; }
                }
            }
            __syncthreads();
            {
                LAS float* scr = (LAS float*)(lds + wave * 8448);
                const int gw2 = (bid - 32) * NWAVES + wave, ngw2 = nbk * NWAVES;
                constexpr int I1 = (D / 64) * (D / 32), I2 = (D / 64) * (ODD_IN / 32), I3 = (2048 / 64) * (D / 32);
                for (int it = gw2; it < I1 + I2 + I3; it += ngw2) {
                    int r = it;
                    if (r < I1) { transpose_item(args.in[I_WOUTE], D, D, D, (bf16_t*)(ws + WS_WOUT0), 0, scr, r, lane); continue; } r -= I1;
                    if (r < I2) { transpose_item(args.in[I_WINO], D, ODD_IN, ODD_IN, (bf16_t*)(ws + WS_WIN1), 0, scr, r, lane); continue; } r -= I2;
                    transpose_item(args.in[I_WOUTO], 2048, D, D, (bf16_t*)(ws + WS_WOUT1), 0, scr, r, lane);
                }
                convert_moe(args, 0, scr, gw2, ngw2, lane);
            }
        }
    }
    SEAM(3);

    if (RUN(4)) { PHASE_IDS;
        pg8::Gemm g{(const bf16_t*)(ws + WS_HMIX0), (const bf16_t*)(ws + WS_WOUT0), D, D};
        pg8::DenseOrder S; S.init(T, D, G, bid, D, D);
        pg8::EpiResF32 E{args.in[I_X], args.out, D};
        pg8::gemm_phase(lds, g, S, E);
    }
    SEAM(4);

    if (RUN(5)) { PHASE_IDS; moe_route(args, 0, lds, bid, G, tid, lane, wave); }
    SEAM(5);
    if (RUN(6)) { PHASE_IDS; moe_scatter(args, 0, lds, bid, G, tid, lane, wave); }
    SEAM(6);
    if (RUN(7)) { PHASE_IDS; moe_gemm1(args, 0, lds, bid, G, tid); }
    SEAM(7);
    if (RUN(8)) { PHASE_IDS; moe_gemm2(args, 0, lds, bid, G, tid); }
    SEAM(8);
    if (RUN(9)) { PHASE_IDS; moe_combine<true>(args, args.in[I_LNO], (bf16_t*)(ws + WS_H1), gw, ngw, lane); }
    SEAM(9);

    if (RUN(10)) { PHASE_IDS;
        pg8::Gemm g{(const bf16_t*)(ws + WS_H1), (const bf16_t*)(ws + WS_WIN1), D, D};
        pg8::DenseOrder S; S.init(T, ODD_IN, G, bid, D, D);
        pg8::EpiBf16 E{(bf16_t*)(ws + WS_PROJ1), ODD_IN};
        pg8::gemm_phase(lds, g, S, E);
    }
    SEAM(10);

    if (RUN(11)) { PHASE_IDS;
        bf16_t* proj1 = (bf16_t*)(ws + WS_PROJ1); bf16_t* inner = (bf16_t*)(ws + WS_INNER); bf16_t* kzT = (bf16_t*)(ws + WS_KZT);
        LAS bf16_t* Qs = (LAS bf16_t*)lds;
        LAS bf16_t* Ks = (LAS bf16_t*)(lds + 67584);
        const int fr = lane & 15, fq = lane >> 4;
        for (int item = bid; item < 1024; item += G) {
            const int b = item >> 7, n = (item >> 2) & 31, h = item & 3;
            const int t0 = b * SEQ + n * 128;
            const float l2g = logf(1.0f - exp2f(-5.0f - (float)h)) * 1.4426950408889634f;
            __syncthreads();
            {
                const int r = tid >> 2, seg = tid & 3;
                const float pos = (float)(n * 128 + r);
                bf16_t* pq = proj1 + (size_t)(t0 + r) * ODD_IN + h * 256 + 64 * seg;
#pragma unroll 2
                for (int c8 = 0; c8 < 8; ++c8) {
                    const u32x4 qr = *(const u32x4*)(pq + 8 * c8), kr = *(const u32x4*)(pq + 1024 + 8 * c8);
                    unsigned qw[4] = {qr.x, qr.y, qr.z, qr.w}, kw[4] = {kr.x, kr.y, kr.z, kr.w};
#pragma unroll
                    for (int pp = 0; pp < 4; ++pp) {
                        const int i = 32 * seg + 4 * c8 + pp;
                        float sn, cs; sincos_rev(pos * exp2f(-0.10462765655f * (float)i), sn, cs);
                        const float q1 = lo_bf(qw[pp]), q2 = hi_bf(qw[pp]), k1 = lo_bf(kw[pp]) * 0.0625f, k2 = hi_bf(kw[pp]) * 0.0625f;
                        qw[pp] = cvt_pk_bf16(q1 * cs - q2 * sn, q2 * cs + q1 * sn);
                        kw[pp] = cvt_pk_bf16(k1 * cs - k2 * sn, k2 * cs + k1 * sn);
                    }
                    const u32x4 qo = (u32x4){qw[0], qw[1], qw[2], qw[3]}, ko = (u32x4){kw[0], kw[1], kw[2], kw[3]};
                    *(u32x4*)(pq + 8 * c8) = qo;
                    *(LAS u32x4*)(Qs + r * 264 + 64 * seg + 8 * c8) = qo;
                    *(LAS u32x4*)(Ks + r * 264 + 64 * seg + 8 * c8) = ko;
                }
            }
            __syncthreads();
            {
                const int i = 16 * wave + fr;
                for (int jt = 0; jt < 8; ++jt) {
                    f32x4 acc = (f32x4){0.f, 0.f, 0.f, 0.f};
                    if (jt <= wave) {
#pragma unroll
                        for (int s = 0; s < 8; ++s)
                            acc = mfma16(*(const LAS bf16x8*)(Ks + (16 * jt + fr) * 264 + 32 * s + 8 * fq), *(const LAS bf16x8*)(Qs + (16 * wave + fr) * 264 + 32 * s + 8 * fq), acc);
                    }
                    float vv[4];
#pragma unroll
                    for (int rg = 0; rg < 4; ++rg) { const int j = 16 * jt + 4 * fq + rg; vv[rg] = (i >= j) ? acc[rg] * exp2f((float)(i - j) * l2g) : 0.f; }
                    u32x2 w; w.x = cvt_pk_bf16(vv[0], vv[1]); w.y = cvt_pk_bf16(vv[2], vv[3]);
                    *(u32x2*)(inner + ((size_t)item * 128 + i) * 128 + 16 * jt + 4 * fq) = w;
                }
            }
            {
                const int d = tid >> 1, half = tid & 1;
                u32x4* po = (u32x4*)(kzT + ((size_t)item * 256 + d) * 128 + 64 * half);
#pragma unroll
                for (int i8 = 0; i8 < 8; ++i8) {
                    float kv[8];
#pragma unroll
                    for (int e = 0; e < 8; ++e) { const int r = 64 * half + 8 * i8 + e; kv[e] = bf2f((unsigned)Ks[r * 264 + d]) * exp2f((float)(127 - r) * l2g); }
                    u32x4 o; o.x = cvt_pk_bf16(kv[0], kv[1]); o.y = cvt_pk_bf16(kv[2], kv[3]); o.z = cvt_pk_bf16(kv[4], kv[5]); o.w = cvt_pk_bf16(kv[6], kv[7]);
                    po[i8] = o;
                }
            }
        }
    }
    SEAM(11);

    if (RUN(12)) { PHASE_IDS;
        bf16_t* proj1 = (bf16_t*)(ws + WS_PROJ1); const bf16_t* inner = (const bf16_t*)(ws + WS_INNER); const bf16_t* kzT = (const bf16_t*)(ws + WS_KZT);
        float* SSQ = (float*)(ws + WS_SSQ);
        LAS bf16_t* Vt = (LAS bf16_t*)lds;
        LAS bf16_t* St = (LAS bf16_t*)(lds + 17408);
        const int fr = lane & 15, fq = lane >> 4;
        for (int wi = bid; wi < 256; wi += G) {
            const int xcd = wi & 7, jj = wi >> 3, bh = xcd * 4 + (jj >> 3), sl = jj & 7, b = bh >> 2, h = bh & 3;
            const float l2g = logf(1.0f - exp2f(-5.0f - (float)h)) * 1.4426950408889634f;
            const float gC = exp2f(128.0f * l2g);
            const float xi = exp2f((float)(16 * wave + fr + 1) * l2g);
            f32x4 Sacc[2][4];
#pragma unroll
            for (int mt = 0; mt < 2; ++mt)
#pragma unroll
                for (int nt = 0; nt < 4; ++nt) Sacc[mt][nt] = (f32x4){0.f, 0.f, 0.f, 0.f};
            __syncthreads();
            for (int i = tid; i < 64 * 264 / 2; i += NTHREADS) ((LAS unsigned*)St)[i] = 0u;
            const int vr = tid >> 2, vcs = tid & 3;
            const size_t vcol = 2048 + h * 512 + 64 * sl;
            u32x4 pv0, pv1;
            { const u32x4* pvp = (const u32x4*)(proj1 + (size_t)(b * SEQ + vr) * ODD_IN + vcol + 16 * vcs); pv0 = pvp[0]; pv1 = pvp[1]; }
#define RET_VSTORE() do { const unsigned _w[8] = {pv0.x, pv0.y, pv0.z, pv0.w, pv1.x, pv1.y, pv1.z, pv1.w}; \
                _Pragma("unroll") for (int _e = 0; _e < 8; ++_e) { Vt[(16 * vcs + 2 * _e) * 136 + vr] = (bf16_t)(_w[_e] & 0xffffu); Vt[(16 * vcs + 2 * _e + 1) * 136 + vr] = (bf16_t)(_w[_e] >> 16); } } while (0)
            RET_VSTORE();
            __syncthreads();
            bf16x8 qf[8], nf[4], kf[2][4]; u32x2 zr[4];
            {
                const int ti0 = b * SEQ + 16 * wave + fr; const int item0 = (b * 32) * 4 + h;
                const bf16_t* pq = proj1 + (size_t)ti0 * ODD_IN + h * 256 + 8 * fq;
#pragma unroll
                for (int s = 0; s < 8; ++s) qf[s] = *(const bf16x8*)(pq + 32 * s);
                const bf16_t* pin = inner + ((size_t)item0 * 128 + 16 * wave + fr) * 128 + 8 * fq;
#pragma unroll
                for (int s = 0; s < 4; ++s) nf[s] = *(const bf16x8*)(pin + 32 * s);
                const bf16_t* pk = kzT + ((size_t)item0 * 256 + 32 * wave + fr) * 128 + 8 * fq;
#pragma unroll
                for (int mt = 0; mt < 2; ++mt)
#pragma unroll
                    for (int s = 0; s < 4; ++s) kf[mt][s] = *(const bf16x8*)(pk + (size_t)mt * 16 * 128 + 32 * s);
                const bf16_t* pz = proj1 + (size_t)ti0 * ODD_IN + vcol + 4 * fq + 2048;
#pragma unroll
                for (int ct = 0; ct < 4; ++ct) zr[ct] = *(const u32x2*)(pz + 16 * ct);
            }
            for (int n = 0; n < 32; ++n) {
                const int item = (b * 32 + n) * 4 + h, t0 = b * SEQ + n * 128;
                const int ti = t0 + 16 * wave + fr;
                const bool more = (n + 1 < 32);
                if (more) { const u32x4* pvp = (const u32x4*)(proj1 + (size_t)(t0 + 128 + vr) * ODD_IN + vcol + 16 * vcs); pv0 = pvp[0]; pv1 = pvp[1]; }
                f32x4 ac[4], ai[4];
#pragma unroll
                for (int ct = 0; ct < 4; ++ct) { ac[ct] = (f32x4){0.f, 0.f, 0.f, 0.f}; ai[ct] = (f32x4){0.f, 0.f, 0.f, 0.f}; }
#pragma unroll
                for (int s = 0; s < 8; ++s)
#pragma unroll
                    for (int ct = 0; ct < 4; ++ct) ac[ct] = mfma16(*(const LAS bf16x8*)(St + (16 * ct + fr) * 264 + 32 * s + 8 * fq), qf[s], ac[ct]);
                if (more) { const bf16_t* pq = proj1 + (size_t)(ti + 128) * ODD_IN + h * 256 + 8 * fq;
#pragma unroll
                    for (int s = 0; s < 8; ++s) qf[s] = *(const bf16x8*)(pq + 32 * s); }
#pragma unroll
                for (int s = 0; s < 4; ++s)
#pragma unroll
                    for (int ct = 0; ct < 4; ++ct) ai[ct] = mfma16(*(const LAS bf16x8*)(Vt + (16 * ct + fr) * 136 + 32 * s + 8 * fq), nf[s], ai[ct]);
                if (more) { const bf16_t* pin = inner + ((size_t)(item + 4) * 128 + 16 * wave + fr) * 128 + 8 * fq;
#pragma unroll
                    for (int s = 0; s < 4; ++s) nf[s] = *(const bf16x8*)(pin + 32 * s); }
                {
                    float ssq = 0.f;
                    bf16_t* po = proj1 + (size_t)ti * ODD_IN + vcol + 4 * fq;
#pragma unroll
                    for (int ct = 0; ct < 4; ++ct) {
                        f32x4 o = ai[ct] + ac[ct] * xi;
                        ssq += (o[0] * o[0] + o[1] * o[1]) + (o[2] * o[2] + o[3] * o[3]);
                        u32x2 w; w.x = cvt_pk_bf16(o[0] * silu_f(lo_bf(zr[ct].x)), o[1] * silu_f(hi_bf(zr[ct].x))); w.y = cvt_pk_bf16(o[2] * silu_f(lo_bf(zr[ct].y)), o[3] * silu_f(hi_bf(zr[ct].y)));
                        *(u32x2*)(po + 16 * ct) = w;
                    }
                    if (more) {
#pragma unroll
                        for (int ct = 0; ct < 4; ++ct) zr[ct] = *(const u32x2*)(po + (size_t)128 * ODD_IN + 2048 + 16 * ct); }
                    ssq += __shfl_xor(ssq, 16); ssq += __shfl_xor(ssq, 32);
                    if (fq == 0) SSQ[((size_t)(h * 8 + sl)) * T + ti] = ssq;
                }
#pragma unroll
                for (int mt = 0; mt < 2; ++mt)
#pragma unroll
                    for (int nt = 0; nt < 4; ++nt) { Sacc[mt][nt] = Sacc[mt][nt] * gC;
#pragma unroll
                        for (int s = 0; s < 4; ++s) Sacc[mt][nt] = mfma16(kf[mt][s], *(const LAS bf16x8*)(Vt + (16 * nt + fr) * 136 + 32 * s + 8 * fq), Sacc[mt][nt]); }
                if (more) { const bf16_t* pk = kzT + ((size_t)(item + 4) * 256 + 32 * wave + fr) * 128 + 8 * fq;
#pragma unroll
                    for (int mt = 0; mt < 2; ++mt)
#pragma unroll
                        for (int s = 0; s < 4; ++s) kf[mt][s] = *(const bf16x8*)(pk + (size_t)mt * 16 * 128 + 32 * s); }
                __syncthreads();
#pragma unroll
                for (int mt = 0; mt < 2; ++mt)
#pragma unroll
                    for (int nt = 0; nt < 4; ++nt) { u32x2 w; w.x = cvt_pk_bf16(Sacc[mt][nt][0], Sacc[mt][nt][1]); w.y = cvt_pk_bf16(Sacc[mt][nt][2], Sacc[mt][nt][3]);
                        *(LAS u32x2*)(St + (16 * nt + fr) * 264 + 32 * wave + 16 * mt + 4 * fq) = w; }
                if (more) RET_VSTORE();
                __syncthreads();
            }
#undef RET_VSTORE
        }
    }
    SEAM(12);

    if (RUN(13)) { PHASE_IDS;
        bf16_t* proj1 = (bf16_t*)(ws + WS_PROJ1); const float* SSQ = (const float*)(ws + WS_SSQ);
        for (int t = gw; t < T; t += ngw) {
#pragma unroll
            for (int j = 0; j < 4; ++j) {
                float ssum = 0.f;
#pragma unroll
                for (int q8 = 0; q8 < 8; ++q8) ssum += SSQ[((size_t)(j * 8 + q8)) * T + t];
                const float rstd = rsqrtf(ssum * (1.f / 512.f) + EPS);
                u32x4* p = (u32x4*)(proj1 + (size_t)t * ODD_IN + 2048 + j * 512) + lane;
                const u32x4 v = *p; u32x4 o;
                o.x = cvt_pk_bf16(lo_bf(v.x) * rstd, hi_bf(v.x) * rstd); o.y = cvt_pk_bf16(lo_bf(v.y) * rstd, hi_bf(v.y) * rstd);
                o.z = cvt_pk_bf16(lo_bf(v.z) * rstd, hi_bf(v.z) * rstd); o.w = cvt_pk_bf16(lo_bf(v.w) * rstd, hi_bf(v.w) * rstd);
                *p = o;
            }
        }
        convert_moe(args, 1, (LAS float*)(lds + wave * 8448), gw, ngw, lane);
    }
    SEAM(13);

    if (RUN(14)) { PHASE_IDS;
        pg8::Gemm g{(const bf16_t*)(ws + WS_PROJ1) + 2048, (const bf16_t*)(ws + WS_WOUT1), ODD_IN, 2048};
        pg8::DenseOrder S; S.init(T, D, G, bid, ODD_IN, 2048);
        pg8::EpiResF32 E{args.out, args.out, D};
        pg8::gemm_phase(lds, g, S, E);
    }
    SEAM(14);

    if (RUN(15)) { PHASE_IDS; moe_route(args, 1, lds, bid, G, tid, lane, wave); }
    SEAM(15);
    if (RUN(16)) { PHASE_IDS; moe_scatter(args, 1, lds, bid, G, tid, lane, wave); }
    SEAM(16);
    if (RUN(17)) { PHASE_IDS; moe_gemm1(args, 1, lds, bid, G, tid); }
    SEAM(17);
    if (RUN(18)) { PHASE_IDS; moe_gemm2(args, 1, lds, bid, G, tid); }
    SEAM(18);
    if (RUN(19)) { PHASE_IDS; moe_combine<false>(args, nullptr, nullptr, gw, ngw, lane); }
#ifdef CKPROBE
    {
        xcd_barrier(xbar);
        unsigned* ckd = (unsigned*)(ws + WS_CTL) + 256;
        CKPROBE;
        xcd_barrier(xbar);
        const unsigned c = xb_ld(ckd);
        const float f = (float)((c >> 4) & 0xFFFFu) + 1.0f;
        f32x4* o = (f32x4*)args.out; for (size_t i = (size_t)bid * NTHREADS + tid; i < (size_t)T * D / 4; i += (size_t)G * NTHREADS) o[i] = (f32x4){f, f, f, f};
    }
#endif
#undef IN
#undef SEAM
}

extern "C" void kernel_launch(void* const* d_in, const int* in_sizes, int n_in, void* d_out, int out_size, void* d_ws, size_t ws_size, hipStream_t stream) {
    static int grid = 0;
    if (grid == 0) {
        if (n_in != 22 || in_sizes[0] != T * D || out_size != T * D || ws_size < WS_END) { fprintf(stderr, "kernel_launch: unexpected shapes / workspace (n_in %d, ws %zu, need %zu)\n", n_in, ws_size, (size_t)WS_END); grid = -1; return; }
        int dev = 0, cus = 0, per_cu = 0;
        (void)hipGetDevice(&dev); (void)hipDeviceGetAttribute(&cus, hipDeviceAttributeMultiprocessorCount, dev);
        if (hipFuncSetAttribute((const void*)fwd_kernel, hipFuncAttributeMaxDynamicSharedMemorySize, LDS_BYTES) != hipSuccess) { fprintf(stderr, "kernel_launch: hipFuncSetAttribute failed\n"); grid = -1; return; }
        if (hipOccupancyMaxActiveBlocksPerMultiprocessor(&per_cu, (const void*)fwd_kernel, NTHREADS, LDS_BYTES) != hipSuccess || per_cu < 1) { fprintf(stderr, "kernel_launch: occupancy query says %d\n", per_cu); grid = -1; return; }
        (void)hipGetLastError();
        grid = cus;
    }
    if (grid < 0) return;
    (void)hipMemsetAsync((char*)d_ws + WS_CTL, 0, 32768, stream);
    Args a{};
    for (int i = 0; i < 22; ++i) a.in[i] = (const float*)d_in[i];
    a.out = (float*)d_out; a.ws = (unsigned char*)d_ws; a.ph_lo = 0; a.ph_hi = PHHI;
    void* kargs[] = {&a};
    hipError_t e = hipLaunchCooperativeKernel((const void*)fwd_kernel, dim3(grid), dim3(NTHREADS), kargs, LDS_BYTES, stream);
    if (e != hipSuccess) fprintf(stderr, "kernel_launch: cooperative launch failed: %s (grid %d)\n", hipGetErrorString(e), grid);
}
```

```cpp
#include <hip/hip_runtime.h>
#include <hip/hip_cooperative_groups.h>
#include <cstdio>
#include <cstdint>
namespace cg = cooperative_groups;

#define LAS __attribute__((address_space(3)))
typedef unsigned short bf16_t;
typedef short bf16x8 __attribute__((ext_vector_type(8)));
typedef float f32x4 __attribute__((ext_vector_type(4)));
typedef float f32x2 __attribute__((ext_vector_type(2)));
typedef unsigned u32x4 __attribute__((ext_vector_type(4)));
typedef unsigned u32x2 __attribute__((ext_vector_type(2)));

constexpr int NB = 8, SEQ = 4096, D = 1024, T = NB * SEQ;
constexpr int EVEN_IN = 2824, N0 = 2816;
constexpr int ODD_IN = 6144;
constexpr int NEXP = 32, DEXP = 512;
constexpr int ROWS_PAD = 73728;
constexpr float EPS = 1e-6f;
constexpr int NWAVES = 8, NTHREADS = 512;
constexpr int LDS_BYTES = 163840;

constexpr size_t MiB = 1u << 20;
constexpr size_t WS_CTL = 0;
constexpr size_t WS_WIN0 = 1 * MiB;
constexpr size_t WS_WOUT0 = 7 * MiB;
constexpr size_t WS_WIN1 = 9 * MiB;
constexpr size_t WS_WOUT1 = 21 * MiB;
constexpr size_t WS_X = 25 * MiB;
constexpr size_t WS_XB1 = WS_X;
constexpr size_t WS_XB2 = WS_X + 64 * MiB;
constexpr size_t WS_H1 = WS_X;
constexpr size_t WS_INNER = WS_X;
constexpr size_t WS_KZT = WS_X + 32 * MiB;
constexpr size_t WS_SM = 121 * MiB;
constexpr size_t WS_BAB = WS_SM;
constexpr size_t WS_RE = WS_SM + 1 * MiB;
constexpr size_t WS_RG = WS_RE + 256 * 1024;
constexpr size_t WS_RS = WS_RG + 256 * 1024;
constexpr size_t WS_RP = WS_RS + 256 * 1024;
constexpr size_t WS_SSQ = WS_SM + 2 * MiB;
constexpr size_t WS_GL = WS_SM + 6 * MiB;
constexpr size_t WS_BC = WS_SM + 7 * MiB;
constexpr size_t WS_A = 129 * MiB;
constexpr size_t WS_PROJ0 = WS_A;
constexpr size_t WS_HMIX0 = WS_A + 176 * MiB;
constexpr size_t WS_GU = WS_A + 240 * MiB;
constexpr size_t WS_GW = WS_A + 272 * MiB;
constexpr size_t WS_GQD = WS_A + 304 * MiB;
constexpr size_t WS_GKDT = WS_A + 336 * MiB;
constexpr size_t WS_GA = WS_A + 368 * MiB;
constexpr size_t WS_XN = WS_A;
constexpr size_t WS_XROWS = WS_A + 64 * MiB;
constexpr size_t WS_HID = WS_A + 208 * MiB;
constexpr size_t WS_PROJ1 = WS_A;
constexpr size_t WS_END = 513 * MiB;

__device__ __forceinline__ float bf2f(unsigned b) { return __uint_as_float(b << 16); }
typedef __bf16 bf16x2_t __attribute__((ext_vector_type(2)));
__device__ __forceinline__ unsigned cvt_pk_bf16(float lo, float hi) { f32x2 v = {lo, hi}; bf16x2_t b = __builtin_convertvector(v, bf16x2_t); return __builtin_bit_cast(unsigned, b); }
__device__ __forceinline__ unsigned short f2bf(float f) { return (unsigned short)(cvt_pk_bf16(f, 0.f) & 0xffffu); }
__device__ __forceinline__ float lo_bf(unsigned w) { return __uint_as_float(w << 16); }
__device__ __forceinline__ float hi_bf(unsigned w) { return __uint_as_float(w & 0xffff0000u); }
__device__ __forceinline__ float silu_f(float x) { return x / (1.0f + __expf(-x)); }
__device__ __forceinline__ float sigmoid_f(float x) { return 1.0f / (1.0f + __expf(-x)); }
__device__ __forceinline__ f32x4 mfma16(bf16x8 a, bf16x8 b, f32x4 c) { return __builtin_amdgcn_mfma_f32_16x16x32_bf16(a, b, c, 0, 0, 0); }
__device__ __forceinline__ bf16x8 mk8(u32x2 lo, u32x2 hi) { u32x4 v; v.x = lo.x; v.y = lo.y; v.z = hi.x; v.w = hi.y; return __builtin_bit_cast(bf16x8, v); }
__device__ __forceinline__ bf16x8 mk8f(f32x4 a, f32x4 b) { u32x4 v; v.x = cvt_pk_bf16(a[0], a[1]); v.y = cvt_pk_bf16(a[2], a[3]); v.z = cvt_pk_bf16(b[0], b[1]); v.w = cvt_pk_bf16(b[2], b[3]); return __builtin_bit_cast(bf16x8, v); }
__device__ __forceinline__ float wave_sum(float v) {
#pragma unroll
    for (int o = 1; o < 64; o <<= 1) v += __shfl_xor(v, o);
    return v;
}
__device__ __forceinline__ void sincos_rev(float ang, float& s, float& c) {
    float r = ang * 0.15915494309189535f; r = r - floorf(r);
    s = __builtin_amdgcn_sinf(r); c = __builtin_amdgcn_cosf(r);
}

namespace pg8 {
constexpr int BM = 256, BK = 64, HALF = 128, HTB = HALF * BK * 2, STAGE_BYTES = 8 * HTB, NXCD = 8, WGM = 8;
__device__ __forceinline__ int lds_byte(int r, int c) { const int st = (r >> 4) * 2 + (c >> 5), rr = r & 15, cc = c & 31, ob = rr * 64 + cc * 2; return st * 1024 + (ob ^ (((ob >> 9) & 1) << 5)); }
__device__ __forceinline__ void stage_rc(int b, int& R, int& C) { const int st = b / 1024, sb = b % 1024, swz = sb ^ (((sb >> 9) & 1) << 5); R = (st >> 1) * 16 + swz / 64; C = (st & 1) * 32 + (swz % 64) / 2; }
__device__ __forceinline__ int perm32(int rho) { const int n = rho >> 4, i = rho & 15; return 8 * (i >> 2) + 4 * n + (i & 3); }

struct Unit { size_t aoff, boff; int pm, pn; };
struct Gemm { const bf16_t* A; const bf16_t* Bt; int lda, K; };

struct DenseOrder {
    int nM, nN, nwg, G, c, lda, K;
    __device__ void init(int M, int N, int G_, int c_, int lda_, int K_) { nM = M / BM; nN = N / BM; nwg = nM * nN; G = G_; c = c_; lda = lda_; K = K_; }
    __device__ bool next(int i, Unit& u) const {
        const long L = (long)i * G + c; if (L >= nwg) return false;
        int wgid = (int)L; { const int q = nwg / NXCD, r = nwg % NXCD, xcd = wgid % NXCD, off = wgid / NXCD; wgid = (xcd < r ? xcd * (q + 1) : r * (q + 1) + (xcd - r) * q) + off; }
        const int nig = WGM * nN, gid = wgid / nig, fm = gid * WGM, gsz = (nM - fm) < WGM ? (nM - fm) : WGM;
        u.pm = fm + ((wgid % nig) % gsz); u.pn = (wgid % nig) / gsz;
        u.aoff = (size_t)u.pm * BM * lda * 2; u.boff = (size_t)u.pn * BM * K * 2; return true;
    }
};
struct GroupedOrder {
    const LAS int* tile_e; int ntiles, G, c, lda, K; size_t estride;
    __device__ bool next(int i, Unit& u) const {
        const int L = i * G + c; if (L >= ntiles * 4) return false;
        const int rt = L >> 2, pn = L & 3; const int e = tile_e[rt];
        u.pm = rt; u.pn = pn; u.aoff = (size_t)rt * BM * lda * 2; u.boff = (size_t)e * estride + (size_t)pn * BM * K * 2; return true;
    }
};

struct EpiBf16 {
    static constexpr bool PERM = true;
    bf16_t* O; int ldc;
    __device__ __forceinline__ void operator()(const f32x4 (&acc)[2][2][4][2], const Unit& u, int wr, int wc, int fr, int fq) const {
        const int row0 = u.pm * BM + wr * 64 + fr; const int col0 = u.pn * BM + wc * 32 + 8 * fq;
#pragma unroll
        for (int ai = 0; ai < 2; ++ai)
#pragma unroll
            for (int m = 0; m < 4; ++m) { bf16_t* rowp = O + (size_t)(row0 + ai * HALF + m * 16) * ldc + col0;
#pragma unroll
                for (int bj = 0; bj < 2; ++bj) { const f32x4 v0 = acc[ai][bj][m][0], v1 = acc[ai][bj][m][1];
                    u32x4 w; w.x = cvt_pk_bf16(v0[0], v0[1]); w.y = cvt_pk_bf16(v0[2], v0[3]); w.z = cvt_pk_bf16(v1[0], v1[1]); w.w = cvt_pk_bf16(v1[2], v1[3]);
                    *(u32x4*)(rowp + bj * HALF) = w; } }
    }
};
struct EpiResF32 {
    static constexpr bool PERM = false;
    const float* base; float* out; int ldc;
    __device__ __forceinline__ void operator()(const f32x4 (&acc)[2][2][4][2], const Unit& u, int wr, int wc, int fr, int fq) const {
        const int row0 = u.pm * BM + wr * 64 + fr, col0 = u.pn * BM + wc * 32 + 4 * fq;
#pragma unroll
        for (int ai = 0; ai < 2; ++ai)
#pragma unroll
            for (int m = 0; m < 4; ++m) { const size_t off = (size_t)(row0 + ai * HALF + m * 16) * ldc + col0;
#pragma unroll
                for (int bj = 0; bj < 2; ++bj)
#pragma unroll
                    for (int n = 0; n < 2; ++n) { const f32x4 b = *(const f32x4*)(base + off + bj * HALF + n * 16); *(f32x4*)(out + off + bj * HALF + n * 16) = b + acc[ai][bj][m][n]; } }
    }
};
struct EpiSwiGLU {
    static constexpr bool PERM = false;
    bf16_t* H;
    __device__ __forceinline__ void operator()(const f32x4 (&acc)[2][2][4][2], const Unit& u, int wr, int wc, int fr, int fq) const {
        const int row0 = u.pm * BM + wr * 64 + fr;
#pragma unroll
        for (int ai = 0; ai < 2; ++ai)
#pragma unroll
            for (int m = 0; m < 4; ++m) { bf16_t* rowp = H + (size_t)(row0 + ai * HALF + m * 16) * DEXP;
#pragma unroll
                for (int bj = 0; bj < 2; ++bj) { const f32x4 g = acc[ai][bj][m][0], up = acc[ai][bj][m][1];
                    const int hc = 16 * (8 * u.pn + 4 * bj + wc) + 4 * fq;
                    u32x2 w; w.x = cvt_pk_bf16(silu_f(g[0]) * up[0], silu_f(g[1]) * up[1]); w.y = cvt_pk_bf16(silu_f(g[2]) * up[2], silu_f(g[3]) * up[3]);
                    *(u32x2*)(rowp + hc) = w; } }
    }
};

template <class Epi, class Sched>
__device__ __forceinline__ void gemm_phase(LAS unsigned char* lds, const Gemm g, const Sched& S, const Epi& E) {
    const int tid = threadIdx.x, wid = __builtin_amdgcn_readfirstlane(tid >> 6), lane = tid & 63, wr = wid >> 2, wc = wid & 3, fr = lane & 15, fq = lane >> 4;
    const int K = g.K, nt = K / BK;
    unsigned voffA[2], voffB[2];
#pragma unroll
    for (int i = 0; i < 2; ++i) { int R, C; stage_rc(tid * 16 + i * 8192, R, C); const int Rb = Epi::PERM ? ((R & ~31) + perm32(R & 31)) : R;
        voffA[i] = (unsigned)(R * g.lda + C) * 2u; voffB[i] = (unsigned)(Rb * K + C) * 2u; }
    const size_t kstep = (size_t)(BK * 2);
    const size_t hstepA = (size_t)HALF * g.lda * 2, hstepB = (size_t)HALF * K * 2;
    const unsigned ldsw = (unsigned)wid * 1024u;
    const int aoff = lds_byte(wr * 64 + fr, fq * 8), boff = lds_byte(wc * 32 + fr, fq * 8);
#define PG8_SA(b, h) (((b) * 2 + (h)) * HTB)
#define PG8_SB(b, h) ((4 + (b) * 2 + (h)) * HTB)
#define PG8_STAGE(bufoff, gbase, voff) do { _Pragma("unroll") for (int _i = 0; _i < 2; ++_i) \
        __builtin_amdgcn_global_load_lds((const unsigned*)((const char*)(gbase) + (voff)[_i]), (LAS unsigned*)(lds + (bufoff) + ldsw + _i * 8192), 16, 0, 0); } while (0)
#define PG8_LDA(dst, b, h) do { _Pragma("unroll") for (int m = 0; m < 4; ++m) _Pragma("unroll") for (int k = 0; k < 2; ++k) dst[m][k] = *(const LAS bf16x8*)(lds + PG8_SA(b, h) + aoff + m * 2048 + k * 1024); } while (0)
#define PG8_LDB(dst, b, h) do { _Pragma("unroll") for (int n = 0; n < 2; ++n) _Pragma("unroll") for (int k = 0; k < 2; ++k) dst[n][k] = *(const LAS bf16x8*)(lds + PG8_SB(b, h) + boff + n * 2048 + k * 1024); } while (0)
#define PG8_MMA(ai, bj, At, Bt) do { __builtin_amdgcn_s_setprio(1); _Pragma("unroll") for (int m = 0; m < 4; ++m) _Pragma("unroll") for (int n = 0; n < 2; ++n) _Pragma("unroll") for (int k = 0; k < 2; ++k) \
        acc[ai][bj][m][n] = __builtin_amdgcn_mfma_f32_16x16x32_bf16(Bt[n][k], At[m][k], acc[ai][bj][m][n], 0, 0, 0); __builtin_amdgcn_s_setprio(0); } while (0)
#define PG8_WAIT_V(n) asm volatile("s_waitcnt vmcnt(" #n ")" ::: "memory")
#define PG8_WAIT_L(n) asm volatile("s_waitcnt lgkmcnt(" #n ")" ::: "memory")
#define PG8_BAR __builtin_amdgcn_s_barrier()
#define PG8_SCHED __builtin_amdgcn_sched_barrier(0)
    Unit cur, nxt; int ui = 0;
    if (!S.next(0, cur)) return;
    f32x4 acc[2][2][4][2];
#pragma unroll
    for (int a = 0; a < 2; ++a)
#pragma unroll
        for (int b = 0; b < 2; ++b)
#pragma unroll
            for (int m = 0; m < 4; ++m)
#pragma unroll
                for (int n = 0; n < 2; ++n) acc[a][b][m][n] = (f32x4){0.f, 0.f, 0.f, 0.f};
    bf16x8 At[4][2], B0[2][2], B1[2][2];
    const char* cA = (const char*)g.A + cur.aoff; const char* cB = (const char*)g.Bt + cur.boff;
    PG8_STAGE(PG8_SB(0, 0), cB, voffB); PG8_STAGE(PG8_SB(0, 1), cB + hstepB, voffB); PG8_STAGE(PG8_SA(0, 0), cA, voffA); PG8_STAGE(PG8_SA(0, 1), cA + hstepA, voffA);
    if (wr == 1) PG8_BAR;
    PG8_WAIT_V(2); PG8_BAR;
    PG8_STAGE(PG8_SB(1, 0), cB + kstep, voffB); PG8_STAGE(PG8_SA(1, 0), cA + kstep, voffA); PG8_STAGE(PG8_SB(1, 1), cB + hstepB + kstep, voffB);
    PG8_WAIT_V(6); PG8_BAR;
    for (;;) {
        const bool has_next = S.next(ui + 1, nxt);
        const char* nA = has_next ? (const char*)g.A + nxt.aoff : cA; const char* nB = has_next ? (const char*)g.Bt + nxt.boff : cB;
        for (int t = 0; t < nt; t += 2) {
            const bool last = (t == nt - 2);
            const char* a1 = cA + (size_t)(t + 1) * kstep;
            const char* a2 = last ? nA : cA + (size_t)(t + 2) * kstep; const char* b2 = last ? nB : cB + (size_t)(t + 2) * kstep;
            const char* a3 = a2 + kstep; const char* b3 = b2 + kstep;
            PG8_LDB(B0, 0, 0); PG8_LDB(B1, 0, 1); PG8_SCHED; PG8_LDA(At, 0, 0); PG8_STAGE(PG8_SA(1, 1), a1 + hstepA, voffA);
            PG8_WAIT_V(8); PG8_WAIT_L(0); PG8_BAR; PG8_MMA(0, 0, At, B0); PG8_MMA(0, 1, At, B1); PG8_BAR; PG8_SCHED;
            PG8_LDA(At, 0, 1); PG8_STAGE(PG8_SB(0, 0), b2, voffB); PG8_STAGE(PG8_SB(0, 1), b2 + hstepB, voffB); PG8_STAGE(PG8_SA(0, 0), a2, voffA);
            PG8_WAIT_V(8); PG8_WAIT_L(0); PG8_BAR; PG8_MMA(1, 0, At, B0); PG8_MMA(1, 1, At, B1); PG8_BAR; PG8_SCHED;
            PG8_LDB(B0, 1, 0); PG8_LDB(B1, 1, 1); PG8_SCHED; PG8_LDA(At, 1, 0); PG8_STAGE(PG8_SA(0, 1), a2 + hstepA, voffA);
            PG8_WAIT_V(8); PG8_WAIT_L(0); PG8_BAR; PG8_MMA(0, 0, At, B0); PG8_MMA(0, 1, At, B1); PG8_BAR; PG8_SCHED;
            PG8_LDA(At, 1, 1); PG8_STAGE(PG8_SB(1, 0), b3, voffB); PG8_STAGE(PG8_SB(1, 1), b3 + hstepB, voffB); PG8_STAGE(PG8_SA(1, 0), a3, voffA);
            PG8_WAIT_V(8); PG8_WAIT_L(0); PG8_BAR; PG8_MMA(1, 0, At, B0); PG8_MMA(1, 1, At, B1); PG8_BAR; PG8_SCHED;
        }
        if (wr == 0) PG8_BAR;
        E(acc, cur, wr, wc, fr, fq);
        if (!has_next) break;
#pragma unroll
        for (int a = 0; a < 2; ++a)
#pragma unroll
            for (int b = 0; b < 2; ++b)
#pragma unroll
                for (int m = 0; m < 4; ++m)
#pragma unroll
                    for (int n = 0; n < 2; ++n) acc[a][b][m][n] = (f32x4){0.f, 0.f, 0.f, 0.f};
        cur = nxt; cA = nA; cB = nB; ++ui;
        if (wr == 1) PG8_BAR;
    }
    PG8_WAIT_V(0);
    PG8_BAR;
#undef PG8_SA
#undef PG8_SB
#undef PG8_STAGE
#undef PG8_LDA
#undef PG8_LDB
#undef PG8_MMA
#undef PG8_WAIT_V
#undef PG8_WAIT_L
#undef PG8_BAR
#undef PG8_SCHED
}
}

#define XB_TMO      128
#define XB_XCNT(j)  (256  + 64 * (j))
#define XB_XSUB(j)  (1280 + 64 * (j))
#define XB_XGEN(j)  (2304 + 64 * (j))
#define XB_TOP      3328
#define XB_TOPGEN   3392
#define XCD_BAR_WORDS 3456
#define XB_SPIN_CAP (1u << 18)
__device__ __forceinline__ unsigned xb_ld(unsigned* p)              { return __hip_atomic_load(p, __ATOMIC_RELAXED, __HIP_MEMORY_SCOPE_AGENT); }
__device__ __forceinline__ unsigned xb_add(unsigned* p, unsigned v) { return __hip_atomic_fetch_add(p, v, __ATOMIC_RELAXED, __HIP_MEMORY_SCOPE_AGENT); }
__device__ __forceinline__ unsigned xb_xcc_id() { return (unsigned)__builtin_amdgcn_s_getreg((3 << 11) | 20) & 0xFu; }
#define XB_SPIN(cond, bar) do { unsigned _sp = 0; while (cond) { __builtin_amdgcn_s_sleep(1); \
    if ((++_sp & 255u) == 0u) { if (xb_ld(&(bar)[XB_TMO])) break; if (_sp > XB_SPIN_CAP) { atomicAdd(&(bar)[XB_TMO], 1u); break; } } } } while (0)
struct XcdBarrier { unsigned* bar; unsigned x; volatile LAS unsigned* st; };
__device__ __forceinline__ XcdBarrier xcd_barrier_post(unsigned* bar, volatile LAS unsigned* st) {
    XcdBarrier b; b.bar = bar; b.x = xb_xcc_id(); b.st = st;
    if (threadIdx.x == 0) (void)xb_add(&bar[XB_XCNT(b.x)], 1u);
    return b;
}
__device__ __forceinline__ void xcd_barrier_complete(unsigned* bar, unsigned x, unsigned& nloc, unsigned& nx) {
    const unsigned G = gridDim.x * gridDim.y * gridDim.z;
    unsigned sum, cnt, mine, sp = 0u;
    for (;;) {
        sum = 0u; cnt = 0u; mine = 0u;
#pragma unroll
        for (unsigned j = 0; j < 16; ++j) { const unsigned c = xb_ld(&bar[XB_XCNT(j)]); sum += c; cnt += (c > 0u) ? 1u : 0u; mine = (j == x) ? c : mine; }
        if (sum == G) break;
        __builtin_amdgcn_s_sleep(1);
        if ((++sp & 255u) == 0u) { if (xb_ld(&bar[XB_TMO])) break; if (sp > XB_SPIN_CAP) { atomicAdd(&bar[XB_TMO], 1u); break; } }
    }
    nloc = mine > 0u ? mine : 1u; nx = cnt > 0u ? cnt : 1u;
}
__device__ __forceinline__ void xcd_barrier(const XcdBarrier& b) {
    asm volatile("s_waitcnt vmcnt(0)" ::: "memory");
    __syncthreads();
    if (threadIdx.x == 0) {
        unsigned* bar = b.bar;
        __builtin_amdgcn_s_waitcnt(0);
        unsigned nloc = b.st[0], nx = b.st[1];
        if (nloc == 0u) { xcd_barrier_complete(bar, b.x, nloc, nx); b.st[0] = nloc; b.st[1] = nx; }
        const unsigned old = xb_add(&bar[XB_XSUB(b.x)], 1u);
        const unsigned gen = old / nloc;
        if (old + 1u == (gen + 1u) * nloc) {
            __builtin_amdgcn_fence(__ATOMIC_RELEASE, "agent");
            asm volatile("s_waitcnt vmcnt(0)" ::: "memory");
            const unsigned og = xb_add(&bar[XB_TOP], 1u);
            const unsigned tg = og / nx;
            if (og + 1u == (tg + 1u) * nx) xb_add(&bar[XB_TOPGEN], 1u);
            else XB_SPIN(xb_ld(&bar[XB_TOPGEN]) == tg, bar);
            __builtin_amdgcn_fence(__ATOMIC_ACQUIRE, "agent");
            xb_add(&bar[XB_XGEN(b.x)], 1u);
            asm volatile("s_waitcnt vmcnt(0)" ::: "memory");
        } else {
            XB_SPIN(xb_ld(&bar[XB_XGEN(b.x)]) == gen, bar);
            __builtin_amdgcn_fence(__ATOMIC_ACQUIRE, "agent");
            asm volatile("s_waitcnt vmcnt(0)" ::: "memory");
        }
    }
    __syncthreads();
}

struct Args {
    const float* in[22];
    float* out; unsigned char* ws;
    int ph_lo, ph_hi;
};
enum { I_X = 0, I_LNE, I_WINE, I_CONVW, I_ALOG, I_DTB, I_QG, I_KG, I_SINK, I_GDNG, I_WOUTE, I_LNO, I_WINO, I_WOUTO, I_LNF, I_WRG, I_BRG, I_WRE, I_BRE, I_WG, I_WU, I_WD };

__device__ __forceinline__ void transpose_item(const float* W, int K, int ldw, int ncols, bf16_t* WT, int mode, LAS float* scr, int item, int lane) {
    const int nblk = ncols / 32, kb = item / nblk, nb = item % nblk, k0 = 64 * kb, n0 = 32 * nb;
#pragma unroll 8
    for (int i = 0; i < 32; ++i) { const int kk = 2 * i + (lane >> 5); scr[kk * 33 + (lane & 31)] = W[(size_t)(k0 + kk) * ldw + n0 + (lane & 31)]; }
    asm volatile("s_waitcnt lgkmcnt(0)" ::: "memory");
    const int c = lane & 7;
#pragma unroll
    for (int j = 0; j < 4; ++j) { const int n = (lane >> 3) + 8 * j; const LAS float* s = scr + (8 * c) * 33 + n;
        u32x4 o; o.x = cvt_pk_bf16(s[0 * 33], s[1 * 33]); o.y = cvt_pk_bf16(s[2 * 33], s[3 * 33]); o.z = cvt_pk_bf16(s[4 * 33], s[5 * 33]); o.w = cvt_pk_bf16(s[6 * 33], s[7 * 33]);
        const int ng = n0 + n; const int row = (mode == 0) ? ng : (32 * (ng >> 4) + (ng & 15) + (mode == 2 ? 16 : 0));
        *(u32x4*)(WT + (size_t)row * K + k0 + 8 * c) = o; }
    asm volatile("s_waitcnt lgkmcnt(0)" ::: "memory");
}
__device__ __forceinline__ void convert_moe(const Args& a, int layer, LAS float* scr, int gw, int ngw, int lane) {
    bf16_t* B1 = (bf16_t*)(a.ws + WS_XB1); bf16_t* B2 = (bf16_t*)(a.ws + WS_XB2);
    const float* wg = a.in[I_WG] + (size_t)layer * NEXP * D * DEXP; const float* wu = a.in[I_WU] + (size_t)layer * NEXP * D * DEXP; const float* wd = a.in[I_WD] + (size_t)layer * NEXP * DEXP * D;
    constexpr int IG = (D / 64) * (DEXP / 32);
    constexpr int ID = (DEXP / 64) * (D / 32);
    constexpr int PER_E = 2 * IG + ID;
    for (int it = gw; it < NEXP * PER_E; it += ngw) {
        const int e = it / PER_E; int r = it % PER_E;
        if (r < IG) { transpose_item(wg + (size_t)e * D * DEXP, D, DEXP, DEXP, B1 + (size_t)e * 1024 * 1024, 1, scr, r, lane); continue; } r -= IG;
        if (r < IG) { transpose_item(wu + (size_t)e * D * DEXP, D, DEXP, DEXP, B1 + (size_t)e * 1024 * 1024, 2, scr, r, lane); continue; } r -= IG;
        transpose_item(wd + (size_t)e * DEXP * D, DEXP, D, D, B2 + (size_t)e * 1024 * 512, 0, scr, r, lane);
    }
}

__device__ __forceinline__ void moe_route(const Args& a, int layer, LAS unsigned char* lds, int bid, int G, int tid, int lane, int wave) {
    LAS float* wT = (LAS float*)lds;
    LAS float* lng = (LAS float*)(lds + 147456);
    LAS float* bias = (LAS float*)(lds + 151552);
    LAS int* lcnt = (LAS int*)(lds + 151552 + 256);
    LAS int* lbase = lcnt + 32;
    LAS int* tokE = lbase + 32;
    LAS int* tokR = tokE + 256;
    const float* wrg = a.in[I_WRG] + (size_t)layer * D * 4; const float* wre = a.in[I_WRE] + (size_t)layer * D * 32;
    for (int i = tid; i < 4 * 1024; i += NTHREADS) { const int k = i >> 2, o = i & 3; wT[o * 1024 + k] = wrg[i]; }
    for (int i = tid; i < 32 * 1024; i += NTHREADS) { const int k = i >> 5, o = i & 31; wT[(4 + o) * 1024 + k] = wre[i]; }
    for (int i = tid; i < 1024; i += NTHREADS) lng[i] = a.in[I_LNF][layer * D + i];
    if (tid < 4) bias[tid] = a.in[I_BRG][layer * 4 + tid];
    if (tid >= 64 && tid < 96) bias[4 + tid - 64] = a.in[I_BRE][layer * 32 + tid - 64];
    const float* x = a.out;
    bf16_t* xn = (bf16_t*)(a.ws + WS_XN);
    int* RE = (int*)(a.ws + WS_RE); float* RG = (float*)(a.ws + WS_RG); int* RS = (int*)(a.ws + WS_RS);
    int* gcnt = (int*)(a.ws + WS_CTL) + layer * 32; int* BC = (int*)(a.ws + WS_BC);
    const int tsub = lane >> 4, l16 = lane & 15;
    for (int tile = bid; tile < T / 128; tile += G) {
        __syncthreads();
        if (tid < 32) lcnt[tid] = 0;
        __syncthreads();
        for (int iter = 0; iter < 4; ++iter) {
            const int tl = wave * 16 + iter * 4 + tsub, t = tile * 128 + tl;
            const f32x4* xr = (const f32x4*)(x + (size_t)t * D) + l16;
            f32x4 v[16]; float ss = 0.f;
#pragma unroll
            for (int j = 0; j < 16; ++j) { v[j] = xr[16 * j]; ss += (v[j][0] * v[j][0] + v[j][1] * v[j][1]) + (v[j][2] * v[j][2] + v[j][3] * v[j][3]); }
            ss += __shfl_xor(ss, 1); ss += __shfl_xor(ss, 2); ss += __shfl_xor(ss, 4); ss += __shfl_xor(ss, 8);
            const float rstd = rsqrtf(ss * (1.f / D) + EPS);
            unsigned long long* o8 = (unsigned long long*)(xn + (size_t)t * D) + l16;
#pragma unroll
            for (int j = 0; j < 16; ++j) { v[j] = v[j] * rstd * *((const LAS f32x4*)lng + l16 + 16 * j);
                o8[16 * j] = (unsigned long long)cvt_pk_bf16(v[j][0], v[j][1]) | ((unsigned long long)cvt_pk_bf16(v[j][2], v[j][3]) << 32); }
            LAS float* lgs = (LAS float*)(lds + 154624) + (wave * 4 + tsub) * 40;
#pragma unroll 2
            for (int o = 0; o < 36; ++o) { float acc = 0.f;
#pragma unroll
                for (int j = 0; j < 16; ++j) { const f32x4 w = *((const LAS f32x4*)(wT + o * 1024) + l16 + 16 * j); acc += (v[j][0] * w[0] + v[j][1] * w[1]) + (v[j][2] * w[2] + v[j][3] * w[3]); }
                acc += __shfl_xor(acc, 1); acc += __shfl_xor(acc, 2); acc += __shfl_xor(acc, 4); acc += __shfl_xor(acc, 8);
                if (l16 == 0) lgs[o] = acc + bias[o]; }
            asm volatile("s_waitcnt lgkmcnt(0)" ::: "memory");
            int gi = 0; float gm = lgs[0];
            for (int o = 1; o < 4; ++o) { const float lv = lgs[o]; if (lv > gm) { gm = lv; gi = o; } }
            float gs = 0.f;
            for (int o = 0; o < 4; ++o) gs += __expf(lgs[o] - gm);
            const float grp_p = 1.f / gs;
            const LAS float* le = lgs + 4 + 8 * gi;
            int e1 = 0; float m1 = le[0];
            for (int k = 1; k < 8; ++k) { const float lv = le[k]; if (lv > m1) { m1 = lv; e1 = k; } }
            int e2 = -1; float m2 = -3.0e38f;
            for (int k = 0; k < 8; ++k) { const float lv = le[k]; if (k != e1 && lv > m2) { m2 = lv; e2 = k; } }
            const float p2 = __expf(m2 - m1);
            const float g1 = grp_p / (1.f + p2), g2 = grp_p * p2 / (1.f + p2);
            if (l16 == 0) {
                const int ea = gi * 8 + e1, eb = gi * 8 + e2;
                RE[(size_t)t * 2] = ea; RE[(size_t)t * 2 + 1] = eb; RG[(size_t)t * 2] = g1; RG[(size_t)t * 2 + 1] = g2;
                tokE[tl * 2] = ea; tokE[tl * 2 + 1] = eb;
                atomicAdd((int*)(lcnt + ea), 1); atomicAdd((int*)(lcnt + eb), 1);
            }
        }
        __syncthreads();
        if (tid < 32) { const int c = lcnt[tid]; BC[tile * 32 + tid] = c; atomicAdd(gcnt + tid, c); }
        if (tid < 256) { const int e = tokE[tid]; int rank = 0; for (int j = 0; j < tid; ++j) rank += (tokE[j] == e) ? 1 : 0; RS[(size_t)tile * 256 + tid] = rank; }
    }
}
__device__ __forceinline__ void moe_tables(const Args& a, int layer, LAS int* tab, int tid) {
    __syncthreads();
    if (tid == 0) {
        const int* gcnt = (const int*)(a.ws + WS_CTL) + layer * 32; int t = 0;
        for (int e = 0; e < 32; ++e) { const int c = __hip_atomic_load(gcnt + e, __ATOMIC_RELAXED, __HIP_MEMORY_SCOPE_AGENT); const int nt = (c + 255) >> 8; tab[e] = t * 256; for (int i = 0; i < nt; ++i) tab[64 + t + i] = e; t += nt; }
        tab[32] = t;
    }
    __syncthreads();
}
__device__ __forceinline__ void moe_scatter(const Args& a, int layer, LAS unsigned char* lds, int bid, int G, int tid, int lane, int wave) {
    LAS int* tab = (LAS int*)(lds + 131072);
    LAS int* psum = (LAS int*)(lds + 131072 + 4096);
    moe_tables(a, layer, tab, tid);
    const bf16_t* xn = (const bf16_t*)(a.ws + WS_XN); bf16_t* xr = (bf16_t*)(a.ws + WS_XROWS);
    const int* RE = (const int*)(a.ws + WS_RE); const int* RS = (const int*)(a.ws + WS_RS); int* RP = (int*)(a.ws + WS_RP); const int* BC = (const int*)(a.ws + WS_BC);
    for (int tile = bid; tile < T / 128; tile += G) {
        __syncthreads();
        { const int e = tid & 31, part = tid >> 5; int sacc = 0; for (int b2 = part * 16; b2 < part * 16 + 16; ++b2) if (b2 < tile) sacc += BC[b2 * 32 + e]; psum[part * 32 + e] = sacc; }
        __syncthreads();
        if (tid < 32) { int sacc = 0; for (int p2 = 0; p2 < 16; ++p2) sacc += psum[p2 * 32 + tid]; psum[512 + tid] = sacc + tab[tid]; }
        __syncthreads();
        for (int i = 0; i < 16; ++i) {
            const int t = tile * 128 + wave * 16 + i;
            const int e0 = RE[(size_t)t * 2], e1 = RE[(size_t)t * 2 + 1];
            const int r0 = psum[512 + e0] + RS[(size_t)t * 2], r1 = psum[512 + e1] + RS[(size_t)t * 2 + 1];
            const u32x4* src = (const u32x4*)(xn + (size_t)t * D) + lane;
            const u32x4 v0 = src[0], v1 = src[64];
            u32x4* d0 = (u32x4*)(xr + (size_t)r0 * D) + lane; u32x4* d1 = (u32x4*)(xr + (size_t)r1 * D) + lane;
            d0[0] = v0; d0[64] = v1; d1[0] = v0; d1[64] = v1;
            if (lane == 0) { RP[(size_t)t * 2] = r0; RP[(size_t)t * 2 + 1] = r1; }
        }
    }
}
__device__ __forceinline__ void moe_gemm1(const Args& a, int layer, LAS unsigned char* lds, int bid, int G, int tid) {
    LAS int* tab = (LAS int*)(lds + 131072);
    moe_tables(a, layer, tab, tid);
    pg8::Gemm g{(const bf16_t*)(a.ws + WS_XROWS), (const bf16_t*)(a.ws + WS_XB1), D, D};
    pg8::GroupedOrder S{tab + 64, tab[32], G, bid, D, D, (size_t)1024 * 1024 * 2};
    pg8::EpiSwiGLU E{(bf16_t*)(a.ws + WS_HID)};
    pg8::gemm_phase(lds, g, S, E);
}
__device__ __forceinline__ void moe_gemm2(const Args& a, int layer, LAS unsigned char* lds, int bid, int G, int tid) {
    LAS int* tab = (LAS int*)(lds + 131072);
    moe_tables(a, layer, tab, tid);
    pg8::Gemm g{(const bf16_t*)(a.ws + WS_HID), (const bf16_t*)(a.ws + WS_XB2), DEXP, DEXP};
    pg8::GroupedOrder S{tab + 64, tab[32], G, bid, DEXP, DEXP, (size_t)1024 * 512 * 2};
    pg8::EpiBf16 E{(bf16_t*)(a.ws + WS_XROWS), D};
    pg8::gemm_phase(lds, g, S, E);
}
template <bool NORM>
__device__ __forceinline__ void moe_combine(const Args& a, const float* gain, bf16_t* hout, int gw, int ngw, int lane) {
    const bf16_t* y = (const bf16_t*)(a.ws + WS_XROWS);
    const int* RP = (const int*)(a.ws + WS_RP); const float* RG = (const float*)(a.ws + WS_RG);
    f32x4 gn[4];
    if (NORM) {
#pragma unroll
        for (int j = 0; j < 4; ++j) gn[j] = *((const f32x4*)gain + lane + 64 * j);
    }
    for (int t = gw; t < T; t += ngw) {
        const int p0 = RP[(size_t)t * 2], p1 = RP[(size_t)t * 2 + 1]; const float g0 = RG[(size_t)t * 2], g1 = RG[(size_t)t * 2 + 1];
        f32x4* xr = (f32x4*)(a.out + (size_t)t * D) + lane;
        const u32x2* y0 = (const u32x2*)(y + (size_t)p0 * D) + lane; const u32x2* y1 = (const u32x2*)(y + (size_t)p1 * D) + lane;
        f32x4 v[4]; float s = 0.f;
#pragma unroll
        for (int j = 0; j < 4; ++j) { v[j] = xr[64 * j]; const u32x2 a0 = y0[64 * j], a1 = y1[64 * j];
            v[j][0] += g0 * lo_bf(a0.x) + g1 * lo_bf(a1.x); v[j][1] += g0 * hi_bf(a0.x) + g1 * hi_bf(a1.x); v[j][2] += g0 * lo_bf(a0.y) + g1 * lo_bf(a1.y); v[j][3] += g0 * hi_bf(a0.y) + g1 * hi_bf(a1.y);
            xr[64 * j] = v[j]; s += (v[j][0] * v[j][0] + v[j][1] * v[j][1]) + (v[j][2] * v[j][2] + v[j][3] * v[j][3]); }
        if (NORM) {
            const float rstd = rsqrtf(wave_sum(s) * (1.f / D) + EPS);
            unsigned long long* o8 = (unsigned long long*)(hout + (size_t)t * D) + lane;
#pragma unroll
            for (int j = 0; j < 4; ++j) { const f32x4 w = v[j] * rstd * gn[j]; o8[64 * j] = (unsigned long long)cvt_pk_bf16(w[0], w[1]) | ((unsigned long long)cvt_pk_bf16(w[2], w[3]) << 32); }
        }
    }
}


__device__ __forceinline__ void ck_add(const void* p, size_t bytes, unsigned* dst, int gthread, int nthread) {
    const u32x4* q = (const u32x4*)p; const size_t n = bytes / 16; unsigned acc = 0u;
    for (size_t i = gthread; i < n; i += nthread) { const u32x4 v = q[i]; acc += v.x + v.y * 3u + v.z * 5u + v.w * 7u + (unsigned)i * 0x9E3779B1u * (v.x ^ v.w); }
#pragma unroll
    for (int o = 1; o < 64; o <<= 1) acc += __shfl_xor(acc, o);
    if ((threadIdx.x & 63) == 0) atomicAdd(dst, acc);
}
__device__ __forceinline__ Args load_args() {
#if defined(__HIP_DEVICE_COMPILE__)
    const __attribute__((address_space(4))) Args* kap = (const __attribute__((address_space(4))) Args*)__builtin_amdgcn_kernarg_segment_ptr(); asm volatile("" : "+s"(kap));
    Args a;
#pragma unroll
    for (int i = 0; i < 22; ++i) a.in[i] = kap->in[i];
    a.out = kap->out; a.ws = kap->ws; a.ph_lo = kap->ph_lo; a.ph_hi = kap->ph_hi; return a;
#else
    return Args{};
#endif
}
constexpr int NPHASE = 20;
#define PHASE_IDS int tid_o = threadIdx.x; asm volatile("" : "+v"(tid_o)); const int tid = tid_o, lane = tid & 63, wave = __builtin_amdgcn_readfirstlane(tid >> 6); const int gw = bid * NWAVES + wave; (void)gw; (void)lane; \
    const Args args = load_args(); unsigned char* const ws = args.ws; (void)ws
#ifndef PHHI
#define PHHI NPHASE
#endif
#define CKB(off, bytes) ck_add(ws + (off), (size_t)(bytes), ckd, bid * NTHREADS + tid, G * NTHREADS)

__global__ void __launch_bounds__(NTHREADS, 2) fwd_kernel(Args args_) {
    extern __shared__ __attribute__((aligned(16))) unsigned char lds_raw[];
    LAS unsigned char* lds = (LAS unsigned char*)lds_raw;
    const int tid = threadIdx.x, lane = tid & 63, wave = __builtin_amdgcn_readfirstlane(tid >> 6);
    const int G = gridDim.x, bid = blockIdx.x;
    const int gw = bid * NWAVES + wave, ngw = G * NWAVES;
    unsigned char* ws = args_.ws;
    const int lo = args_.ph_lo, hi = args_.ph_hi;
    cg::grid_group grid = cg::this_grid();
    if (tid < 4) ((LAS unsigned*)(lds + LDS_BYTES - 16))[tid] = 0u;
    __syncthreads();
    const XcdBarrier xbar = xcd_barrier_post((unsigned*)(ws + WS_CTL) + 1024, (volatile LAS unsigned*)(lds + LDS_BYTES - 16));
    if (lo < 0) grid.sync();
#ifndef ONLYP
#define ONLYP -1
#endif
#define IN(k) ((ONLYP < 0 || ONLYP == (k)) && lo <= (k) && (k) < hi)
#ifndef SKIPLO
#define SKIPLO 100
#define SKIPHI 100
#endif
#define RUN(k) (IN(k) && !((k) >= SKIPLO && (k) <= SKIPHI))
#define SEAM(k) do { if (IN(k) && IN((k) + 1)) xcd_barrier(xbar); else __syncthreads(); } while (0)

    if (RUN(0)) { PHASE_IDS;
        LAS float* scr = (LAS float*)(lds + wave * 8448);
        {
            constexpr int I0 = (D / 64) * (N0 / 32);
            for (int it = gw; it < I0; it += ngw) transpose_item(args.in[I_WINE], D, EVEN_IN, N0, (bf16_t*)(ws + WS_WIN0), 0, scr, it, lane);
        }
        LAS float* wab = (LAS float*)(lds + 72 * 1024);
        __syncthreads();
        for (int i = tid; i < 8 * 1024; i += NTHREADS) { const int k = i >> 3, o = i & 7; wab[o * 1024 + k] = args.in[I_WINE][(size_t)k * EVEN_IN + N0 + o]; }
        __syncthreads();
        const float* x = args.in[I_X]; const float* gain = args.in[I_LNE];
        bf16_t* h0 = (bf16_t*)(ws + WS_HMIX0); float* bab = (float*)(ws + WS_BAB);
        f32x4 gn[4];
#pragma unroll
        for (int j = 0; j < 4; ++j) gn[j] = *((const f32x4*)gain + lane + 64 * j);
        for (int m = gw; m < T; m += ngw) {
            const f32x4* xr = (const f32x4*)(x + (size_t)m * D) + lane;
            f32x4 v[4]; float s = 0.f;
#pragma unroll
            for (int j = 0; j < 4; ++j) { v[j] = xr[64 * j]; s += (v[j][0] * v[j][0] + v[j][1] * v[j][1]) + (v[j][2] * v[j][2] + v[j][3] * v[j][3]); }
            const float rstd = rsqrtf(wave_sum(s) * (1.f / D) + EPS);
            float p[8];
#pragma unroll
            for (int o = 0; o < 8; ++o) p[o] = 0.f;
            unsigned long long* o8 = (unsigned long long*)(h0 + (size_t)m * D) + lane;
#pragma unroll
            for (int j = 0; j < 4; ++j) { v[j] = v[j] * rstd * gn[j];
                o8[64 * j] = (unsigned long long)cvt_pk_bf16(v[j][0], v[j][1]) | ((unsigned long long)cvt_pk_bf16(v[j][2], v[j][3]) << 32);
#pragma unroll
                for (int o = 0; o < 8; ++o) { const f32x4 w = *((const LAS f32x4*)(wab + o * 1024) + lane + 64 * j); p[o] += (v[j][0] * w[0] + v[j][1] * w[1]) + (v[j][2] * w[2] + v[j][3] * w[3]); } }
#pragma unroll
            for (int o = 0; o < 8; ++o) p[o] = wave_sum(p[o]);
            if (lane == 0) { *(f32x4*)(bab + (size_t)m * 8) = (f32x4){p[0], p[1], p[2], p[3]}; *(f32x4*)(bab + (size_t)m * 8 + 4) = (f32x4){p[4], p[5], p[6], p[7]}; }
        }
    }
    SEAM(0);

    if (RUN(1)) { PHASE_IDS;
        pg8::Gemm g{(const bf16_t*)(ws + WS_HMIX0), (const bf16_t*)(ws + WS_WIN0), D, D};
        pg8::DenseOrder S; S.init(T, N0, G, bid, D, D);
        pg8::EpiBf16 E{(bf16_t*)(ws + WS_PROJ0), N0};
        pg8::gemm_phase(lds, g, S, E);
    }
    SEAM(1);

    if (RUN(2)) { PHASE_IDS;
        const bf16_t* proj0 = (const bf16_t*)(ws + WS_PROJ0);
        const float* bab = (const float*)(ws + WS_BAB);
        bf16_t* gUT = (bf16_t*)(ws + WS_GU); bf16_t* gW = (bf16_t*)(ws + WS_GW); bf16_t* gQD = (bf16_t*)(ws + WS_GQD); bf16_t* gKDT = (bf16_t*)(ws + WS_GKDT); bf16_t* gA = (bf16_t*)(ws + WS_GA);
        float* gGL = (float*)(ws + WS_GL);
        LAS bf16_t* Kb = (LAS bf16_t*)(lds);
        LAS bf16_t* Qb = (LAS bf16_t*)(lds + 17408);
        LAS bf16_t* Rb = (LAS bf16_t*)(lds + 34816);
        LAS float* Lm = (LAS float*)(lds + 68608);
        LAS bf16_t* raw = (LAS bf16_t*)(lds + 84992);
        LAS float* cw = (LAS float*)(lds + 137520);
        LAS float* gcs = (LAS float*)(lds + 162096);
        LAS float* bts = gcs + 64;
        const int fr = lane & 15, fq = lane >> 4;
        for (int i = tid; i < 4 * 1536; i += NTHREADS) cw[i] = args.in[I_CONVW][i];
        const float alog_e[4] = {-__expf(args.in[I_ALOG][0]), -__expf(args.in[I_ALOG][1]), -__expf(args.in[I_ALOG][2]), -__expf(args.in[I_ALOG][3])};
        const float dtb[4] = {args.in[I_DTB][0], args.in[I_DTB][1], args.in[I_DTB][2], args.in[I_DTB][3]};
        u32x4 praw[7]; float pa_ = 0.f, pb_ = 0.f;
#define P2_PREFETCH(itm) do { const int _b = (itm) >> 8, _n = ((itm) >> 2) & 63, _h = (itm) & 3; \
            _Pragma("unroll") for (int i7 = 0; i7 < 7; ++i7) { const int idx = tid + NTHREADS * i7; const int row = idx / 48, rem = idx - row * 48, part = rem >> 4, ch = rem & 15; const int srow = _n * 64 - 3 + row; \
                praw[i7] = (u32x4){0u, 0u, 0u, 0u}; \
                if (idx < 67 * 48 && srow >= 0) praw[i7] = *(const u32x4*)(proj0 + (size_t)(_b * SEQ + srow) * N0 + 768 + part * 512 + _h * 128 + ch * 8); } \
            if (wave == 0) { const int t = _b * SEQ + _n * 64 + lane; pa_ = bab[(size_t)t * 8 + _h]; pb_ = bab[(size_t)t * 8 + 4 + _h]; } } while (0)
        const int npb = G - 32;
        int* ready = (int*)(ws + WS_CTL + 32768);
#define P2_ITEM(q) ((((((q) & 31) >> 2) * 64 + ((q) >> 5)) * 4) + ((q) & 3))
        if (bid >= 32) P2_PREFETCH(P2_ITEM(bid - 32));
        __syncthreads();
        for (int q = bid - 32; bid >= 32 && q < 2048; q += npb) {
            const int item = P2_ITEM(q);
            const int h = item & 3;
#pragma unroll
            for (int i7 = 0; i7 < 7; ++i7) { const int idx = tid + NTHREADS * i7; const int row = idx / 48, rem = idx - row * 48; if (idx < 67 * 48) *(LAS u32x4*)(raw + row * 392 + rem * 8) = praw[i7]; }
            if (wave == 0) {
                const float a = pa_ + (h == 0 ? dtb[0] : h == 1 ? dtb[1] : h == 2 ? dtb[2] : dtb[3]);
                const float sp = fmaxf(a, 0.f) + log1pf(__expf(-fabsf(a)));
                float gv = (h == 0 ? alog_e[0] : h == 1 ? alog_e[1] : h == 2 ? alog_e[2] : alog_e[3]) * sp;
#pragma unroll
                for (int o = 1; o < 64; o <<= 1) { const float y = __shfl_up(gv, o); if (lane >= o) gv += y; }
                gcs[lane] = gv; bts[lane] = sigmoid_f(pb_);
            }
            __syncthreads();
            if (q + npb < 2048) P2_PREFETCH(P2_ITEM(q + npb));
            {
                const int r = tid >> 3, d0 = (tid & 7) * 16;
                const float gc = gcs[r], beta = bts[r], glast = gcs[63];
                const float eg = __expf(gc), ekd = __expf(glast - gc);
#define P2_CONV(P, OUT) do { float acc[16]; _Pragma("unroll") for (int d = 0; d < 16; ++d) acc[d] = 0.f; \
                    _Pragma("unroll") for (int j = 0; j < 4; ++j) { \
                        const LAS u32x4* px = (const LAS u32x4*)(raw + (r + j) * 392 + (P) * 128 + d0); const u32x4 x0 = px[0], x1 = px[1]; \
                        const LAS f32x4* pw = (const LAS f32x4*)(cw + j * 1536 + (P) * 512 + h * 128 + d0); const f32x4 w0 = pw[0], w1 = pw[1], w2 = pw[2], w3 = pw[3]; \
                        acc[0] += w0[0] * lo_bf(x0.x); acc[1] += w0[1] * hi_bf(x0.x); acc[2] += w0[2] * lo_bf(x0.y); acc[3] += w0[3] * hi_bf(x0.y); \
                        acc[4] += w1[0] * lo_bf(x0.z); acc[5] += w1[1] * hi_bf(x0.z); acc[6] += w1[2] * lo_bf(x0.w); acc[7] += w1[3] * hi_bf(x0.w); \
                        acc[8] += w2[0] * lo_bf(x1.x); acc[9] += w2[1] * hi_bf(x1.x); acc[10] += w2[2] * lo_bf(x1.y); acc[11] += w2[3] * hi_bf(x1.y); \
                        acc[12] += w3[0] * lo_bf(x1.z); acc[13] += w3[1] * hi_bf(x1.z); acc[14] += w3[2] * lo_bf(x1.w); acc[15] += w3[3] * hi_bf(x1.w); } \
                    _Pragma("unroll") for (int d = 0; d < 16; ++d) OUT[d] = silu_f(acc[d]); } while (0)
#define P2_PACK(W0, W1, X, SC) do { W0.x = cvt_pk_bf16(X[0] * (SC), X[1] * (SC)); W0.y = cvt_pk_bf16(X[2] * (SC), X[3] * (SC)); W0.z = cvt_pk_bf16(X[4] * (SC), X[5] * (SC)); W0.w = cvt_pk_bf16(X[6] * (SC), X[7] * (SC)); \
                    W1.x = cvt_pk_bf16(X[8] * (SC), X[9] * (SC)); W1.y = cvt_pk_bf16(X[10] * (SC), X[11] * (SC)); W1.z = cvt_pk_bf16(X[12] * (SC), X[13] * (SC)); W1.w = cvt_pk_bf16(X[14] * (SC), X[15] * (SC)); } while (0)
                u32x4 w0_, w1_;
                {
                    float kk[16]; P2_CONV(1, kk);
                    float sk = 0.f;
#pragma unroll
                    for (int d = 0; d < 16; ++d) sk += kk[d] * kk[d];
                    sk += __shfl_xor(sk, 1); sk += __shfl_xor(sk, 2); sk += __shfl_xor(sk, 4);
                    const float kinv = rsqrtf(sk + EPS);
                    P2_PACK(w0_, w1_, kk, kinv); *(LAS u32x4*)(Kb + r * 136 + d0) = w0_; *(LAS u32x4*)(Kb + r * 136 + d0 + 8) = w1_;
                    P2_PACK(w0_, w1_, kk, kinv * beta * eg); *(LAS u32x4*)(Rb + r * 264 + 128 + d0) = w0_; *(LAS u32x4*)(Rb + r * 264 + 128 + d0 + 8) = w1_;
                    const float ks = kinv * ekd;
#pragma unroll
                    for (int d = 0; d < 16; ++d) gKDT[((size_t)item * 128 + d0 + d) * 64 + r] = f2bf(kk[d] * ks);
                }
                __builtin_amdgcn_sched_barrier(0);
                {
                    float qq[16]; P2_CONV(0, qq);
                    float sq = 0.f;
#pragma unroll
                    for (int d = 0; d < 16; ++d) sq += qq[d] * qq[d];
                    sq += __shfl_xor(sq, 1); sq += __shfl_xor(sq, 2); sq += __shfl_xor(sq, 4);
                    const float qinv = rsqrtf(sq + EPS) * 0.08838834764831845f;
                    P2_PACK(w0_, w1_, qq, qinv); *(LAS u32x4*)(Qb + r * 136 + d0) = w0_; *(LAS u32x4*)(Qb + r * 136 + d0 + 8) = w1_;
                    P2_PACK(w0_, w1_, qq, qinv * eg); { u32x4* pqd = (u32x4*)(gQD + ((size_t)item * 64 + r) * 128 + d0); pqd[0] = w0_; pqd[1] = w1_; }
                }
                __builtin_amdgcn_sched_barrier(0);
                {
                    float vv[16]; P2_CONV(2, vv);
                    P2_PACK(w0_, w1_, vv, beta); *(LAS u32x4*)(Rb + r * 264 + d0) = w0_; *(LAS u32x4*)(Rb + r * 264 + d0 + 8) = w1_;
                }
#undef P2_CONV
#undef P2_PACK
                if (tid == 0) gGL[(size_t)item * 32] = __expf(glast);
            }
            __syncthreads();
            {
                const int which = wave >> 2, mt = wave & 3;
                const LAS bf16_t* X = which ? Qb : Kb;
                for (int nt = 0; nt < 4; ++nt) {
                    f32x4 acc = (f32x4){0.f, 0.f, 0.f, 0.f};
                    if (nt <= mt) {
#pragma unroll
                        for (int s4 = 0; s4 < 4; ++s4) {
                            const bf16x8 af = *(const LAS bf16x8*)(X + (16 * mt + fr) * 136 + 32 * s4 + 8 * fq);
                            const bf16x8 bfr = *(const LAS bf16x8*)(Kb + (16 * nt + fr) * 136 + 32 * s4 + 8 * fq);
                            acc = mfma16(af, bfr, acc);
                        }
                    }
                    const int j = 16 * nt + fr; const float gj = gcs[j];
#pragma unroll
                    for (int rg = 0; rg < 4; ++rg) {
                        const int i = 16 * mt + 4 * fq + rg;
                        const float dec = __expf(fminf(gcs[i] - gj, 0.f));
                        if (which == 0) Lm[i * 64 + j] = (i > j) ? bts[i] * acc[rg] * dec : 0.f;
                        else gA[((size_t)item * 64 + i) * 64 + j] = f2bf((i >= j) ? acc[rg] * dec : 0.f);
                    }
                }
            }
            __syncthreads();
            if (tid < 256) {
                const int c = tid;
                float U[64];
                int lnext = __builtin_bit_cast(int, Lm[lane]);
#pragma unroll
                for (int i = 0; i < 64; ++i) {
                    const int lrow = lnext;
                    if (i + 1 < 64) lnext = __builtin_bit_cast(int, Lm[(i + 1) * 64 + lane]);
                    float s0 = bf2f((unsigned)Rb[i * 264 + c]), s1 = 0.f, s2 = 0.f, s3 = 0.f;
#pragma unroll
                    for (int j = 0; j < i; ++j) { const float l = __builtin_bit_cast(float, __builtin_amdgcn_readlane(lrow, j)); const float t = l * U[j]; if ((j & 3) == 0) s0 -= t; else if ((j & 3) == 1) s1 -= t; else if ((j & 3) == 2) s2 -= t; else s3 -= t; }
                    U[i] = (s0 + s1) + (s2 + s3);
                }
                if (c < 128) {
                    u32x4* pu = (u32x4*)(gUT + ((size_t)item * 128 + c) * 64);
#pragma unroll
                    for (int i8 = 0; i8 < 8; ++i8) { u32x4 o; o.x = cvt_pk_bf16(U[8 * i8], U[8 * i8 + 1]); o.y = cvt_pk_bf16(U[8 * i8 + 2], U[8 * i8 + 3]); o.z = cvt_pk_bf16(U[8 * i8 + 4], U[8 * i8 + 5]); o.w = cvt_pk_bf16(U[8 * i8 + 6], U[8 * i8 + 7]); pu[i8] = o; }
                } else {
#pragma unroll
                    for (int i = 0; i < 64; ++i) gW[((size_t)item * 64 + i) * 128 + (c - 128)] = f2bf(U[i]);
                }
            }
            asm volatile("s_waitcnt vmcnt(0)" ::: "memory");
            __syncthreads();
            if (tid == 0) {
                __builtin_amdgcn_fence(__ATOMIC_RELEASE, "agent");
                asm volatile("s_waitcnt vmcnt(0)" ::: "memory");
                __hip_atomic_store(ready + item, 1, __ATOMIC_RELAXED, __HIP_MEMORY_SCOPE_AGENT);
            }
        }
#undef P2_PREFETCH
#undef P2_ITEM
    }
    __syncthreads();

    if (RUN(3)) { PHASE_IDS;
        const bf16_t* proj0 = (const bf16_t*)(ws + WS_PROJ0);
        bf16_t* mix0 = (bf16_t*)(ws + WS_HMIX0);
        const int fr = lane & 15, fq = lane >> 4;
        if (bid < 32) {
            const bf16_t* gUT = (const bf16_t*)(ws + WS_GU); const bf16_t* gW = (const bf16_t*)(ws + WS_GW); const bf16_t* gQD = (const bf16_t*)(ws + WS_GQD); const bf16_t* gKDT = (const bf16_t*)(ws + WS_GKDT); const bf16_t* gA = (const bf16_t*)(ws + WS_GA);
            const float* gGL = (const float*)(ws + WS_GL);
            const int b = bid >> 2, h = bid & 3;
            constexpr int BUFB = 62464;
            LAS bf16_t* Obuf0 = (LAS bf16_t*)(lds + 2 * BUFB);
            const int wrow0 = tid >> 4, wch = tid & 15;
            const int krow0 = tid >> 3, kch = tid & 7;
            u32x4 pw[2], pq[2], pk[2], pa;
            u32x2 pu[4], pun[4]; u32x4 pz0, pz1; float glv, glvn = 0.f;
            f32x4 Sacc[8];
#pragma unroll
            for (int k = 0; k < 8; ++k) Sacc[k] = (f32x4){0.f, 0.f, 0.f, 0.f};
            LAS float* gnl = (LAS float*)(lds + 2 * BUFB + 2 * 17408);
            if (tid < 128) gnl[tid] = args.in[I_GDNG][tid];
#define GDN_LOAD(itm) do { const size_t _it = (size_t)(itm); \
                pw[0] = *(const u32x4*)(gW + (_it * 64 + wrow0) * 128 + wch * 8); pw[1] = *(const u32x4*)(gW + (_it * 64 + wrow0 + 32) * 128 + wch * 8); \
                pq[0] = *(const u32x4*)(gQD + (_it * 64 + wrow0) * 128 + wch * 8); pq[1] = *(const u32x4*)(gQD + (_it * 64 + wrow0 + 32) * 128 + wch * 8); \
                pk[0] = *(const u32x4*)(gKDT + (_it * 128 + krow0) * 64 + kch * 8); pk[1] = *(const u32x4*)(gKDT + (_it * 128 + krow0 + 64) * 64 + kch * 8); \
                pa = *(const u32x4*)(gA + (_it * 64 + krow0) * 64 + kch * 8); } while (0)
#define GDN_LOAD2(itm, U, GLV) do { const size_t _it = (size_t)(itm); \
                _Pragma("unroll") for (int mt = 0; mt < 4; ++mt) U[mt] = *(const u32x2*)(gUT + (_it * 128 + 16 * wave + fr) * 64 + 16 * mt + 4 * fq); \
                GLV = gGL[_it * 32]; } while (0)
#define GDN_STORE(bufi) do { LAS bf16_t* _W = (LAS bf16_t*)(lds + (bufi) * BUFB); LAS bf16_t* _Q = _W + 64 * 136; LAS bf16_t* _K = _Q + 64 * 136; LAS bf16_t* _A = _K + 128 * 72; \
                *(LAS u32x4*)(_W + wrow0 * 136 + wch * 8) = pw[0]; *(LAS u32x4*)(_W + (wrow0 + 32) * 136 + wch * 8) = pw[1]; \
                *(LAS u32x4*)(_Q + wrow0 * 136 + wch * 8) = pq[0]; *(LAS u32x4*)(_Q + (wrow0 + 32) * 136 + wch * 8) = pq[1]; \
                *(LAS u32x4*)(_K + krow0 * 72 + kch * 8) = pk[0]; *(LAS u32x4*)(_K + (krow0 + 64) * 72 + kch * 8) = pk[1]; \
                *(LAS u32x4*)(_A + krow0 * 72 + kch * 8) = pa; } while (0)
            const int* ready = (const int*)(ws + WS_CTL + 32768);
#define GDN_WAIT(c0, cnt) do { if (wave == 0) { if (lane < (cnt)) { const int* f = ready + (((b * 64 + (c0) + lane) * 4) + h); while (__hip_atomic_load(f, __ATOMIC_RELAXED, __HIP_MEMORY_SCOPE_AGENT) == 0) __builtin_amdgcn_s_sleep(4); } \
                __builtin_amdgcn_fence(__ATOMIC_ACQUIRE, "agent"); asm volatile("s_waitcnt vmcnt(0)" ::: "memory"); } __syncthreads(); } while (0)
            GDN_WAIT(0, 5);
            GDN_LOAD((b * 64 + 0) * 4 + h); GDN_STORE(0);
            GDN_LOAD2((b * 64 + 0) * 4 + h, pu, glv);
            __syncthreads();
            for (int n = 0; n < 64; ++n) {
                if (n > 0 && (n & 3) == 0 && n + 1 < 64) GDN_WAIT(n + 1, (n + 5 <= 64) ? 4 : (63 - n));
                const int item = (b * 64 + n) * 4 + h, cur = n & 1;
                const int t0 = b * SEQ + n * 64;
                const LAS bf16_t* Wl = (const LAS bf16_t*)(lds + cur * BUFB); const LAS bf16_t* Ql = Wl + 64 * 136; const LAS bf16_t* Kl = Ql + 64 * 136; const LAS bf16_t* Al = Kl + 128 * 72;
                LAS bf16_t* Obuf = Obuf0 + cur * (64 * 136);
                if (n + 1 < 64) { GDN_LOAD(item + 4); GDN_LOAD2(item + 4, pun, glvn); }
                { const u32x4* pz = (const u32x4*)(proj0 + (size_t)(t0 + (tid >> 3)) * N0 + 2304 + h * 128 + (tid & 7) * 16); pz0 = pz[0]; pz1 = pz[1]; }
                bf16x8 Sb[4];
#pragma unroll
                for (int s = 0; s < 4; ++s) Sb[s] = mk8f(Sacc[2 * s], Sacc[2 * s + 1]);
                f32x4 WS[4], QS[4];
#pragma unroll
                for (int mt = 0; mt < 4; ++mt) { WS[mt] = (f32x4){0.f, 0.f, 0.f, 0.f}; QS[mt] = (f32x4){0.f, 0.f, 0.f, 0.f};
#pragma unroll
                    for (int s = 0; s < 4; ++s) {
                        const LAS bf16_t* pwf = Wl + (16 * mt + fr) * 136 + 32 * s + 4 * fq;
                        WS[mt] = mfma16(mk8(*(const LAS u32x2*)pwf, *(const LAS u32x2*)(pwf + 16)), Sb[s], WS[mt]);
                        const LAS bf16_t* pqf = Ql + (16 * mt + fr) * 136 + 32 * s + 4 * fq;
                        QS[mt] = mfma16(mk8(*(const LAS u32x2*)pqf, *(const LAS u32x2*)(pqf + 16)), Sb[s], QS[mt]);
                    } }
                f32x4 vn[4];
#pragma unroll
                for (int mt = 0; mt < 4; ++mt) { vn[mt][0] = lo_bf(pu[mt].x) - WS[mt][0]; vn[mt][1] = hi_bf(pu[mt].x) - WS[mt][1]; vn[mt][2] = lo_bf(pu[mt].y) - WS[mt][2]; vn[mt][3] = hi_bf(pu[mt].y) - WS[mt][3]; }
                bf16x8 Vb[2];
                Vb[0] = mk8f(vn[0], vn[1]); Vb[1] = mk8f(vn[2], vn[3]);
#pragma unroll
                for (int mt = 0; mt < 4; ++mt)
#pragma unroll
                    for (int s2 = 0; s2 < 2; ++s2) { const LAS bf16_t* paf = Al + (16 * mt + fr) * 72 + 32 * s2 + 4 * fq;
                        QS[mt] = mfma16(mk8(*(const LAS u32x2*)paf, *(const LAS u32x2*)(paf + 16)), Vb[s2], QS[mt]); }
#pragma unroll
                for (int kt = 0; kt < 8; ++kt) { Sacc[kt] = Sacc[kt] * glv;
#pragma unroll
                    for (int s2 = 0; s2 < 2; ++s2) { const LAS bf16_t* pkf = Kl + (16 * kt + fr) * 72 + 32 * s2 + 4 * fq;
                        Sacc[kt] = mfma16(mk8(*(const LAS u32x2*)pkf, *(const LAS u32x2*)(pkf + 16)), Vb[s2], Sacc[kt]); } }
#pragma unroll
                for (int mt = 0; mt < 4; ++mt)
#pragma unroll
                    for (int rg = 0; rg < 4; ++rg) Obuf[(16 * mt + 4 * fq + rg) * 136 + 16 * wave + fr] = f2bf(QS[mt][rg]);
                if (n + 1 < 64) GDN_STORE(cur ^ 1);
                __syncthreads();
                {
                    const int r = tid >> 3, c0 = (tid & 7) * 16;
                    const u32x4 o0 = *(const LAS u32x4*)(Obuf + r * 136 + c0), o1 = *(const LAS u32x4*)(Obuf + r * 136 + c0 + 8);
                    float ov[16], zv[16];
                    ov[0] = lo_bf(o0.x); ov[1] = hi_bf(o0.x); ov[2] = lo_bf(o0.y); ov[3] = hi_bf(o0.y); ov[4] = lo_bf(o0.z); ov[5] = hi_bf(o0.z); ov[6] = lo_bf(o0.w); ov[7] = hi_bf(o0.w);
                    ov[8] = lo_bf(o1.x); ov[9] = hi_bf(o1.x); ov[10] = lo_bf(o1.y); ov[11] = hi_bf(o1.y); ov[12] = lo_bf(o1.z); ov[13] = hi_bf(o1.z); ov[14] = lo_bf(o1.w); ov[15] = hi_bf(o1.w);
                    float ss = 0.f;
#pragma unroll
                    for (int d = 0; d < 16; ++d) ss += ov[d] * ov[d];
                    ss += __shfl_xor(ss, 1); ss += __shfl_xor(ss, 2); ss += __shfl_xor(ss, 4);
                    const float rstd = rsqrtf(ss * (1.f / 128.f) + EPS);
                    zv[0] = lo_bf(pz0.x); zv[1] = hi_bf(pz0.x); zv[2] = lo_bf(pz0.y); zv[3] = hi_bf(pz0.y); zv[4] = lo_bf(pz0.z); zv[5] = hi_bf(pz0.z); zv[6] = lo_bf(pz0.w); zv[7] = hi_bf(pz0.w);
                    zv[8] = lo_bf(pz1.x); zv[9] = hi_bf(pz1.x); zv[10] = lo_bf(pz1.y); zv[11] = hi_bf(pz1.y); zv[12] = lo_bf(pz1.z); zv[13] = hi_bf(pz1.z); zv[14] = lo_bf(pz1.w); zv[15] = hi_bf(pz1.w);
#pragma unroll
                    for (int d = 0; d < 16; ++d) ov[d] = ov[d] * rstd * gnl[c0 + d] * silu_f(zv[d]);
                    u32x4 w0, w1;
                    w0.x = cvt_pk_bf16(ov[0], ov[1]); w0.y = cvt_pk_bf16(ov[2], ov[3]); w0.z = cvt_pk_bf16(ov[4], ov[5]); w0.w = cvt_pk_bf16(ov[6], ov[7]);
                    w1.x = cvt_pk_bf16(ov[8], ov[9]); w1.y = cvt_pk_bf16(ov[10], ov[11]); w1.z = cvt_pk_bf16(ov[12], ov[13]); w1.w = cvt_pk_bf16(ov[14], ov[15]);
                    u32x4* po = (u32x4*)(mix0 + (size_t)(t0 + r) * D + 512 + h * 128 + c0); po[0] = w0; po[1] = w1;
                }
#pragma unroll
                for (int mt = 0; mt < 4; ++mt) pu[mt] = pun[mt];
                glv = glvn;
            }
#undef GDN_LOAD2
#undef GDN_WAIT
#undef GDN_LOAD
#undef GDN_STORE
        } else {
            LAS bf16_t* Ks = (LAS bf16_t*)(lds);
            LAS bf16_t* Vt = (LAS bf16_t*)(lds + 27648);
            const float* qgain = args.in[I_QG]; const float* kgain = args.in[I_KG];
            const int nbk = G - 32;
            for (int it = bid - 32; it < 1024; it += nbk) {
                const int b = it >> 7, qb = (it >> 1) & 63, hk = it & 1;
                const int t0 = b * SEQ + qb * 64;
                __syncthreads();
#pragma unroll
                for (int i3 = 0; i3 < 3; ++i3) {
                    const int task = tid + NTHREADS * i3, key = task >> 3, dg = task & 7;
                    const int kp = qb * 64 - 128 + key;
                    u32x4 kr = (u32x4){0u, 0u, 0u, 0u}, vr = (u32x4){0u, 0u, 0u, 0u};
                    if (kp >= 0) { const bf16_t* pr = proj0 + (size_t)(b * SEQ + kp) * N0 + hk * 64 + 8 * dg; kr = *(const u32x4*)(pr + 512); vr = *(const u32x4*)(pr + 640); }
                    float kv[8];
                    kv[0] = lo_bf(kr.x); kv[1] = hi_bf(kr.x); kv[2] = lo_bf(kr.y); kv[3] = hi_bf(kr.y); kv[4] = lo_bf(kr.z); kv[5] = hi_bf(kr.z); kv[6] = lo_bf(kr.w); kv[7] = hi_bf(kr.w);
                    float ss = 0.f;
#pragma unroll
                    for (int i = 0; i < 8; ++i) ss += kv[i] * kv[i];
                    ss += __shfl_xor(ss, 1); ss += __shfl_xor(ss, 2); ss += __shfl_xor(ss, 4);
                    const float rstd = rsqrtf(ss * (1.f / 64.f) + EPS);
                    const f32x4 g0 = *(const f32x4*)(kgain + 8 * dg), g1 = *(const f32x4*)(kgain + 8 * dg + 4);
                    kv[0] *= rstd * g0[0]; kv[1] *= rstd * g0[1]; kv[2] *= rstd * g0[2]; kv[3] *= rstd * g0[3]; kv[4] *= rstd * g1[0]; kv[5] *= rstd * g1[1]; kv[6] *= rstd * g1[2]; kv[7] *= rstd * g1[3];
                    float pv[8];
#pragma unroll
                    for (int i = 0; i < 8; ++i) pv[i] = __shfl_xor(kv[i], 1);
                    if (dg < 2) {
#pragma unroll
                        for (int i = 0; i < 8; ++i) { float sn, cs; sincos_rev((float)kp * exp2f(-2.36644607f * (float)i), sn, cs);
                            kv[i] = (dg == 0) ? (kv[i] * cs - pv[i] * sn) : (kv[i] * cs + pv[i] * sn); }
                    }
                    u32x4 kw; kw.x = cvt_pk_bf16(kv[0], kv[1]); kw.y = cvt_pk_bf16(kv[2], kv[3]); kw.z = cvt_pk_bf16(kv[4], kv[5]); kw.w = cvt_pk_bf16(kv[6], kv[7]);
                    *(LAS u32x4*)(Ks + key * 72 + 8 * dg) = kw;
                    Vt[(8 * dg + 0) * 200 + key] = (bf16_t)(vr.x & 0xffffu); Vt[(8 * dg + 1) * 200 + key] = (bf16_t)(vr.x >> 16);
                    Vt[(8 * dg + 2) * 200 + key] = (bf16_t)(vr.y & 0xffffu); Vt[(8 * dg + 3) * 200 + key] = (bf16_t)(vr.y >> 16);
                    Vt[(8 * dg + 4) * 200 + key] = (bf16_t)(vr.z & 0xffffu); Vt[(8 * dg + 5) * 200 + key] = (bf16_t)(vr.z >> 16);
                    Vt[(8 * dg + 6) * 200 + key] = (bf16_t)(vr.w & 0xffffu); Vt[(8 * dg + 7) * 200 + key] = (bf16_t)(vr.w >> 16);
                }
                __syncthreads();
                const int g = wave >> 1, qs = wave & 1, hq = hk * 4 + g;
                const float sinkv = args.in[I_SINK][hq];
#pragma unroll
                for (int j2 = 0; j2 < 2; ++j2) {
                    const int qrow = 32 * qs + 16 * j2 + fr;
                    const int tq = t0 + qrow, qpos = qb * 64 + qrow;
                    bf16x8 Qf[2];
                    {
                        const u32x4 r0 = *(const u32x4*)(proj0 + (size_t)tq * N0 + hq * 64 + 8 * fq), r1 = *(const u32x4*)(proj0 + (size_t)tq * N0 + hq * 64 + 32 + 8 * fq);
                        float q0[8], q1[8];
                        q0[0] = lo_bf(r0.x); q0[1] = hi_bf(r0.x); q0[2] = lo_bf(r0.y); q0[3] = hi_bf(r0.y); q0[4] = lo_bf(r0.z); q0[5] = hi_bf(r0.z); q0[6] = lo_bf(r0.w); q0[7] = hi_bf(r0.w);
                        q1[0] = lo_bf(r1.x); q1[1] = hi_bf(r1.x); q1[2] = lo_bf(r1.y); q1[3] = hi_bf(r1.y); q1[4] = lo_bf(r1.z); q1[5] = hi_bf(r1.z); q1[6] = lo_bf(r1.w); q1[7] = hi_bf(r1.w);
                        float ss = 0.f;
#pragma unroll
                        for (int i = 0; i < 8; ++i) ss += q0[i] * q0[i] + q1[i] * q1[i];
                        ss += __shfl_xor(ss, 16); ss += __shfl_xor(ss, 32);
                        const float rstd = rsqrtf(ss * (1.f / 64.f) + EPS) * 0.125f;
#pragma unroll
                        for (int i = 0; i < 8; ++i) { q0[i] *= rstd * qgain[8 * fq + i]; q1[i] *= rstd * qgain[32 + 8 * fq + i]; }
                        float pv[8];
#pragma unroll
                        for (int i = 0; i < 8; ++i) pv[i] = __shfl_xor(q0[i], 16);
                        if (fq < 2) {
#pragma unroll
                            for (int i = 0; i < 8; ++i) { float sn, cs; sincos_rev((float)qpos * exp2f(-2.36644607f * (float)i), sn, cs);
                                q0[i] = (fq == 0) ? (q0[i] * cs - pv[i] * sn) : (q0[i] * cs + pv[i] * sn); }
                        }
                        u32x4 w0, w1;
                        w0.x = cvt_pk_bf16(q0[0], q0[1]); w0.y = cvt_pk_bf16(q0[2], q0[3]); w0.z = cvt_pk_bf16(q0[4], q0[5]); w0.w = cvt_pk_bf16(q0[6], q0[7]);
                        w1.x = cvt_pk_bf16(q1[0], q1[1]); w1.y = cvt_pk_bf16(q1[2], q1[3]); w1.z = cvt_pk_bf16(q1[4], q1[5]); w1.w = cvt_pk_bf16(q1[6], q1[7]);
                        Qf[0] = __builtin_bit_cast(bf16x8, w0); Qf[1] = __builtin_bit_cast(bf16x8, w1);
                    }
                    float mrun = sinkv, lrun = (fq == 0) ? 1.f : 0.f;
                    f32x4 Oa[4];
#pragma unroll
                    for (int dt = 0; dt < 4; ++dt) Oa[dt] = (f32x4){0.f, 0.f, 0.f, 0.f};
#pragma unroll
                    for (int kt = 0; kt < 3; ++kt) {
                        f32x4 sc[4];
                        float tmax = -1e30f;
#pragma unroll
                        for (int mt = 0; mt < 4; ++mt) { sc[mt] = (f32x4){0.f, 0.f, 0.f, 0.f};
#pragma unroll
                            for (int s = 0; s < 2; ++s) sc[mt] = mfma16(*(const LAS bf16x8*)(Ks + (64 * kt + 16 * mt + fr) * 72 + 32 * s + 8 * fq), Qf[s], sc[mt]);
#pragma unroll
                            for (int rg = 0; rg < 4; ++rg) { const int key = 64 * kt + 16 * mt + 4 * fq + rg; const int rel = 128 + qrow - key; const int kp = qb * 64 - 128 + key;
                                const bool ok = (rel >= 0) && (rel < 128) && (kp >= 0);
                                sc[mt][rg] = ok ? sc[mt][rg] : -1e30f; tmax = fmaxf(tmax, sc[mt][rg]); } }
                        tmax = fmaxf(tmax, __shfl_xor(tmax, 16)); tmax = fmaxf(tmax, __shfl_xor(tmax, 32));
                        const float mnew = fmaxf(mrun, tmax), alpha = __expf(mrun - mnew);
                        float ps = 0.f;
#pragma unroll
                        for (int mt = 0; mt < 4; ++mt)
#pragma unroll
                            for (int rg = 0; rg < 4; ++rg) { const float p = (sc[mt][rg] > -1e29f) ? __expf(sc[mt][rg] - mnew) : 0.f; sc[mt][rg] = p; ps += p; }
                        lrun = lrun * alpha + ps; mrun = mnew;
                        bf16x8 Pb[2]; Pb[0] = mk8f(sc[0], sc[1]); Pb[1] = mk8f(sc[2], sc[3]);
#pragma unroll
                        for (int dt = 0; dt < 4; ++dt) { Oa[dt] = Oa[dt] * alpha;
#pragma unroll
                            for (int s2 = 0; s2 < 2; ++s2) { const LAS bf16_t* pvf = Vt + (16 * dt + fr) * 200 + 64 * kt + 32 * s2 + 4 * fq;
                                Oa[dt] = mfma16(mk8(*(const LAS u32x2*)pvf, *(const LAS u32x2*)(pvf + 16)), Pb[s2], Oa[dt]); } }
                    }
                    lrun += __shfl_xor(lrun, 16); lrun += __shfl_xor(lrun, 32);
                    const float inv = 1.f / lrun;
#pragma unroll
                    for (int dt = 0; dt < 4; ++dt) { u32x2 w; w.x = cvt_pk_bf16(Oa[dt][0] * inv, Oa[dt][1] * inv); w.y = cvt_pk_bf16(Oa[dt][2] * inv, Oa[dt][3] * inv);
                        *(u32x2*)(mix0 + (size_t)tq * D + hq * 64 + 16 * dt + 4 * fq) = w; }
                }
            }
            __syncthreads();
            {
                LAS float* scr = (LAS float*)(lds + wave * 8448);
                const int gw2 = (bid - 32) * NWAVES + wave, ngw2 = nbk * NWAVES;
                constexpr int I1 = (D / 64) * (D / 32), I2 = (D / 64) * (ODD_IN / 32), I3 = (2048 / 64) * (D / 32);
                for (int it = gw2; it < I1 + I2 + I3; it += ngw2) {
                    int r = it;
                    if (r < I1) { transpose_item(args.in[I_WOUTE], D, D, D, (bf16_t*)(ws + WS_WOUT0), 0, scr, r, lane); continue; } r -= I1;
                    if (r < I2) { transpose_item(args.in[I_WINO], D, ODD_IN, ODD_IN, (bf16_t*)(ws + WS_WIN1), 0, scr, r, lane); continue; } r -= I2;
                    transpose_item(args.in[I_WOUTO], 2048, D, D, (bf16_t*)(ws + WS_WOUT1), 0, scr, r, lane);
                }
                convert_moe(args, 0, scr, gw2, ngw2, lane);
            }
        }
    }
    SEAM(3);

    if (RUN(4)) { PHASE_IDS;
        pg8::Gemm g{(const bf16_t*)(ws + WS_HMIX0), (const bf16_t*)(ws + WS_WOUT0), D, D};
        pg8::DenseOrder S; S.init(T, D, G, bid, D, D);
        pg8::EpiResF32 E{args.in[I_X], args.out, D};
        pg8::gemm_phase(lds, g, S, E);
    }
    SEAM(4);

    if (RUN(5)) { PHASE_IDS; moe_route(args, 0, lds, bid, G, tid, lane, wave); }
    SEAM(5);
    if (RUN(6)) { PHASE_IDS; moe_scatter(args, 0, lds, bid, G, tid, lane, wave); }
    SEAM(6);
    if (RUN(7)) { PHASE_IDS; moe_gemm1(args, 0, lds, bid, G, tid); }
    SEAM(7);
    if (RUN(8)) { PHASE_IDS; moe_gemm2(args, 0, lds, bid, G, tid); }
    SEAM(8);
    if (RUN(9)) { PHASE_IDS; moe_combine<true>(args, args.in[I_LNO], (bf16_t*)(ws + WS_H1), gw, ngw, lane); }
    SEAM(9);

    if (RUN(10)) { PHASE_IDS;
        pg8::Gemm g{(const bf16_t*)(ws + WS_H1), (const bf16_t*)(ws + WS_WIN1), D, D};
        pg8::DenseOrder S; S.init(T, ODD_IN, G, bid, D, D);
        pg8::EpiBf16 E{(bf16_t*)(ws + WS_PROJ1), ODD_IN};
        pg8::gemm_phase(lds, g, S, E);
    }
    SEAM(10);

    if (RUN(11)) { PHASE_IDS;
        bf16_t* proj1 = (bf16_t*)(ws + WS_PROJ1); bf16_t* inner = (bf16_t*)(ws + WS_INNER); bf16_t* kzT = (bf16_t*)(ws + WS_KZT);
        LAS bf16_t* Qs = (LAS bf16_t*)lds;
        LAS bf16_t* Ks = (LAS bf16_t*)(lds + 67584);
        const int fr = lane & 15, fq = lane >> 4;
        for (int item = bid; item < 1024; item += G) {
            const int b = item >> 7, n = (item >> 2) & 31, h = item & 3;
            const int t0 = b * SEQ + n * 128;
            const float l2g = logf(1.0f - exp2f(-5.0f - (float)h)) * 1.4426950408889634f;
            __syncthreads();
            {
                const int r = tid >> 2, seg = tid & 3;
                const float pos = (float)(n * 128 + r);
                bf16_t* pq = proj1 + (size_t)(t0 + r) * ODD_IN + h * 256 + 64 * seg;
#pragma unroll 2
                for (int c8 = 0; c8 < 8; ++c8) {
                    const u32x4 qr = *(const u32x4*)(pq + 8 * c8), kr = *(const u32x4*)(pq + 1024 + 8 * c8);
                    unsigned qw[4] = {qr.x, qr.y, qr.z, qr.w}, kw[4] = {kr.x, kr.y, kr.z, kr.w};
#pragma unroll
                    for (int pp = 0; pp < 4; ++pp) {
                        const int i = 32 * seg + 4 * c8 + pp;
                        float sn, cs; sincos_rev(pos * exp2f(-0.10462765655f * (float)i), sn, cs);
                        const float q1 = lo_bf(qw[pp]), q2 = hi_bf(qw[pp]), k1 = lo_bf(kw[pp]) * 0.0625f, k2 = hi_bf(kw[pp]) * 0.0625f;
                        qw[pp] = cvt_pk_bf16(q1 * cs - q2 * sn, q2 * cs + q1 * sn);
                        kw[pp] = cvt_pk_bf16(k1 * cs - k2 * sn, k2 * cs + k1 * sn);
                    }
                    const u32x4 qo = (u32x4){qw[0], qw[1], qw[2], qw[3]}, ko = (u32x4){kw[0], kw[1], kw[2], kw[3]};
                    *(u32x4*)(pq + 8 * c8) = qo;
                    *(LAS u32x4*)(Qs + r * 264 + 64 * seg + 8 * c8) = qo;
                    *(LAS u32x4*)(Ks + r * 264 + 64 * seg + 8 * c8) = ko;
                }
            }
            __syncthreads();
            {
                for (int t = wave; t < 64; t += 8) {
                    int it, jt;
                    if (t < 36) { it = 0; int rem = t; while (rem > it) { rem -= it + 1; ++it; } jt = rem; }
                    else { const int u = t - 36; it = 0; int rem = u; while (rem >= 7 - it) { rem -= 7 - it; ++it; } jt = it + 1 + rem; }
                    f32x4 acc = (f32x4){0.f, 0.f, 0.f, 0.f};
                    if (t < 36) {
#pragma unroll
                        for (int s8 = 0; s8 < 8; ++s8)
                            acc = mfma16(*(const LAS bf16x8*)(Ks + (16 * jt + fr) * 264 + 32 * s8 + 8 * fq), *(const LAS bf16x8*)(Qs + (16 * it + fr) * 264 + 32 * s8 + 8 * fq), acc);
                    }
                    const int i = 16 * it + fr;
                    float vv[4];
#pragma unroll
                    for (int rg = 0; rg < 4; ++rg) { const int j = 16 * jt + 4 * fq + rg; vv[rg] = (i >= j) ? acc[rg] * exp2f((float)(i - j) * l2g) : 0.f; }
                    u32x2 w; w.x = cvt_pk_bf16(vv[0], vv[1]); w.y = cvt_pk_bf16(vv[2], vv[3]);
                    *(u32x2*)(inner + ((size_t)item * 128 + i) * 128 + 16 * jt + 4 * fq) = w;
                }
            }
            {
                const int d = tid >> 1, half = tid & 1;
                u32x4* po = (u32x4*)(kzT + ((size_t)item * 256 + d) * 128 + 64 * half);
#pragma unroll
                for (int i8 = 0; i8 < 8; ++i8) {
                    float kv[8];
#pragma unroll
                    for (int e = 0; e < 8; ++e) { const int r = 64 * half + 8 * i8 + e; kv[e] = bf2f((unsigned)Ks[r * 264 + d]) * exp2f((float)(127 - r) * l2g); }
                    u32x4 o; o.x = cvt_pk_bf16(kv[0], kv[1]); o.y = cvt_pk_bf16(kv[2], kv[3]); o.z = cvt_pk_bf16(kv[4], kv[5]); o.w = cvt_pk_bf16(kv[6], kv[7]);
                    po[i8] = o;
                }
            }
        }
    }
    SEAM(11);

    if (RUN(12)) { PHASE_IDS;
        bf16_t* proj1 = (bf16_t*)(ws + WS_PROJ1); const bf16_t* inner = (const bf16_t*)(ws + WS_INNER); const bf16_t* kzT = (const bf16_t*)(ws + WS_KZT);
        float* SSQ = (float*)(ws + WS_SSQ);
        LAS bf16_t* Vt = (LAS bf16_t*)lds;
        LAS bf16_t* St = (LAS bf16_t*)(lds + 17408);
        const int fr = lane & 15, fq = lane >> 4;
        for (int wi = bid; wi < 256; wi += G) {
            const int xcd = wi & 7, jj = wi >> 3, bh = xcd * 4 + (jj >> 3), sl = jj & 7, b = bh >> 2, h = bh & 3;
            const float l2g = logf(1.0f - exp2f(-5.0f - (float)h)) * 1.4426950408889634f;
            const float gC = exp2f(128.0f * l2g);
            const float xi = exp2f((float)(16 * wave + fr + 1) * l2g);
            f32x4 Sacc[2][4];
#pragma unroll
            for (int mt = 0; mt < 2; ++mt)
#pragma unroll
                for (int nt = 0; nt < 4; ++nt) Sacc[mt][nt] = (f32x4){0.f, 0.f, 0.f, 0.f};
            __syncthreads();
            for (int i = tid; i < 64 * 264 / 2; i += NTHREADS) ((LAS unsigned*)St)[i] = 0u;
            const int vr = tid >> 2, vcs = tid & 3;
            const size_t vcol = 2048 + h * 512 + 64 * sl;
            u32x4 pv0, pv1;
            { const u32x4* pvp = (const u32x4*)(proj1 + (size_t)(b * SEQ + vr) * ODD_IN + vcol + 16 * vcs); pv0 = pvp[0]; pv1 = pvp[1]; }
#define RET_VSTORE() do { const unsigned _w[8] = {pv0.x, pv0.y, pv0.z, pv0.w, pv1.x, pv1.y, pv1.z, pv1.w}; \
                _Pragma("unroll") for (int _e = 0; _e < 8; ++_e) { Vt[(16 * vcs + 2 * _e) * 136 + vr] = (bf16_t)(_w[_e] & 0xffffu); Vt[(16 * vcs + 2 * _e + 1) * 136 + vr] = (bf16_t)(_w[_e] >> 16); } } while (0)
            RET_VSTORE();
            __syncthreads();
            bf16x8 qf[8], nf[4], kf[2][4]; u32x2 zr[4];
            {
                const int ti0 = b * SEQ + 16 * wave + fr; const int item0 = (b * 32) * 4 + h;
                const bf16_t* pq = proj1 + (size_t)ti0 * ODD_IN + h * 256 + 8 * fq;
#pragma unroll
                for (int s = 0; s < 8; ++s) qf[s] = *(const bf16x8*)(pq + 32 * s);
                const bf16_t* pin = inner + ((size_t)item0 * 128 + 16 * wave + fr) * 128 + 8 * fq;
#pragma unroll
                for (int s = 0; s < 4; ++s) nf[s] = *(const bf16x8*)(pin + 32 * s);
                const bf16_t* pk = kzT + ((size_t)item0 * 256 + 32 * wave + fr) * 128 + 8 * fq;
#pragma unroll
                for (int mt = 0; mt < 2; ++mt)
#pragma unroll
                    for (int s = 0; s < 4; ++s) kf[mt][s] = *(const bf16x8*)(pk + (size_t)mt * 16 * 128 + 32 * s);
                const bf16_t* pz = proj1 + (size_t)ti0 * ODD_IN + vcol + 4 * fq + 2048;
#pragma unroll
                for (int ct = 0; ct < 4; ++ct) zr[ct] = *(const u32x2*)(pz + 16 * ct);
            }
            for (int n = 0; n < 32; ++n) {
                const int item = (b * 32 + n) * 4 + h, t0 = b * SEQ + n * 128;
                const int ti = t0 + 16 * wave + fr;
                const bool more = (n + 1 < 32);
                if (more) { const u32x4* pvp = (const u32x4*)(proj1 + (size_t)(t0 + 128 + vr) * ODD_IN + vcol + 16 * vcs); pv0 = pvp[0]; pv1 = pvp[1]; }
                f32x4 ac[4], ai[4];
#pragma unroll
                for (int ct = 0; ct < 4; ++ct) { ac[ct] = (f32x4){0.f, 0.f, 0.f, 0.f}; ai[ct] = (f32x4){0.f, 0.f, 0.f, 0.f}; }
#pragma unroll
                for (int s = 0; s < 8; ++s)
#pragma unroll
                    for (int ct = 0; ct < 4; ++ct) ac[ct] = mfma16(*(const LAS bf16x8*)(St + (16 * ct + fr) * 264 + 32 * s + 8 * fq), qf[s], ac[ct]);
                if (more) { const bf16_t* pq = proj1 + (size_t)(ti + 128) * ODD_IN + h * 256 + 8 * fq;
#pragma unroll
                    for (int s = 0; s < 8; ++s) qf[s] = *(const bf16x8*)(pq + 32 * s); }
#pragma unroll
                for (int s = 0; s < 4; ++s)
#pragma unroll
                    for (int ct = 0; ct < 4; ++ct) ai[ct] = mfma16(*(const LAS bf16x8*)(Vt + (16 * ct + fr) * 136 + 32 * s + 8 * fq), nf[s], ai[ct]);
                if (more) { const bf16_t* pin = inner + ((size_t)(item + 4) * 128 + 16 * wave + fr) * 128 + 8 * fq;
#pragma unroll
                    for (int s = 0; s < 4; ++s) nf[s] = *(const bf16x8*)(pin + 32 * s); }
                {
                    float ssq = 0.f;
                    bf16_t* po = proj1 + (size_t)ti * ODD_IN + vcol + 4 * fq;
#pragma unroll
                    for (int ct = 0; ct < 4; ++ct) {
                        f32x4 o = ai[ct] + ac[ct] * xi;
                        ssq += (o[0] * o[0] + o[1] * o[1]) + (o[2] * o[2] + o[3] * o[3]);
                        u32x2 w; w.x = cvt_pk_bf16(o[0] * silu_f(lo_bf(zr[ct].x)), o[1] * silu_f(hi_bf(zr[ct].x))); w.y = cvt_pk_bf16(o[2] * silu_f(lo_bf(zr[ct].y)), o[3] * silu_f(hi_bf(zr[ct].y)));
                        *(u32x2*)(po + 16 * ct) = w;
                    }
                    if (more) {
#pragma unroll
                        for (int ct = 0; ct < 4; ++ct) zr[ct] = *(const u32x2*)(po + (size_t)128 * ODD_IN + 2048 + 16 * ct); }
                    ssq += __shfl_xor(ssq, 16); ssq += __shfl_xor(ssq, 32);
                    if (fq == 0) SSQ[((size_t)(h * 8 + sl)) * T + ti] = ssq;
                }
#pragma unroll
                for (int mt = 0; mt < 2; ++mt)
#pragma unroll
                    for (int nt = 0; nt < 4; ++nt) { Sacc[mt][nt] = Sacc[mt][nt] * gC;
#pragma unroll
                        for (int s = 0; s < 4; ++s) Sacc[mt][nt] = mfma16(kf[mt][s], *(const LAS bf16x8*)(Vt + (16 * nt + fr) * 136 + 32 * s + 8 * fq), Sacc[mt][nt]); }
                if (more) { const bf16_t* pk = kzT + ((size_t)(item + 4) * 256 + 32 * wave + fr) * 128 + 8 * fq;
#pragma unroll
                    for (int mt = 0; mt < 2; ++mt)
#pragma unroll
                        for (int s = 0; s < 4; ++s) kf[mt][s] = *(const bf16x8*)(pk + (size_t)mt * 16 * 128 + 32 * s); }
                __syncthreads();
#pragma unroll
                for (int mt = 0; mt < 2; ++mt)
#pragma unroll
                    for (int nt = 0; nt < 4; ++nt) { u32x2 w; w.x = cvt_pk_bf16(Sacc[mt][nt][0], Sacc[mt][nt][1]); w.y = cvt_pk_bf16(Sacc[mt][nt][2], Sacc[mt][nt][3]);
                        *(LAS u32x2*)(St + (16 * nt + fr) * 264 + 32 * wave + 16 * mt + 4 * fq) = w; }
                if (more) RET_VSTORE();
                __syncthreads();
            }
#undef RET_VSTORE
        }
    }
    SEAM(12);

    if (RUN(13)) { PHASE_IDS;
        bf16_t* proj1 = (bf16_t*)(ws + WS_PROJ1); const float* SSQ = (const float*)(ws + WS_SSQ);
        for (int t = gw; t < T; t += ngw) {
#pragma unroll
            for (int j = 0; j < 4; ++j) {
                float ssum = 0.f;
#pragma unroll
                for (int q8 = 0; q8 < 8; ++q8) ssum += SSQ[((size_t)(j * 8 + q8)) * T + t];
                const float rstd = rsqrtf(ssum * (1.f / 512.f) + EPS);
                u32x4* p = (u32x4*)(proj1 + (size_t)t * ODD_IN + 2048 + j * 512) + lane;
                const u32x4 v = *p; u32x4 o;
                o.x = cvt_pk_bf16(lo_bf(v.x) * rstd, hi_bf(v.x) * rstd); o.y = cvt_pk_bf16(lo_bf(v.y) * rstd, hi_bf(v.y) * rstd);
                o.z = cvt_pk_bf16(lo_bf(v.z) * rstd, hi_bf(v.z) * rstd); o.w = cvt_pk_bf16(lo_bf(v.w) * rstd, hi_bf(v.w) * rstd);
                *p = o;
            }
        }
        convert_moe(args, 1, (LAS float*)(lds + wave * 8448), gw, ngw, lane);
    }
    SEAM(13);

    if (RUN(14)) { PHASE_IDS;
        pg8::Gemm g{(const bf16_t*)(ws + WS_PROJ1) + 2048, (const bf16_t*)(ws + WS_WOUT1), ODD_IN, 2048};
        pg8::DenseOrder S; S.init(T, D, G, bid, ODD_IN, 2048);
        pg8::EpiResF32 E{args.out, args.out, D};
        pg8::gemm_phase(lds, g, S, E);
    }
    SEAM(14);

    if (RUN(15)) { PHASE_IDS; moe_route(args, 1, lds, bid, G, tid, lane, wave); }
    SEAM(15);
    if (RUN(16)) { PHASE_IDS; moe_scatter(args, 1, lds, bid, G, tid, lane, wave); }
    SEAM(16);
    if (RUN(17)) { PHASE_IDS; moe_gemm1(args, 1, lds, bid, G, tid); }
    SEAM(17);
    if (RUN(18)) { PHASE_IDS; moe_gemm2(args, 1, lds, bid, G, tid); }
    SEAM(18);
    if (RUN(19)) { PHASE_IDS; moe_combine<false>(args, nullptr, nullptr, gw, ngw, lane); }
#ifdef CKPROBE
    {
        xcd_barrier(xbar);
        unsigned* ckd = (unsigned*)(ws + WS_CTL) + 256;
        CKPROBE;
        xcd_barrier(xbar);
        const unsigned c = xb_ld(ckd);
        const float f = (float)((c >> 4) & 0xFFFFu) + 1.0f;
        f32x4* o = (f32x4*)args.out; for (size_t i = (size_t)bid * NTHREADS + tid; i < (size_t)T * D / 4; i += (size_t)G * NTHREADS) o[i] = (f32x4){f, f, f, f};
    }
#endif
#undef IN
#undef SEAM
}

extern "C" void kernel_launch(void* const* d_in, const int* in_sizes, int n_in, void* d_out, int out_size, void* d_ws, size_t ws_size, hipStream_t stream) {
    static int grid = 0;
    if (grid == 0) {
        if (n_in != 22 || in_sizes[0] != T * D || out_size != T * D || ws_size < WS_END) { fprintf(stderr, "kernel_launch: unexpected shapes / workspace (n_in %d, ws %zu, need %zu)\n", n_in, ws_size, (size_t)WS_END); grid = -1; return; }
        int dev = 0, cus = 0, per_cu = 0;
        (void)hipGetDevice(&dev); (void)hipDeviceGetAttribute(&cus, hipDeviceAttributeMultiprocessorCount, dev);
        if (hipFuncSetAttribute((const void*)fwd_kernel, hipFuncAttributeMaxDynamicSharedMemorySize, LDS_BYTES) != hipSuccess) { fprintf(stderr, "kernel_launch: hipFuncSetAttribute failed\n"); grid = -1; return; }
        if (hipOccupancyMaxActiveBlocksPerMultiprocessor(&per_cu, (const void*)fwd_kernel, NTHREADS, LDS_BYTES) != hipSuccess || per_cu < 1) { fprintf(stderr, "kernel_launch: occupancy query says %d\n", per_cu); grid = -1; return; }
        (void)hipGetLastError();
        grid = cus;
    }
    if (grid < 0) return;
    (void)hipMemsetAsync((char*)d_ws + WS_CTL, 0, 65536, stream);
    Args a{};
    for (int i = 0; i < 22; ++i) a.in[i] = (const float*)d_in[i];
    a.out = (float*)d_out; a.ws = (unsigned char*)d_ws; a.ph_lo = 0; a.ph_hi = PHHI;
    void* kargs[] = {&a};
    hipError_t e = hipLaunchCooperativeKernel((const void*)fwd_kernel, dim3(grid), dim3(NTHREADS), kargs, LDS_BYTES, stream);
    if (e != hipSuccess) fprintf(stderr, "kernel_launch: cooperative launch failed: %s (grid %d)\n", hipGetErrorString(e), grid);
}
```

```cpp
#include <hip/hip_runtime.h>
#include <utility>
#include <hip/hip_cooperative_groups.h>
#include <cstdio>
#include <cstdint>
namespace cg = cooperative_groups;

#define LAS __attribute__((address_space(3)))
typedef unsigned short bf16_t;
typedef short bf16x8 __attribute__((ext_vector_type(8)));
typedef float f32x4 __attribute__((ext_vector_type(4)));
typedef float f32x2 __attribute__((ext_vector_type(2)));
typedef unsigned u32x4 __attribute__((ext_vector_type(4)));
typedef unsigned u32x2 __attribute__((ext_vector_type(2)));

constexpr int NB = 8, SEQ = 4096, D = 1024, T = NB * SEQ;
constexpr int EVEN_IN = 2824, N0 = 2816;
constexpr int ODD_IN = 6144;
constexpr int NEXP = 32, DEXP = 512;
constexpr int ROWS_PAD = 73728;
constexpr float EPS = 1e-6f;
constexpr int NWAVES = 8, NTHREADS = 512;
constexpr int LDS_BYTES = 163840;

constexpr size_t MiB = 1u << 20;
constexpr size_t WS_CTL = 0;
constexpr size_t WS_WIN0 = 1 * MiB;
constexpr size_t WS_WOUT0 = 7 * MiB;
constexpr size_t WS_WIN1 = 9 * MiB;
constexpr size_t WS_WOUT1 = 21 * MiB;
constexpr size_t WS_X = 25 * MiB;
constexpr size_t WS_XB1 = WS_X;
constexpr size_t WS_XB2 = WS_X + 64 * MiB;
constexpr size_t WS_H1 = WS_X;
constexpr size_t WS_INNER = WS_X;
constexpr size_t WS_KZT = WS_X + 32 * MiB;
constexpr size_t WS_SM = 121 * MiB;
constexpr size_t WS_BAB = WS_SM;
constexpr size_t WS_RE = WS_SM + 1 * MiB;
constexpr size_t WS_RG = WS_RE + 256 * 1024;
constexpr size_t WS_RS = WS_RG + 256 * 1024;
constexpr size_t WS_RP = WS_RS + 256 * 1024;
constexpr size_t WS_SSQ = WS_SM + 2 * MiB;
constexpr size_t WS_GL = WS_SM + 6 * MiB;
constexpr size_t WS_ROWTOK = WS_SM + 7 * MiB + 65536;
constexpr size_t WS_BC = WS_SM + 7 * MiB;
constexpr size_t WS_A = 129 * MiB;
constexpr size_t WS_PROJ0 = WS_A;
constexpr size_t WS_HMIX0 = WS_A + 176 * MiB;
constexpr size_t WS_GU = WS_A + 240 * MiB;
constexpr size_t WS_GW = WS_A + 272 * MiB;
constexpr size_t WS_GQD = WS_A + 304 * MiB;
constexpr size_t WS_GKDT = WS_A + 336 * MiB;
constexpr size_t WS_GA = WS_A + 368 * MiB;
constexpr size_t WS_XN = WS_A;
constexpr size_t WS_XROWS = WS_A + 64 * MiB;
constexpr size_t WS_HID = WS_A + 208 * MiB;
constexpr size_t WS_PROJ1 = WS_A;
constexpr size_t WS_XB2L1 = 513 * MiB;
constexpr size_t WS_END = 545 * MiB;

__device__ __forceinline__ float bf2f(unsigned b) { return __uint_as_float(b << 16); }
typedef __bf16 bf16x2_t __attribute__((ext_vector_type(2)));
__device__ __forceinline__ unsigned cvt_pk_bf16(float lo, float hi) { f32x2 v = {lo, hi}; bf16x2_t b = __builtin_convertvector(v, bf16x2_t); return __builtin_bit_cast(unsigned, b); }
__device__ __forceinline__ unsigned short f2bf(float f) { return (unsigned short)(cvt_pk_bf16(f, 0.f) & 0xffffu); }
__device__ __forceinline__ float lo_bf(unsigned w) { return __uint_as_float(w << 16); }
__device__ __forceinline__ float hi_bf(unsigned w) { return __uint_as_float(w & 0xffff0000u); }
__device__ __forceinline__ float silu_f(float x) { return x * __builtin_amdgcn_rcpf(1.0f + __expf(-x)); }
__device__ __forceinline__ float sigmoid_f(float x) { return __builtin_amdgcn_rcpf(1.0f + __expf(-x)); }
__device__ __forceinline__ f32x4 mfma16(bf16x8 a, bf16x8 b, f32x4 c) { return __builtin_amdgcn_mfma_f32_16x16x32_bf16(a, b, c, 0, 0, 0); }
__device__ __forceinline__ bf16x8 mk8(u32x2 lo, u32x2 hi) { u32x4 v; v.x = lo.x; v.y = lo.y; v.z = hi.x; v.w = hi.y; return __builtin_bit_cast(bf16x8, v); }
__device__ __forceinline__ bf16x8 mk8f(f32x4 a, f32x4 b) { u32x4 v; v.x = cvt_pk_bf16(a[0], a[1]); v.y = cvt_pk_bf16(a[2], a[3]); v.z = cvt_pk_bf16(b[0], b[1]); v.w = cvt_pk_bf16(b[2], b[3]); return __builtin_bit_cast(bf16x8, v); }
template <int J> __device__ __forceinline__ void fmac_bc(float& acc, int l, float u) {
    if constexpr (J == 0) asm("s_nop 1\n\tv_fmac_f32_dpp %0, %1, %2 row_newbcast:0 row_mask:0xf bank_mask:0xf" : "+v"(acc) : "v"(l), "v"(u));
    else asm("v_fmac_f32_dpp %0, %1, %2 row_newbcast:%3 row_mask:0xf bank_mask:0xf" : "+v"(acc) : "v"(l), "v"(u), "n"(J));
}
template <int... Js> __device__ __forceinline__ void solve_terms(float (&s)[4], const int (&lc)[4], const float (&U)[64], std::integer_sequence<int, Js...>) { (fmac_bc<(Js & 15)>(s[Js & 3], lc[Js >> 4], U[Js]), ...); }
template <int I> __device__ __forceinline__ void solve_row(float (&U)[64], int (&ln)[4], const LAS float* Lm, const LAS unsigned short* Rb, int l16, int c) {
    const int lc[4] = {ln[0], ln[1], ln[2], ln[3]};
    if constexpr (I + 1 < 64) {
#pragma unroll
        for (int k = 0; k < 4; ++k) if (16 * k < I + 1) ln[k] = __builtin_bit_cast(int, Lm[(I + 1) * 64 + 16 * k + l16]);
    }
    float s[4] = {__uint_as_float((unsigned)Rb[I * 264 + c] << 16), 0.f, 0.f, 0.f};
    solve_terms(s, lc, U, std::make_integer_sequence<int, I>{});
    U[I] = (s[0] + s[1]) + (s[2] + s[3]);
}
template <int... Is> __device__ __forceinline__ void solve_rows(float (&U)[64], int (&ln)[4], const LAS float* Lm, const LAS unsigned short* Rb, int l16, int c, std::integer_sequence<int, Is...>) { (solve_row<Is + 1>(U, ln, Lm, Rb, l16, c), ...); }
__device__ __forceinline__ float wave_sum(float v) {
#pragma unroll
    for (int o = 1; o < 64; o <<= 1) v += __shfl_xor(v, o);
    return v;
}
__device__ __forceinline__ void sincos_rev(float ang, float& s, float& c) {
    float r = ang * 0.15915494309189535f; r = r - floorf(r);
    s = __builtin_amdgcn_sinf(r); c = __builtin_amdgcn_cosf(r);
}

namespace pg8 {
constexpr int BM = 256, BK = 64, HALF = 128, HTB = HALF * BK * 2, STAGE_BYTES = 8 * HTB, NXCD = 8, WGM = 4;
__device__ __forceinline__ int lds_byte(int r, int c) { const int st = (r >> 4) * 2 + (c >> 5), rr = r & 15, cc = c & 31, ob = rr * 64 + cc * 2; return st * 1024 + (ob ^ (((ob >> 9) & 1) << 5)); }
__device__ __forceinline__ void stage_rc(int b, int& R, int& C) { const int st = b / 1024, sb = b % 1024, swz = sb ^ (((sb >> 9) & 1) << 5); R = (st >> 1) * 16 + swz / 64; C = (st & 1) * 32 + (swz % 64) / 2; }
__device__ __forceinline__ int perm32(int rho) { const int n = rho >> 4, i = rho & 15; return 8 * (i >> 2) + 4 * n + (i & 3); }

struct Unit { size_t aoff, boff; int pm, pn; };
struct Gemm { const bf16_t* A; const bf16_t* Bt; int lda, K; const int* rowtok; };

struct DenseOrder {
    int nM, nN, nwg, G, c, lda, K;
    __device__ void init(int M, int N, int G_, int c_, int lda_, int K_) { nM = M / BM; nN = N / BM; nwg = nM * nN; G = G_; c = c_; lda = lda_; K = K_; }
    __device__ bool next(int i, Unit& u) const {
        const long L = (long)i * G + c; if (L >= nwg) return false;
        int wgid = (int)L; { const int q = nwg / NXCD, r = nwg % NXCD, xcd = wgid % NXCD, off = wgid / NXCD; wgid = (xcd < r ? xcd * (q + 1) : r * (q + 1) + (xcd - r) * q) + off; }
        const int nig = WGM * nN, gid = wgid / nig, fm = gid * WGM, gsz = (nM - fm) < WGM ? (nM - fm) : WGM;
        u.pm = fm + ((wgid % nig) % gsz); u.pn = (wgid % nig) / gsz;
        u.aoff = (size_t)u.pm * BM * lda * 2; u.boff = (size_t)u.pn * BM * K * 2; return true;
    }
};
struct GroupedOrder {
    const LAS int* tile_e; int ntiles, G, c, lda, K; size_t estride;
    __device__ bool next(int i, Unit& u) const {
        const int L = i * G + c; if (L >= ntiles * 4) return false;
        const int rt = L >> 2, pn = L & 3; const int e = tile_e[rt];
        u.pm = rt; u.pn = pn; u.aoff = (size_t)rt * BM * lda * 2; u.boff = (size_t)e * estride + (size_t)pn * BM * K * 2; return true;
    }
};

struct EpiBf16 {
    static constexpr bool PERM = true;
    bf16_t* O; int ldc;
    __device__ __forceinline__ void operator()(const f32x4 (&acc)[2][2][4][2], const Unit& u, int wr, int wc, int fr, int fq) const {
        const int row0 = u.pm * BM + wr * 64 + fr; const int col0 = u.pn * BM + wc * 32 + 8 * fq;
#pragma unroll
        for (int ai = 0; ai < 2; ++ai)
#pragma unroll
            for (int m = 0; m < 4; ++m) { bf16_t* rowp = O + (size_t)(row0 + ai * HALF + m * 16) * ldc + col0;
#pragma unroll
                for (int bj = 0; bj < 2; ++bj) { const f32x4 v0 = acc[ai][bj][m][0], v1 = acc[ai][bj][m][1];
                    u32x4 w; w.x = cvt_pk_bf16(v0[0], v0[1]); w.y = cvt_pk_bf16(v0[2], v0[3]); w.z = cvt_pk_bf16(v1[0], v1[1]); w.w = cvt_pk_bf16(v1[2], v1[3]);
                    *(u32x4*)(rowp + bj * HALF) = w; } }
    }
};
struct EpiResF32 {
    static constexpr bool PERM = false;
    const float* base; float* out; int ldc;
    __device__ __forceinline__ void operator()(const f32x4 (&acc)[2][2][4][2], const Unit& u, int wr, int wc, int fr, int fq) const {
        const int row0 = u.pm * BM + wr * 64 + fr, col0 = u.pn * BM + wc * 32 + 4 * fq;
#pragma unroll
        for (int ai = 0; ai < 2; ++ai)
#pragma unroll
            for (int m = 0; m < 4; ++m) { const size_t off = (size_t)(row0 + ai * HALF + m * 16) * ldc + col0;
#pragma unroll
                for (int bj = 0; bj < 2; ++bj)
#pragma unroll
                    for (int n = 0; n < 2; ++n) { const f32x4 b = *(const f32x4*)(base + off + bj * HALF + n * 16); *(f32x4*)(out + off + bj * HALF + n * 16) = b + acc[ai][bj][m][n]; } }
    }
};
struct EpiSwiGLU {
    static constexpr bool PERM = false;
    bf16_t* H;
    __device__ __forceinline__ void operator()(const f32x4 (&acc)[2][2][4][2], const Unit& u, int wr, int wc, int fr, int fq) const {
        const int row0 = u.pm * BM + wr * 64 + fr;
#pragma unroll
        for (int ai = 0; ai < 2; ++ai)
#pragma unroll
            for (int m = 0; m < 4; ++m) { bf16_t* rowp = H + (size_t)(row0 + ai * HALF + m * 16) * DEXP;
#pragma unroll
                for (int bj = 0; bj < 2; ++bj) { const f32x4 g = acc[ai][bj][m][0], up = acc[ai][bj][m][1];
                    const int hc = 16 * (8 * u.pn + 4 * bj + wc) + 4 * fq;
                    u32x2 w; w.x = cvt_pk_bf16(silu_f(g[0]) * up[0], silu_f(g[1]) * up[1]); w.y = cvt_pk_bf16(silu_f(g[2]) * up[2], silu_f(g[3]) * up[3]);
                    *(u32x2*)(rowp + hc) = w; } }
    }
};

template <class Epi, class Sched, bool GATHER = false>
__device__ __forceinline__ void gemm_phase(LAS unsigned char* lds, const Gemm g, const Sched& S, const Epi& E) {
    const int tid = threadIdx.x, wid = __builtin_amdgcn_readfirstlane(tid >> 6), lane = tid & 63, wr = wid >> 2, wc = wid & 3, fr = lane & 15, fq = lane >> 4;
    const int K = g.K, nt = K / BK;
    unsigned voffA[2], voffB[2]; int gR[2]; unsigned gC[2];
#pragma unroll
    for (int i = 0; i < 2; ++i) { int R, C; stage_rc(tid * 16 + i * 8192, R, C); const int Rb = Epi::PERM ? ((R & ~31) + perm32(R & 31)) : R;
        voffA[i] = (unsigned)(R * g.lda + C) * 2u; voffB[i] = (unsigned)(Rb * K + C) * 2u; gR[i] = R; gC[i] = (unsigned)C * 2u; }
    unsigned gA[2][2], gN[2][2];
#define PG8_GLOAD(dst, pm_) do { _Pragma("unroll") for (int _h = 0; _h < 2; ++_h) _Pragma("unroll") for (int _i = 0; _i < 2; ++_i) \
        dst[_h][_i] = (unsigned)g.rowtok[(pm_) * BM + _h * HALF + gR[_i]] * (unsigned)(g.lda * 2) + gC[_i]; } while (0)
    const size_t kstep = (size_t)(BK * 2);
    const size_t hstepA = (size_t)HALF * g.lda * 2, hstepB = (size_t)HALF * K * 2;
    const unsigned ldsw = (unsigned)wid * 1024u;
    const int aoff = lds_byte(wr * 64 + fr, fq * 8), boff = lds_byte(wc * 32 + fr, fq * 8);
#define PG8_SA(b, h) (((b) * 2 + (h)) * HTB)
#define PG8_SB(b, h) ((4 + (b) * 2 + (h)) * HTB)
#define PG8_STAGE(bufoff, gbase, voff) do { _Pragma("unroll") for (int _i = 0; _i < 2; ++_i) \
        __builtin_amdgcn_global_load_lds((const unsigned*)((const char*)(gbase) + (voff)[_i]), (LAS unsigned*)(lds + (bufoff) + ldsw + _i * 8192), 16, 0, 0); } while (0)
#define PG8_STAGE_A(bufoff, gbase, h, OFFS) do { if constexpr (GATHER) { PG8_STAGE(bufoff, gbase, OFFS[h]); } else { PG8_STAGE(bufoff, (gbase) + (h) * hstepA, voffA); } } while (0)
#define PG8_LDA(dst, b, h) do { _Pragma("unroll") for (int m = 0; m < 4; ++m) _Pragma("unroll") for (int k = 0; k < 2; ++k) dst[m][k] = *(const LAS bf16x8*)(lds + PG8_SA(b, h) + aoff + m * 2048 + k * 1024); } while (0)
#define PG8_LDB(dst, b, h) do { _Pragma("unroll") for (int n = 0; n < 2; ++n) _Pragma("unroll") for (int k = 0; k < 2; ++k) dst[n][k] = *(const LAS bf16x8*)(lds + PG8_SB(b, h) + boff + n * 2048 + k * 1024); } while (0)
#define PG8_MMA(ai, bj, At, Bt) do { __builtin_amdgcn_s_setprio(1); _Pragma("unroll") for (int m = 0; m < 4; ++m) _Pragma("unroll") for (int n = 0; n < 2; ++n) _Pragma("unroll") for (int k = 0; k < 2; ++k) \
        acc[ai][bj][m][n] = __builtin_amdgcn_mfma_f32_16x16x32_bf16(Bt[n][k], At[m][k], acc[ai][bj][m][n], 0, 0, 0); __builtin_amdgcn_s_setprio(0); } while (0)
#define PG8_WAIT_V(n) asm volatile("s_waitcnt vmcnt(" #n ")" ::: "memory")
#define PG8_WAIT_L(n) asm volatile("s_waitcnt lgkmcnt(" #n ")" ::: "memory")
#define PG8_BAR __builtin_amdgcn_s_barrier()
#define PG8_SCHED __builtin_amdgcn_sched_barrier(0)
    Unit cur, nxt; int ui = 0;
    if (!S.next(0, cur)) return;
    f32x4 acc[2][2][4][2];
#pragma unroll
    for (int a = 0; a < 2; ++a)
#pragma unroll
        for (int b = 0; b < 2; ++b)
#pragma unroll
            for (int m = 0; m < 4; ++m)
#pragma unroll
                for (int n = 0; n < 2; ++n) acc[a][b][m][n] = (f32x4){0.f, 0.f, 0.f, 0.f};
    bf16x8 At[4][2], B0[2][2], B1[2][2];
    const char* cA = (const char*)g.A + cur.aoff; const char* cB = (const char*)g.Bt + cur.boff;
    if constexpr (GATHER) { PG8_GLOAD(gA, cur.pm); } else { gA[0][0] = gA[0][1] = gA[1][0] = gA[1][1] = 0u; }
#pragma unroll
    for (int _h = 0; _h < 2; ++_h) { gN[_h][0] = gA[_h][0]; gN[_h][1] = gA[_h][1]; }
    PG8_STAGE(PG8_SB(0, 0), cB, voffB); PG8_STAGE(PG8_SB(0, 1), cB + hstepB, voffB); PG8_STAGE_A(PG8_SA(0, 0), cA, 0, gA); PG8_STAGE_A(PG8_SA(0, 1), cA, 1, gA);
    if (wr == 1) PG8_BAR;
    PG8_WAIT_V(2); PG8_BAR;
    PG8_STAGE(PG8_SB(1, 0), cB + kstep, voffB); PG8_STAGE_A(PG8_SA(1, 0), cA + kstep, 0, gA); PG8_STAGE(PG8_SB(1, 1), cB + hstepB + kstep, voffB);
    PG8_WAIT_V(6); PG8_BAR;
    for (;;) {
        const bool has_next = S.next(ui + 1, nxt);
        const char* nA = has_next ? (const char*)g.A + nxt.aoff : cA; const char* nB = has_next ? (const char*)g.Bt + nxt.boff : cB;
        if constexpr (GATHER) { if (has_next) { PG8_GLOAD(gN, nxt.pm); } else {
#pragma unroll
            for (int _h = 0; _h < 2; ++_h) { gN[_h][0] = gA[_h][0]; gN[_h][1] = gA[_h][1]; } } }
        asm volatile(".p2align 6\n\ts_nop 0" ::: "memory");
        for (int t = 0; t < nt; t += 2) {
            const bool last = (t == nt - 2);
            const char* a1 = cA + (size_t)(t + 1) * kstep;
            const char* a2 = last ? nA : cA + (size_t)(t + 2) * kstep; const char* b2 = last ? nB : cB + (size_t)(t + 2) * kstep;
            const char* a3 = a2 + kstep; const char* b3 = b2 + kstep;
            unsigned g2[2][2];
#pragma unroll
            for (int _h = 0; _h < 2; ++_h) { g2[_h][0] = last ? gN[_h][0] : gA[_h][0]; g2[_h][1] = last ? gN[_h][1] : gA[_h][1]; }
            PG8_LDB(B0, 0, 0); PG8_LDB(B1, 0, 1); PG8_SCHED; PG8_LDA(At, 0, 0); PG8_STAGE_A(PG8_SA(1, 1), a1, 1, gA);
            PG8_WAIT_V(8); PG8_WAIT_L(0); PG8_BAR; PG8_MMA(0, 0, At, B0); PG8_MMA(0, 1, At, B1); PG8_BAR; PG8_SCHED;
            PG8_LDA(At, 0, 1); PG8_STAGE(PG8_SB(0, 0), b2, voffB); PG8_STAGE(PG8_SB(0, 1), b2 + hstepB, voffB); PG8_STAGE_A(PG8_SA(0, 0), a2, 0, g2);
            PG8_WAIT_V(8); PG8_WAIT_L(0); PG8_BAR; PG8_MMA(1, 0, At, B0); PG8_MMA(1, 1, At, B1); PG8_BAR; PG8_SCHED;
            PG8_LDB(B0, 1, 0); PG8_LDB(B1, 1, 1); PG8_SCHED; PG8_LDA(At, 1, 0); PG8_STAGE_A(PG8_SA(0, 1), a2, 1, g2);
            PG8_WAIT_V(8); PG8_WAIT_L(0); PG8_BAR; PG8_MMA(0, 0, At, B0); PG8_MMA(0, 1, At, B1); PG8_BAR; PG8_SCHED;
            PG8_LDA(At, 1, 1); PG8_STAGE(PG8_SB(1, 0), b3, voffB); PG8_STAGE(PG8_SB(1, 1), b3 + hstepB, voffB); PG8_STAGE_A(PG8_SA(1, 0), a3, 0, g2);
            PG8_WAIT_V(8); PG8_WAIT_L(0); PG8_BAR; PG8_MMA(1, 0, At, B0); PG8_MMA(1, 1, At, B1); PG8_BAR; PG8_SCHED;
        }
        if (wr == 0) PG8_BAR;
        E(acc, cur, wr, wc, fr, fq);
        if (!has_next) break;
#pragma unroll
        for (int a = 0; a < 2; ++a)
#pragma unroll
            for (int b = 0; b < 2; ++b)
#pragma unroll
                for (int m = 0; m < 4; ++m)
#pragma unroll
                    for (int n = 0; n < 2; ++n) acc[a][b][m][n] = (f32x4){0.f, 0.f, 0.f, 0.f};
        cur = nxt; cA = nA; cB = nB; ++ui;
#pragma unroll
        for (int _h = 0; _h < 2; ++_h) { gA[_h][0] = gN[_h][0]; gA[_h][1] = gN[_h][1]; }
        if (wr == 1) PG8_BAR;
    }
    PG8_WAIT_V(0);
    PG8_BAR;
#undef PG8_SA
#undef PG8_SB
#undef PG8_STAGE
#undef PG8_STAGE_A
#undef PG8_GLOAD
#undef PG8_LDA
#undef PG8_LDB
#undef PG8_MMA
#undef PG8_WAIT_V
#undef PG8_WAIT_L
#undef PG8_BAR
#undef PG8_SCHED
}
}

#define XB_TMO      128
#define XB_XCNT(j)  (256  + 64 * (j))
#define XB_XSUB(j)  (1280 + 64 * (j))
#define XB_XGEN(j)  (2304 + 64 * (j))
#define XB_TOP      3328
#define XB_TOPGEN   3392
#define XCD_BAR_WORDS 3456
#define XB_SPIN_CAP (1u << 18)
__device__ __forceinline__ unsigned xb_ld(unsigned* p)              { return __hip_atomic_load(p, __ATOMIC_RELAXED, __HIP_MEMORY_SCOPE_AGENT); }
__device__ __forceinline__ unsigned xb_add(unsigned* p, unsigned v) { return __hip_atomic_fetch_add(p, v, __ATOMIC_RELAXED, __HIP_MEMORY_SCOPE_AGENT); }
__device__ __forceinline__ unsigned xb_xcc_id() { return (unsigned)__builtin_amdgcn_s_getreg((3 << 11) | 20) & 0xFu; }
#define XB_SPIN(cond, bar) do { unsigned _sp = 0; while (cond) { __builtin_amdgcn_s_sleep(1); \
    if ((++_sp & 255u) == 0u) { if (xb_ld(&(bar)[XB_TMO])) break; if (_sp > XB_SPIN_CAP) { atomicAdd(&(bar)[XB_TMO], 1u); break; } } } } while (0)
struct XcdBarrier { unsigned* bar; unsigned x; volatile LAS unsigned* st; };
__device__ __forceinline__ XcdBarrier xcd_barrier_post(unsigned* bar, volatile LAS unsigned* st) {
    XcdBarrier b; b.bar = bar; b.x = xb_xcc_id(); b.st = st;
    if (threadIdx.x == 0) (void)xb_add(&bar[XB_XCNT(b.x)], 1u);
    return b;
}
__device__ __forceinline__ void xcd_barrier_complete(unsigned* bar, unsigned x, unsigned& nloc, unsigned& nx) {
    const unsigned G = gridDim.x * gridDim.y * gridDim.z;
    unsigned sum, cnt, mine, sp = 0u;
    for (;;) {
        sum = 0u; cnt = 0u; mine = 0u;
#pragma unroll
        for (unsigned j = 0; j < 16; ++j) { const unsigned c = xb_ld(&bar[XB_XCNT(j)]); sum += c; cnt += (c > 0u) ? 1u : 0u; mine = (j == x) ? c : mine; }
        if (sum == G) break;
        __builtin_amdgcn_s_sleep(1);
        if ((++sp & 255u) == 0u) { if (xb_ld(&bar[XB_TMO])) break; if (sp > XB_SPIN_CAP) { atomicAdd(&bar[XB_TMO], 1u); break; } }
    }
    nloc = mine > 0u ? mine : 1u; nx = cnt > 0u ? cnt : 1u;
}
__device__ __forceinline__ void xcd_barrier(const XcdBarrier& b) {
    asm volatile("s_waitcnt vmcnt(0)" ::: "memory");
    __syncthreads();
    if (threadIdx.x == 0) {
        unsigned* bar = b.bar;
        __builtin_amdgcn_s_waitcnt(0);
        unsigned nloc = b.st[0], nx = b.st[1];
        if (nloc == 0u) { xcd_barrier_complete(bar, b.x, nloc, nx); b.st[0] = nloc; b.st[1] = nx; }
        const unsigned old = xb_add(&bar[XB_XSUB(b.x)], 1u);
        const unsigned gen = old / nloc;
        if (old + 1u == (gen + 1u) * nloc) {
            __builtin_amdgcn_fence(__ATOMIC_RELEASE, "agent");
            asm volatile("s_waitcnt vmcnt(0)" ::: "memory");
            const unsigned og = xb_add(&bar[XB_TOP], 1u);
            const unsigned tg = og / nx;
            if (og + 1u == (tg + 1u) * nx) xb_add(&bar[XB_TOPGEN], 1u);
            else XB_SPIN(xb_ld(&bar[XB_TOPGEN]) == tg, bar);
            __builtin_amdgcn_fence(__ATOMIC_ACQUIRE, "agent");
            xb_add(&bar[XB_XGEN(b.x)], 1u);
            asm volatile("s_waitcnt vmcnt(0)" ::: "memory");
        } else {
            XB_SPIN(xb_ld(&bar[XB_XGEN(b.x)]) == gen, bar);
            __builtin_amdgcn_fence(__ATOMIC_ACQUIRE, "agent");
            asm volatile("s_waitcnt vmcnt(0)" ::: "memory");
        }
    }
    __syncthreads();
}

struct Args {
    const float* in[22];
    float* out; unsigned char* ws;
    int ph_lo, ph_hi;
};
enum { I_X = 0, I_LNE, I_WINE, I_CONVW, I_ALOG, I_DTB, I_QG, I_KG, I_SINK, I_GDNG, I_WOUTE, I_LNO, I_WINO, I_WOUTO, I_LNF, I_WRG, I_BRG, I_WRE, I_BRE, I_WG, I_WU, I_WD };

__device__ __forceinline__ void transpose_item(const float* W, int K, int ldw, int ncols, bf16_t* WT, int mode, LAS float* scr, int item, int lane) {
    const int nblk = ncols / 32, kb = item / nblk, nb = item % nblk, k0 = 64 * kb, n0 = 32 * nb;
#pragma unroll 8
    for (int i = 0; i < 32; ++i) { const int kk = 2 * i + (lane >> 5); scr[kk * 33 + (lane & 31)] = W[(size_t)(k0 + kk) * ldw + n0 + (lane & 31)]; }
    asm volatile("s_waitcnt lgkmcnt(0)" ::: "memory");
    const int c = lane & 7;
#pragma unroll
    for (int j = 0; j < 4; ++j) { const int n = (lane >> 3) + 8 * j; const LAS float* s = scr + (8 * c) * 33 + n;
        u32x4 o; o.x = cvt_pk_bf16(s[0 * 33], s[1 * 33]); o.y = cvt_pk_bf16(s[2 * 33], s[3 * 33]); o.z = cvt_pk_bf16(s[4 * 33], s[5 * 33]); o.w = cvt_pk_bf16(s[6 * 33], s[7 * 33]);
        const int ng = n0 + n; const int row = (mode == 0) ? ng : (32 * (ng >> 4) + (ng & 15) + (mode == 2 ? 16 : 0));
        *(u32x4*)(WT + (size_t)row * K + k0 + 8 * c) = o; }
    asm volatile("s_waitcnt lgkmcnt(0)" ::: "memory");
}
__device__ __forceinline__ void convert_moe(const Args& a, int layer, LAS float* scr, int gw, int ngw, int lane, int which = 3) {
    bf16_t* B1 = (bf16_t*)(a.ws + WS_XB1); bf16_t* B2 = (bf16_t*)(a.ws + (layer == 1 ? WS_XB2L1 : WS_XB2));
    const float* wg = a.in[I_WG] + (size_t)layer * NEXP * D * DEXP; const float* wu = a.in[I_WU] + (size_t)layer * NEXP * D * DEXP; const float* wd = a.in[I_WD] + (size_t)layer * NEXP * DEXP * D;
    constexpr int IG = (D / 64) * (DEXP / 32);
    constexpr int ID = (DEXP / 64) * (D / 32);
    constexpr int PER_E = 2 * IG + ID;
    for (int it = gw; it < NEXP * PER_E; it += ngw) {
        const int e = it / PER_E; int r = it % PER_E;
        if (((r < 2 * IG) ? 1 : 2) & ~which) continue;
        if (r < IG) { transpose_item(wg + (size_t)e * D * DEXP, D, DEXP, DEXP, B1 + (size_t)e * 1024 * 1024, 1, scr, r, lane); continue; } r -= IG;
        if (r < IG) { transpose_item(wu + (size_t)e * D * DEXP, D, DEXP, DEXP, B1 + (size_t)e * 1024 * 1024, 2, scr, r, lane); continue; } r -= IG;
        transpose_item(wd + (size_t)e * DEXP * D, DEXP, D, D, B2 + (size_t)e * 1024 * 512, 0, scr, r, lane);
    }
}

__device__ __forceinline__ void moe_route(const Args& a, int layer, LAS unsigned char* lds, int bid, int G, int tid, int lane, int wave) {
    LAS float* wT = (LAS float*)lds;
    LAS float* lng = (LAS float*)(lds + 147456);
    LAS float* bias = (LAS float*)(lds + 151552);
    LAS int* lcnt = (LAS int*)(lds + 151552 + 256);
    LAS int* lbase = lcnt + 32;
    LAS int* tokE = lbase + 32;
    LAS int* tokR = tokE + 256;
    const float* wrg = a.in[I_WRG] + (size_t)layer * D * 4; const float* wre = a.in[I_WRE] + (size_t)layer * D * 32;
    for (int i = tid; i < 4 * 1024; i += NTHREADS) { const int k = i >> 2, o = i & 3; wT[o * 1024 + k] = wrg[i]; }
    for (int i = tid; i < 32 * 1024; i += NTHREADS) { const int k = i >> 5, o = i & 31; wT[(4 + o) * 1024 + k] = wre[i]; }
    for (int i = tid; i < 1024; i += NTHREADS) lng[i] = a.in[I_LNF][layer * D + i];
    if (tid < 4) bias[tid] = a.in[I_BRG][layer * 4 + tid];
    if (tid >= 64 && tid < 96) bias[4 + tid - 64] = a.in[I_BRE][layer * 32 + tid - 64];
    const float* x = a.out;
    bf16_t* xn = (bf16_t*)(a.ws + WS_XN);
    int* RE = (int*)(a.ws + WS_RE); float* RG = (float*)(a.ws + WS_RG); int* RS = (int*)(a.ws + WS_RS);
    int* gcnt = (int*)(a.ws + WS_CTL) + layer * 32; int* BC = (int*)(a.ws + WS_BC);
    const int tsub = lane >> 4, l16 = lane & 15;
    for (int tile = bid; tile < T / 128; tile += G) {
        __syncthreads();
        if (tid < 32) lcnt[tid] = 0;
        __syncthreads();
        for (int iter = 0; iter < 4; ++iter) {
            const int tl = wave * 16 + iter * 4 + tsub, t = tile * 128 + tl;
            const f32x4* xr = (const f32x4*)(x + (size_t)t * D) + l16;
            f32x4 v[16]; float ss = 0.f;
#pragma unroll
            for (int j = 0; j < 16; ++j) { v[j] = xr[16 * j]; ss += (v[j][0] * v[j][0] + v[j][1] * v[j][1]) + (v[j][2] * v[j][2] + v[j][3] * v[j][3]); }
            ss += __shfl_xor(ss, 1); ss += __shfl_xor(ss, 2); ss += __shfl_xor(ss, 4); ss += __shfl_xor(ss, 8);
            const float rstd = rsqrtf(ss * (1.f / D) + EPS);
            unsigned long long* o8 = (unsigned long long*)(xn + (size_t)t * D) + l16;
#pragma unroll
            for (int j = 0; j < 16; ++j) { v[j] = v[j] * rstd * *((const LAS f32x4*)lng + l16 + 16 * j);
                o8[16 * j] = (unsigned long long)cvt_pk_bf16(v[j][0], v[j][1]) | ((unsigned long long)cvt_pk_bf16(v[j][2], v[j][3]) << 32); }
            LAS float* lgs = (LAS float*)(lds + 154624) + (wave * 4 + tsub) * 40;
#pragma unroll 2
            for (int o = 0; o < 36; ++o) { float acc = 0.f;
#pragma unroll
                for (int j = 0; j < 16; ++j) { const f32x4 w = *((const LAS f32x4*)(wT + o * 1024) + l16 + 16 * j); acc += (v[j][0] * w[0] + v[j][1] * w[1]) + (v[j][2] * w[2] + v[j][3] * w[3]); }
                acc += __shfl_xor(acc, 1); acc += __shfl_xor(acc, 2); acc += __shfl_xor(acc, 4); acc += __shfl_xor(acc, 8);
                if (l16 == 0) lgs[o] = acc + bias[o]; }
            asm volatile("s_waitcnt lgkmcnt(0)" ::: "memory");
            int gi = 0; float gm = lgs[0];
            for (int o = 1; o < 4; ++o) { const float lv = lgs[o]; if (lv > gm) { gm = lv; gi = o; } }
            float gs = 0.f;
            for (int o = 0; o < 4; ++o) gs += __expf(lgs[o] - gm);
            const float grp_p = 1.f / gs;
            const LAS float* le = lgs + 4 + 8 * gi;
            int e1 = 0; float m1 = le[0];
            for (int k = 1; k < 8; ++k) { const float lv = le[k]; if (lv > m1) { m1 = lv; e1 = k; } }
            int e2 = -1; float m2 = -3.0e38f;
            for (int k = 0; k < 8; ++k) { const float lv = le[k]; if (k != e1 && lv > m2) { m2 = lv; e2 = k; } }
            const float p2 = __expf(m2 - m1);
            const float g1 = grp_p / (1.f + p2), g2 = grp_p * p2 / (1.f + p2);
            if (l16 == 0) {
                const int ea = gi * 8 + e1, eb = gi * 8 + e2;
                RE[(size_t)t * 2] = ea; RE[(size_t)t * 2 + 1] = eb; RG[(size_t)t * 2] = g1; RG[(size_t)t * 2 + 1] = g2;
                tokE[tl * 2] = ea; tokE[tl * 2 + 1] = eb;
                atomicAdd((int*)(lcnt + ea), 1); atomicAdd((int*)(lcnt + eb), 1);
            }
        }
        __syncthreads();
        if (tid < 32) { const int c = lcnt[tid]; BC[tile * 32 + tid] = c; atomicAdd(gcnt + tid, c); }
        if (tid < 256) { const int e = tokE[tid]; int rank = 0; for (int j = 0; j < tid; ++j) rank += (tokE[j] == e) ? 1 : 0; RS[(size_t)tile * 256 + tid] = rank; }
    }
}
__device__ __forceinline__ void moe_route2(const Args& a, int layer, LAS unsigned char* lds, int bid, int G, int tid, int lane, int wave) {
    LAS bf16_t* wh = (LAS bf16_t*)lds;
    LAS bf16_t* wl = (LAS bf16_t*)(lds + 74304);
    LAS float* lng = (LAS float*)(lds + 148608);
    LAS float* bias = (LAS float*)(lds + 152704);
    LAS int* lcnt = (LAS int*)(lds + 152704 + 256);
    LAS int* tokE = lcnt + 64;
    LAS float* lgs = (LAS float*)lds;
    const float* wrg = a.in[I_WRG] + (size_t)layer * D * 4; const float* wre = a.in[I_WRE] + (size_t)layer * D * 32;
    const float* x = a.out;
    bf16_t* xn = (bf16_t*)(a.ws + WS_XN);
    int* RE = (int*)(a.ws + WS_RE); float* RG = (float*)(a.ws + WS_RG); int* RS = (int*)(a.ws + WS_RS);
    int* gcnt = (int*)(a.ws + WS_CTL) + layer * 32; int* BC = (int*)(a.ws + WS_BC);
    const int fr = lane & 15, fq = lane >> 4;
    { int* rowtok = (int*)(a.ws + WS_ROWTOK); for (int i = bid * NTHREADS + tid; i < ROWS_PAD; i += G * NTHREADS) rowtok[i] = 0; }
    for (int tile = bid; tile < T / 128; tile += G) {
        __syncthreads();
        for (int i = tid; i < 32 * 1024; i += NTHREADS) { const int k = i >> 5, o = i & 31; const float w = wre[i]; const unsigned short h = f2bf(w); wh[o * 1032 + k] = h; wl[o * 1032 + k] = f2bf(w - bf2f(h)); }
        for (int i = tid; i < 4 * 1024; i += NTHREADS) { const int k = i >> 2, o = i & 3; const float w = wrg[i]; const unsigned short h = f2bf(w); wh[(32 + o) * 1032 + k] = h; wl[(32 + o) * 1032 + k] = f2bf(w - bf2f(h)); }
        for (int i = tid; i < 1024; i += NTHREADS) lng[i] = a.in[I_LNF][layer * D + i];
        if (tid < 32) bias[tid] = a.in[I_BRE][layer * 32 + tid];
        if (tid >= 64 && tid < 68) bias[32 + tid - 64] = a.in[I_BRG][layer * 4 + tid - 64];
        if (tid < 32) lcnt[tid] = 0;
        __syncthreads();
        const int t = tile * 128 + wave * 16 + fr;
        const f32x4* xr = (const f32x4*)(x + (size_t)t * D) + 2 * fq;
        float ss = 0.f;
#pragma unroll 8
        for (int s = 0; s < 32; ++s) { const f32x4 v0 = xr[8 * s], v1 = xr[8 * s + 1]; ss += (v0[0] * v0[0] + v0[1] * v0[1]) + (v0[2] * v0[2] + v0[3] * v0[3]) + (v1[0] * v1[0] + v1[1] * v1[1]) + (v1[2] * v1[2] + v1[3] * v1[3]); }
        ss += __shfl_xor(ss, 16); ss += __shfl_xor(ss, 32);
        const float rstd = rsqrtf(ss * (1.f / D) + EPS);
        f32x4 acc[3];
#pragma unroll
        for (int nt = 0; nt < 3; ++nt) acc[nt] = (f32x4){0.f, 0.f, 0.f, 0.f};
        const int brow2 = (32 + fr) < 36 ? (32 + fr) : 35;
#pragma unroll 2
        for (int s = 0; s < 32; ++s) {
            const f32x4 v0 = xr[8 * s], v1 = xr[8 * s + 1];
            const f32x4 g0 = *(const LAS f32x4*)(lng + 32 * s + 8 * fq), g1 = *(const LAS f32x4*)(lng + 32 * s + 8 * fq + 4);
            float v[8] = {v0[0] * rstd * g0[0], v0[1] * rstd * g0[1], v0[2] * rstd * g0[2], v0[3] * rstd * g0[3], v1[0] * rstd * g1[0], v1[1] * rstd * g1[1], v1[2] * rstd * g1[2], v1[3] * rstd * g1[3]};
            u32x4 hw; hw.x = cvt_pk_bf16(v[0], v[1]); hw.y = cvt_pk_bf16(v[2], v[3]); hw.z = cvt_pk_bf16(v[4], v[5]); hw.w = cvt_pk_bf16(v[6], v[7]);
            *(u32x4*)(xn + (size_t)t * D + 32 * s + 8 * fq) = hw;
            u32x4 lw; lw.x = cvt_pk_bf16(v[0] - lo_bf(hw.x), v[1] - hi_bf(hw.x)); lw.y = cvt_pk_bf16(v[2] - lo_bf(hw.y), v[3] - hi_bf(hw.y)); lw.z = cvt_pk_bf16(v[4] - lo_bf(hw.z), v[5] - hi_bf(hw.z)); lw.w = cvt_pk_bf16(v[6] - lo_bf(hw.w), v[7] - hi_bf(hw.w));
            const bf16x8 ah = __builtin_bit_cast(bf16x8, hw), al = __builtin_bit_cast(bf16x8, lw);
#pragma unroll
            for (int nt = 0; nt < 3; ++nt) {
                const int row = (nt < 2) ? (16 * nt + fr) : brow2;
                const bf16x8 bh = *(const LAS bf16x8*)(wh + row * 1032 + 32 * s + 8 * fq), bl = *(const LAS bf16x8*)(wl + row * 1032 + 32 * s + 8 * fq);
                acc[nt] = mfma16(ah, bh, acc[nt]); acc[nt] = mfma16(al, bh, acc[nt]); acc[nt] = mfma16(ah, bl, acc[nt]);
            }
        }
        __syncthreads();
        {
            LAS float* lw_ = lgs + wave * (16 * 40);
#pragma unroll
            for (int nt = 0; nt < 3; ++nt) { const int o = 16 * nt + fr; if (o < 36) { const float bo = bias[o];
#pragma unroll
                for (int rg = 0; rg < 4; ++rg) lw_[(4 * fq + rg) * 40 + o] = acc[nt][rg] + bo; } }
        }
        asm volatile("s_waitcnt lgkmcnt(0)" ::: "memory");
        if (lane < 16) {
            const LAS float* lg = lgs + wave * (16 * 40) + lane * 40;
            const int tl = wave * 16 + lane, tt = tile * 128 + tl;
            int gi = 0; float gm = lg[32];
            for (int o = 1; o < 4; ++o) { const float lv = lg[32 + o]; if (lv > gm) { gm = lv; gi = o; } }
            float gs = 0.f;
            for (int o = 0; o < 4; ++o) gs += __expf(lg[32 + o] - gm);
            const float grp_p = 1.f / gs;
            const LAS float* le = lg + 8 * gi;
            int e1 = 0; float m1 = le[0];
            for (int k = 1; k < 8; ++k) { const float lv = le[k]; if (lv > m1) { m1 = lv; e1 = k; } }
            int e2 = (e1 == 0) ? 1 : 0; float m2 = le[e2];
            for (int k = 0; k < 8; ++k) { const float lv = le[k]; if (k != e1 && lv > m2) { m2 = lv; e2 = k; } }
            const float p2 = __expf(m2 - m1);
            const float g1 = grp_p / (1.f + p2), g2 = grp_p * p2 / (1.f + p2);
            const int ea = gi * 8 + e1, eb = gi * 8 + e2;
            RE[(size_t)tt * 2] = ea; RE[(size_t)tt * 2 + 1] = eb; RG[(size_t)tt * 2] = g1; RG[(size_t)tt * 2 + 1] = g2;
            tokE[tl * 2] = ea; tokE[tl * 2 + 1] = eb;
            atomicAdd((int*)(lcnt + ea), 1); atomicAdd((int*)(lcnt + eb), 1);
        }
        __syncthreads();
        if (tid < 32) { const int c = lcnt[tid]; BC[tile * 32 + tid] = c; atomicAdd(gcnt + tid, c); }
        if (tid < 256) { const int e = tokE[tid]; int rank = 0; for (int j = 0; j < tid; ++j) rank += (tokE[j] == e) ? 1 : 0; RS[(size_t)tile * 256 + tid] = rank; }
    }
}
__device__ __forceinline__ void moe_tables(const Args& a, int layer, LAS int* tab, int tid) {
    __syncthreads();
    if (tid == 0) {
        const int* gcnt = (const int*)(a.ws + WS_CTL) + layer * 32; int t = 0;
        for (int e = 0; e < 32; ++e) { const int c = __hip_atomic_load(gcnt + e, __ATOMIC_RELAXED, __HIP_MEMORY_SCOPE_AGENT); const int nt = (c + 255) >> 8; tab[e] = t * 256; for (int i = 0; i < nt; ++i) tab[64 + t + i] = e; t += nt; }
        tab[32] = t;
    }
    __syncthreads();
}
__device__ __forceinline__ void moe_scatter(const Args& a, int layer, LAS unsigned char* lds, int bid, int G, int tid, int lane, int wave) {
    LAS int* tab = (LAS int*)(lds + 131072);
    LAS int* psum = (LAS int*)(lds + 131072 + 4096);
    moe_tables(a, layer, tab, tid);
    int* rowtok = (int*)(a.ws + WS_ROWTOK);
    const int* RE = (const int*)(a.ws + WS_RE); const int* RS = (const int*)(a.ws + WS_RS); int* RP = (int*)(a.ws + WS_RP); const int* BC = (const int*)(a.ws + WS_BC);
    for (int tile = bid; tile < T / 128; tile += G) {
        __syncthreads();
        { const int e = tid & 31, part = tid >> 5; int sacc = 0; for (int b2 = part * 16; b2 < part * 16 + 16; ++b2) if (b2 < tile) sacc += BC[b2 * 32 + e]; psum[part * 32 + e] = sacc; }
        __syncthreads();
        if (tid < 32) { int sacc = 0; for (int p2 = 0; p2 < 16; ++p2) sacc += psum[p2 * 32 + tid]; psum[512 + tid] = sacc + tab[tid]; }
        __syncthreads();
        if (tid < 128) {
            const int t = tile * 128 + tid;
            const int e0 = RE[(size_t)t * 2], e1 = RE[(size_t)t * 2 + 1];
            const int r0 = psum[512 + e0] + RS[(size_t)t * 2], r1 = psum[512 + e1] + RS[(size_t)t * 2 + 1];
            RP[(size_t)t * 2] = r0; RP[(size_t)t * 2 + 1] = r1; rowtok[r0] = t; rowtok[r1] = t;
        }
    }
}
__device__ __forceinline__ void moe_gemm1(const Args& a, int layer, LAS unsigned char* lds, int bid, int G, int tid) {
    LAS int* tab = (LAS int*)(lds + 131072);
    moe_tables(a, layer, tab, tid);
    pg8::Gemm g{(const bf16_t*)(a.ws + WS_XN), (const bf16_t*)(a.ws + WS_XB1), D, D, (const int*)(a.ws + WS_ROWTOK)};
    pg8::GroupedOrder S{tab + 64, tab[32], G, bid, 0, D, (size_t)1024 * 1024 * 2};
    pg8::EpiSwiGLU E{(bf16_t*)(a.ws + WS_HID)};
    pg8::gemm_phase<pg8::EpiSwiGLU, pg8::GroupedOrder, true>(lds, g, S, E);
}
__device__ __forceinline__ void moe_gemm2(const Args& a, int layer, LAS unsigned char* lds, int bid, int G, int tid) {
    LAS int* tab = (LAS int*)(lds + 131072);
    moe_tables(a, layer, tab, tid);
    pg8::Gemm g{(const bf16_t*)(a.ws + WS_HID), (const bf16_t*)(a.ws + (layer == 1 ? WS_XB2L1 : WS_XB2)), DEXP, DEXP, nullptr};
    pg8::GroupedOrder S{tab + 64, tab[32], G, bid, DEXP, DEXP, (size_t)1024 * 512 * 2};
    pg8::EpiBf16 E{(bf16_t*)(a.ws + WS_XROWS), D};
    pg8::gemm_phase(lds, g, S, E);
}
template <bool NORM>
__device__ __forceinline__ void moe_combine(const Args& a, const float* gain, bf16_t* hout, int gw, int ngw, int lane) {
    const bf16_t* y = (const bf16_t*)(a.ws + WS_XROWS);
    const int* RP = (const int*)(a.ws + WS_RP); const float* RG = (const float*)(a.ws + WS_RG);
    f32x4 gn[4];
    if (NORM) {
#pragma unroll
        for (int j = 0; j < 4; ++j) gn[j] = *((const f32x4*)gain + lane + 64 * j);
    }
    const int ntok = (T - gw + ngw - 1) / ngw;
    int lp0 = 0, lp1 = 0; float lg0 = 0.f, lg1 = 0.f;
    if (lane < ntok) { const size_t tt = (size_t)(gw + lane * ngw); lp0 = RP[tt * 2]; lp1 = RP[tt * 2 + 1]; lg0 = RG[tt * 2]; lg1 = RG[tt * 2 + 1]; }
    f32x4 xv[4], xn_[4]; u32x2 ya[4], yb[4], yan[4], ybn[4];
#define CMB_LOAD(k, XV, YA, YB) do { const int _p0 = __builtin_amdgcn_readlane(lp0, (k)), _p1 = __builtin_amdgcn_readlane(lp1, (k)); \
        const f32x4* _xr = (const f32x4*)(a.out + (size_t)(gw + (k) * ngw) * D) + lane; const u32x2* _y0 = (const u32x2*)(y + (size_t)_p0 * D) + lane; const u32x2* _y1 = (const u32x2*)(y + (size_t)_p1 * D) + lane; \
        _Pragma("unroll") for (int j = 0; j < 4; ++j) { XV[j] = _xr[64 * j]; YA[j] = _y0[64 * j]; YB[j] = _y1[64 * j]; } } while (0)
    if (ntok > 0) CMB_LOAD(0, xv, ya, yb);
    for (int k = 0; k < ntok; ++k) {
        const int t = gw + k * ngw;
        if (k + 1 < ntok) CMB_LOAD(k + 1, xn_, yan, ybn);
        const float g0 = __builtin_bit_cast(float, __builtin_amdgcn_readlane(__builtin_bit_cast(int, lg0), k)), g1 = __builtin_bit_cast(float, __builtin_amdgcn_readlane(__builtin_bit_cast(int, lg1), k));
        f32x4* xr = (f32x4*)(a.out + (size_t)t * D) + lane;
        f32x4 v[4]; float s = 0.f;
#pragma unroll
        for (int j = 0; j < 4; ++j) { v[j] = xv[j]; const u32x2 a0 = ya[j], a1 = yb[j];
            v[j][0] += g0 * lo_bf(a0.x) + g1 * lo_bf(a1.x); v[j][1] += g0 * hi_bf(a0.x) + g1 * hi_bf(a1.x); v[j][2] += g0 * lo_bf(a0.y) + g1 * lo_bf(a1.y); v[j][3] += g0 * hi_bf(a0.y) + g1 * hi_bf(a1.y);
            xr[64 * j] = v[j]; s += (v[j][0] * v[j][0] + v[j][1] * v[j][1]) + (v[j][2] * v[j][2] + v[j][3] * v[j][3]); }
        if (NORM) {
            const float rstd = rsqrtf(wave_sum(s) * (1.f / D) + EPS);
            unsigned long long* o8 = (unsigned long long*)(hout + (size_t)t * D) + lane;
#pragma unroll
            for (int j = 0; j < 4; ++j) { const f32x4 w = v[j] * rstd * gn[j]; o8[64 * j] = (unsigned long long)cvt_pk_bf16(w[0], w[1]) | ((unsigned long long)cvt_pk_bf16(w[2], w[3]) << 32); }
        }
#pragma unroll
        for (int j = 0; j < 4; ++j) { xv[j] = xn_[j]; ya[j] = yan[j]; yb[j] = ybn[j]; }
    }
#undef CMB_LOAD
}


__device__ __forceinline__ Args load_args() {
#if defined(__HIP_DEVICE_COMPILE__)
    const __attribute__((address_space(4))) Args* kap = (const __attribute__((address_space(4))) Args*)__builtin_amdgcn_kernarg_segment_ptr(); asm volatile("" : "+s"(kap));
    Args a;
#pragma unroll
    for (int i = 0; i < 22; ++i) a.in[i] = kap->in[i];
    a.out = kap->out; a.ws = kap->ws; a.ph_lo = kap->ph_lo; a.ph_hi = kap->ph_hi; return a;
#else
    return Args{};
#endif
}
constexpr int NPHASE = 20;
#define PHASE_IDS int tid_o = threadIdx.x; asm volatile("" : "+v"(tid_o)); const int tid = tid_o, lane = tid & 63, wave = __builtin_amdgcn_readfirstlane(tid >> 6); const int gw = bid * NWAVES + wave; (void)gw; (void)lane; \
    const Args args = load_args(); unsigned char* const ws = args.ws; (void)ws
#ifndef PHHI
#define PHHI NPHASE
#endif

__global__ void __launch_bounds__(NTHREADS, 2) fwd_kernel(Args args_) {
    extern __shared__ __attribute__((aligned(16))) unsigned char lds_raw[];
    LAS unsigned char* lds = (LAS unsigned char*)lds_raw;
    const int tid = threadIdx.x, lane = tid & 63, wave = __builtin_amdgcn_readfirstlane(tid >> 6);
    const int G = gridDim.x, bid = blockIdx.x;
    const int gw = bid * NWAVES + wave, ngw = G * NWAVES;
    unsigned char* ws = args_.ws;
    const int lo = args_.ph_lo, hi = args_.ph_hi;
    cg::grid_group grid = cg::this_grid();
    if (tid < 4) ((LAS unsigned*)(lds + LDS_BYTES - 16))[tid] = 0u;
    __syncthreads();
    const XcdBarrier xbar = xcd_barrier_post((unsigned*)(ws + WS_CTL) + 1024, (volatile LAS unsigned*)(lds + LDS_BYTES - 16));
    if (lo < 0) grid.sync();
#ifndef ONLYP
#define ONLYP -1
#endif
#define IN(k) ((ONLYP < 0 || ONLYP == (k)) && lo <= (k) && (k) < hi)
#ifndef SKIPLO
#define SKIPLO 100
#define SKIPHI 100
#endif
#define RUN(k) (IN(k) && !((k) >= SKIPLO && (k) <= SKIPHI))
#define SEAM(k) do { if (IN(k) && IN((k) + 1)) xcd_barrier(xbar); else __syncthreads(); } while (0)

    if (RUN(0)) { PHASE_IDS;
        LAS float* scr = (LAS float*)(lds + wave * 8448);
        {
            constexpr int I0 = (D / 64) * (N0 / 32);
            for (int it = gw; it < I0; it += ngw) transpose_item(args.in[I_WINE], D, EVEN_IN, N0, (bf16_t*)(ws + WS_WIN0), 0, scr, it, lane);
        }
        LAS float* wab = (LAS float*)(lds + 72 * 1024);
        __syncthreads();
        for (int i = tid; i < 8 * 1024; i += NTHREADS) { const int k = i >> 3, o = i & 7; wab[o * 1024 + k] = args.in[I_WINE][(size_t)k * EVEN_IN + N0 + o]; }
        __syncthreads();
        const float* x = args.in[I_X]; const float* gain = args.in[I_LNE];
        bf16_t* h0 = (bf16_t*)(ws + WS_HMIX0); float* bab = (float*)(ws + WS_BAB);
        f32x4 gn[4];
#pragma unroll
        for (int j = 0; j < 4; ++j) gn[j] = *((const f32x4*)gain + lane + 64 * j);
        for (int m = gw; m < T; m += ngw) {
            const f32x4* xr = (const f32x4*)(x + (size_t)m * D) + lane;
            f32x4 v[4]; float s = 0.f;
#pragma unroll
            for (int j = 0; j < 4; ++j) { v[j] = xr[64 * j]; s += (v[j][0] * v[j][0] + v[j][1] * v[j][1]) + (v[j][2] * v[j][2] + v[j][3] * v[j][3]); }
            const float rstd = rsqrtf(wave_sum(s) * (1.f / D) + EPS);
            float p[8];
#pragma unroll
            for (int o = 0; o < 8; ++o) p[o] = 0.f;
            unsigned long long* o8 = (unsigned long long*)(h0 + (size_t)m * D) + lane;
#pragma unroll
            for (int j = 0; j < 4; ++j) { v[j] = v[j] * rstd * gn[j];
                o8[64 * j] = (unsigned long long)cvt_pk_bf16(v[j][0], v[j][1]) | ((unsigned long long)cvt_pk_bf16(v[j][2], v[j][3]) << 32);
#pragma unroll
                for (int o = 0; o < 8; ++o) { const f32x4 w = *((const LAS f32x4*)(wab + o * 1024) + lane + 64 * j); p[o] += (v[j][0] * w[0] + v[j][1] * w[1]) + (v[j][2] * w[2] + v[j][3] * w[3]); } }
#pragma unroll
            for (int o = 0; o < 8; ++o) p[o] = wave_sum(p[o]);
            if (lane == 0) { *(f32x4*)(bab + (size_t)m * 8) = (f32x4){p[0], p[1], p[2], p[3]}; *(f32x4*)(bab + (size_t)m * 8 + 4) = (f32x4){p[4], p[5], p[6], p[7]}; }
        }
    }
    SEAM(0);

    if (RUN(1)) { PHASE_IDS;
        pg8::Gemm g{(const bf16_t*)(ws + WS_HMIX0), (const bf16_t*)(ws + WS_WIN0), D, D, nullptr};
        pg8::DenseOrder S; S.init(T, N0, G, bid, D, D);
        pg8::EpiBf16 E{(bf16_t*)(ws + WS_PROJ0), N0};
        pg8::gemm_phase(lds, g, S, E);
        {
            const int nfull = ((T / 256) * (N0 / 256)) % G;
            if (bid >= nfull) {
                asm volatile("s_waitcnt vmcnt(0) lgkmcnt(0)" ::: "memory"); __syncthreads();
                convert_moe(args, 1, (LAS float*)(lds + wave * 8448), (bid - nfull) * NWAVES + wave, (G - nfull) * NWAVES, lane, 2);
            }
        }
    }
    SEAM(1);

    if (RUN(2)) { PHASE_IDS;
        const bf16_t* proj0 = (const bf16_t*)(ws + WS_PROJ0);
        const float* bab = (const float*)(ws + WS_BAB);
        bf16_t* gUT = (bf16_t*)(ws + WS_GU); bf16_t* gW = (bf16_t*)(ws + WS_GW); bf16_t* gQD = (bf16_t*)(ws + WS_GQD); bf16_t* gKDT = (bf16_t*)(ws + WS_GKDT); bf16_t* gA = (bf16_t*)(ws + WS_GA);
        float* gGL = (float*)(ws + WS_GL);
        LAS bf16_t* Kb = (LAS bf16_t*)(lds);
        LAS bf16_t* Qb = (LAS bf16_t*)(lds + 17408);
        LAS bf16_t* Rb = (LAS bf16_t*)(lds + 34816);
        LAS float* Lm = (LAS float*)(lds + 68608);
        LAS bf16_t* raw = (LAS bf16_t*)(lds + 84992);
        LAS float* cw = (LAS float*)(lds + 137520);
        LAS float* gcs = (LAS float*)(lds + 162096);
        LAS float* bts = gcs + 64;
        const int fr = lane & 15, fq = lane >> 4;
        for (int i = tid; i < 4 * 1536; i += NTHREADS) cw[i] = args.in[I_CONVW][i];
        const float alog_e[4] = {-__expf(args.in[I_ALOG][0]), -__expf(args.in[I_ALOG][1]), -__expf(args.in[I_ALOG][2]), -__expf(args.in[I_ALOG][3])};
        const float dtb[4] = {args.in[I_DTB][0], args.in[I_DTB][1], args.in[I_DTB][2], args.in[I_DTB][3]};
        u32x4 praw[7]; float pa_ = 0.f, pb_ = 0.f;
#define P2_PREFETCH(itm) do { const int _b = (itm) >> 8, _n = ((itm) >> 2) & 63, _h = (itm) & 3; \
            _Pragma("unroll") for (int i7 = 0; i7 < 7; ++i7) { const int idx = tid + NTHREADS * i7; const int row = idx / 48, rem = idx - row * 48, part = rem >> 4, ch = rem & 15; const int srow = _n * 64 - 3 + row; \
                praw[i7] = (u32x4){0u, 0u, 0u, 0u}; \
                if (idx < 67 * 48 && srow >= 0) praw[i7] = *(const u32x4*)(proj0 + (size_t)(_b * SEQ + srow) * N0 + 768 + part * 512 + _h * 128 + ch * 8); } \
            if (wave == 0) { const int t = _b * SEQ + _n * 64 + lane; pa_ = bab[(size_t)t * 8 + _h]; pb_ = bab[(size_t)t * 8 + 4 + _h]; } } while (0)
        const int npb = G - 32;
        int* ready = (int*)(ws + WS_CTL + 32768);
#define P2_ITEM(q) ((((((q) & 31) >> 2) * 64 + ((q) >> 5)) * 4) + ((q) & 3))
        if (bid >= 32) P2_PREFETCH(P2_ITEM(bid - 32));
        __syncthreads();
        int pend = -1, pend2 = -1, held = -1;
        for (int q = bid - 32; bid >= 32 && q < 2048; q += npb) {
            const int item = P2_ITEM(q);
            const int h = item & 3;
#pragma unroll
            for (int i7 = 0; i7 < 7; ++i7) { const int idx = tid + NTHREADS * i7; const int row = idx / 48, rem = idx - row * 48; if (idx < 67 * 48) *(LAS u32x4*)(raw + row * 392 + rem * 8) = praw[i7]; }
            if (wave == 0) {
                const float a = pa_ + (h == 0 ? dtb[0] : h == 1 ? dtb[1] : h == 2 ? dtb[2] : dtb[3]);
                const float sp = fmaxf(a, 0.f) + log1pf(__expf(-fabsf(a)));
                float gv = (h == 0 ? alog_e[0] : h == 1 ? alog_e[1] : h == 2 ? alog_e[2] : alog_e[3]) * sp;
#pragma unroll
                for (int o = 1; o < 64; o <<= 1) { const float y = __shfl_up(gv, o); if (lane >= o) gv += y; }
                gcs[lane] = gv; bts[lane] = sigmoid_f(pb_);
            }
            __syncthreads();
            if (q + npb < 2048) P2_PREFETCH(P2_ITEM(q + npb));
            {
                const int r = tid >> 3, d0 = (tid & 7) * 16;
                const float gc = gcs[r], beta = bts[r], glast = gcs[63];
                const float eg = __expf(gc), ekd = __expf(glast - gc);
#define P2_CONV(P, OUT) do { float acc[16]; _Pragma("unroll") for (int d = 0; d < 16; ++d) acc[d] = 0.f; \
                    _Pragma("unroll") for (int j = 0; j < 4; ++j) { \
                        const LAS u32x4* px = (const LAS u32x4*)(raw + (r + j) * 392 + (P) * 128 + d0); const u32x4 x0 = px[0], x1 = px[1]; \
                        const LAS f32x4* pw = (const LAS f32x4*)(cw + j * 1536 + (P) * 512 + h * 128 + d0); const f32x4 w0 = pw[0], w1 = pw[1], w2 = pw[2], w3 = pw[3]; \
                        acc[0] += w0[0] * lo_bf(x0.x); acc[1] += w0[1] * hi_bf(x0.x); acc[2] += w0[2] * lo_bf(x0.y); acc[3] += w0[3] * hi_bf(x0.y); \
                        acc[4] += w1[0] * lo_bf(x0.z); acc[5] += w1[1] * hi_bf(x0.z); acc[6] += w1[2] * lo_bf(x0.w); acc[7] += w1[3] * hi_bf(x0.w); \
                        acc[8] += w2[0] * lo_bf(x1.x); acc[9] += w2[1] * hi_bf(x1.x); acc[10] += w2[2] * lo_bf(x1.y); acc[11] += w2[3] * hi_bf(x1.y); \
                        acc[12] += w3[0] * lo_bf(x1.z); acc[13] += w3[1] * hi_bf(x1.z); acc[14] += w3[2] * lo_bf(x1.w); acc[15] += w3[3] * hi_bf(x1.w); } \
                    _Pragma("unroll") for (int d = 0; d < 16; ++d) OUT[d] = silu_f(acc[d]); } while (0)
#define P2_PACK(W0, W1, X, SC) do { W0.x = cvt_pk_bf16(X[0] * (SC), X[1] * (SC)); W0.y = cvt_pk_bf16(X[2] * (SC), X[3] * (SC)); W0.z = cvt_pk_bf16(X[4] * (SC), X[5] * (SC)); W0.w = cvt_pk_bf16(X[6] * (SC), X[7] * (SC)); \
                    W1.x = cvt_pk_bf16(X[8] * (SC), X[9] * (SC)); W1.y = cvt_pk_bf16(X[10] * (SC), X[11] * (SC)); W1.z = cvt_pk_bf16(X[12] * (SC), X[13] * (SC)); W1.w = cvt_pk_bf16(X[14] * (SC), X[15] * (SC)); } while (0)
                u32x4 w0_, w1_;
                {
                    float kk[16]; P2_CONV(1, kk);
                    float sk = 0.f;
#pragma unroll
                    for (int d = 0; d < 16; ++d) sk += kk[d] * kk[d];
                    sk += __shfl_xor(sk, 1); sk += __shfl_xor(sk, 2); sk += __shfl_xor(sk, 4);
                    const float kinv = rsqrtf(sk + EPS);
                    P2_PACK(w0_, w1_, kk, kinv); *(LAS u32x4*)(Kb + r * 136 + d0) = w0_; *(LAS u32x4*)(Kb + r * 136 + d0 + 8) = w1_;
                    P2_PACK(w0_, w1_, kk, kinv * beta * eg); *(LAS u32x4*)(Rb + r * 264 + 128 + d0) = w0_; *(LAS u32x4*)(Rb + r * 264 + 128 + d0 + 8) = w1_;
                    const float ks = kinv * ekd;
#pragma unroll
                    for (int d = 0; d < 16; ++d) gKDT[((size_t)item * 128 + d0 + d) * 64 + ((r & 32) | pg8::perm32(r & 31))] = f2bf(kk[d] * ks);
                }
                __builtin_amdgcn_sched_barrier(0);
                {
                    float qq[16]; P2_CONV(0, qq);
                    float sq = 0.f;
#pragma unroll
                    for (int d = 0; d < 16; ++d) sq += qq[d] * qq[d];
                    sq += __shfl_xor(sq, 1); sq += __shfl_xor(sq, 2); sq += __shfl_xor(sq, 4);
                    const float qinv = rsqrtf(sq + EPS) * 0.08838834764831845f;
                    P2_PACK(w0_, w1_, qq, qinv); *(LAS u32x4*)(Qb + r * 136 + d0) = w0_; *(LAS u32x4*)(Qb + r * 136 + d0 + 8) = w1_;
                    P2_PACK(w0_, w1_, qq, qinv * eg); { bf16_t* pqd = gQD + ((size_t)item * 64 + r) * 128 + (d0 & ~31) + 4 * ((d0 >> 4) & 1); *(u32x2*)(pqd) = (u32x2){w0_.x, w0_.y}; *(u32x2*)(pqd + 8) = (u32x2){w0_.z, w0_.w}; *(u32x2*)(pqd + 16) = (u32x2){w1_.x, w1_.y}; *(u32x2*)(pqd + 24) = (u32x2){w1_.z, w1_.w}; }
                }
                __builtin_amdgcn_sched_barrier(0);
                {
                    float vv[16]; P2_CONV(2, vv);
                    P2_PACK(w0_, w1_, vv, beta); *(LAS u32x4*)(Rb + r * 264 + d0) = w0_; *(LAS u32x4*)(Rb + r * 264 + d0 + 8) = w1_;
                }
#undef P2_CONV
#undef P2_PACK
                if (tid == 0) gGL[(size_t)item * 32] = __expf(glast);
            }
            __syncthreads();
            u32x4 gz0, gz1;
            bf16_t* const pgz = (bf16_t*)(ws + WS_PROJ0) + (size_t)((item >> 8) * SEQ + ((item >> 2) & 63) * 64 + (tid >> 3)) * N0 + 2304 + h * 128 + (tid & 7) * 16;
            { const u32x4* pz = (const u32x4*)pgz; gz0 = pz[0]; gz1 = pz[1]; }
            {
                const int which = wave >> 2, mt = wave & 3;
                const LAS bf16_t* X = which ? Qb : Kb;
                for (int nt = 0; nt < 4; ++nt) {
                    f32x4 acc = (f32x4){0.f, 0.f, 0.f, 0.f};
                    if (nt <= mt) {
#pragma unroll
                        for (int s4 = 0; s4 < 4; ++s4) {
                            const bf16x8 af = *(const LAS bf16x8*)(X + (16 * mt + fr) * 136 + 32 * s4 + 8 * fq);
                            const bf16x8 bfr = *(const LAS bf16x8*)(Kb + (16 * nt + fr) * 136 + 32 * s4 + 8 * fq);
                            acc = mfma16(af, bfr, acc);
                        }
                    }
                    const int j = 16 * nt + fr; const float gj = gcs[j];
#pragma unroll
                    for (int rg = 0; rg < 4; ++rg) {
                        const int i = 16 * mt + 4 * fq + rg;
                        const float dec = __expf(fminf(gcs[i] - gj, 0.f));
                        if (which == 0) Lm[i * 64 + j] = (i > j) ? -(bts[i] * acc[rg] * dec) : 0.f;
                        else gA[((size_t)item * 64 + i) * 64 + ((j & 32) | pg8::perm32(j & 31))] = f2bf((i >= j) ? acc[rg] * dec : 0.f);
                    }
                }
            }
            {
                const float* gng = args.in[I_GDNG] + (tid & 7) * 16;
                unsigned zw[8] = {gz0.x, gz0.y, gz0.z, gz0.w, gz1.x, gz1.y, gz1.z, gz1.w};
#pragma unroll
                for (int d = 0; d < 8; ++d) zw[d] = cvt_pk_bf16(gng[2 * d] * silu_f(lo_bf(zw[d])), gng[2 * d + 1] * silu_f(hi_bf(zw[d])));
                u32x4* po = (u32x4*)pgz; po[0] = (u32x4){zw[0], zw[1], zw[2], zw[3]}; po[1] = (u32x4){zw[4], zw[5], zw[6], zw[7]};
            }
            __syncthreads();
            if (tid < 256) {
                const int c = tid, l16 = lane & 15;
                float U[64];
                int ln[4] = {0, 0, 0, 0};
                ln[0] = __builtin_bit_cast(int, Lm[64 + l16]);
                U[0] = bf2f((unsigned)Rb[c]);
                solve_rows(U, ln, Lm, (const LAS unsigned short*)Rb, l16, c, std::make_integer_sequence<int, 63>{});
                if (c < 128) {
                    u32x4* pu = (u32x4*)(gUT + ((size_t)item * 128 + c) * 64);
#pragma unroll
                    for (int i8 = 0; i8 < 8; ++i8) { u32x4 o; o.x = cvt_pk_bf16(U[8 * i8], U[8 * i8 + 1]); o.y = cvt_pk_bf16(U[8 * i8 + 2], U[8 * i8 + 3]); o.z = cvt_pk_bf16(U[8 * i8 + 4], U[8 * i8 + 5]); o.w = cvt_pk_bf16(U[8 * i8 + 6], U[8 * i8 + 7]); pu[i8] = o; }
                } else {
#pragma unroll
                    for (int i = 0; i < 64; ++i) gW[((size_t)item * 64 + i) * 128 + (((c - 128) & ~31) | pg8::perm32((c - 128) & 31))] = f2bf(U[i]);
                }
            }
            else if (tid == 448 && pend >= 0) {
                asm volatile("s_waitcnt vmcnt(0)" ::: "memory");
                __hip_atomic_store(ready + pend, 1, __ATOMIC_RELAXED, __HIP_MEMORY_SCOPE_AGENT);
                if (pend2 >= 0) __hip_atomic_store(ready + pend2, 1, __ATOMIC_RELAXED, __HIP_MEMORY_SCOPE_AGENT);
            }
            pend = -1; pend2 = -1;
            asm volatile("s_waitcnt vmcnt(0)" ::: "memory");
            __syncthreads();
            if (held >= 0 || q + npb >= 2048) { if (tid == 448) asm volatile("buffer_wbl2 sc1" ::: "memory"); pend = item; pend2 = held; held = -1; }
            else held = item;
        }
        if (tid == 448 && pend >= 0) { asm volatile("s_waitcnt vmcnt(0)" ::: "memory"); __hip_atomic_store(ready + pend, 1, __ATOMIC_RELAXED, __HIP_MEMORY_SCOPE_AGENT); if (pend2 >= 0) __hip_atomic_store(ready + pend2, 1, __ATOMIC_RELAXED, __HIP_MEMORY_SCOPE_AGENT); }
#undef P2_PREFETCH
#undef P2_ITEM
    }
    __syncthreads();

    if (RUN(3)) { PHASE_IDS;
        const bf16_t* proj0 = (const bf16_t*)(ws + WS_PROJ0);
        bf16_t* mix0 = (bf16_t*)(ws + WS_HMIX0);
        const int fr = lane & 15, fq = lane >> 4;
        if (bid < 32) {
            const bf16_t* gUT = (const bf16_t*)(ws + WS_GU); const bf16_t* gW = (const bf16_t*)(ws + WS_GW); const bf16_t* gQD = (const bf16_t*)(ws + WS_GQD); const bf16_t* gKDT = (const bf16_t*)(ws + WS_GKDT); const bf16_t* gA = (const bf16_t*)(ws + WS_GA);
            const float* gGL = (const float*)(ws + WS_GL);
            const int b = bid >> 2, h = bid & 3;
            constexpr int BUFB = 62464;
            LAS bf16_t* Obuf0 = (LAS bf16_t*)(lds + 2 * BUFB);
            const int wrow0 = tid >> 4, wch = tid & 15;
            const int krow0 = tid >> 3, kch = tid & 7;
            u32x4 pw[2], pq[2], pk[2], pa;
            u32x2 pu[4], pun[4]; u32x4 pz0, pz1; float glv, glvn = 0.f;
            f32x4 Sacc[8];
#pragma unroll
            for (int k = 0; k < 8; ++k) Sacc[k] = (f32x4){0.f, 0.f, 0.f, 0.f};
            LAS float* gnl = (LAS float*)(lds + 2 * BUFB + 2 * 17408);
            if (tid < 128) gnl[tid] = args.in[I_GDNG][tid];
#define GDN_LOAD(itm) do { const size_t _it = (size_t)(itm); \
                pw[0] = *(const u32x4*)(gW + (_it * 64 + wrow0) * 128 + wch * 8); pw[1] = *(const u32x4*)(gW + (_it * 64 + wrow0 + 32) * 128 + wch * 8); \
                pq[0] = *(const u32x4*)(gQD + (_it * 64 + wrow0) * 128 + wch * 8); pq[1] = *(const u32x4*)(gQD + (_it * 64 + wrow0 + 32) * 128 + wch * 8); \
                pk[0] = *(const u32x4*)(gKDT + (_it * 128 + krow0) * 64 + kch * 8); pk[1] = *(const u32x4*)(gKDT + (_it * 128 + krow0 + 64) * 64 + kch * 8); \
                pa = *(const u32x4*)(gA + (_it * 64 + krow0) * 64 + kch * 8); } while (0)
#define GDN_LOAD2(itm, U, GLV) do { const size_t _it = (size_t)(itm); \
                _Pragma("unroll") for (int mt = 0; mt < 4; ++mt) U[mt] = *(const u32x2*)(gUT + (_it * 128 + 16 * wave + fr) * 64 + 16 * mt + 4 * fq); \
                GLV = gGL[_it * 32]; } while (0)
#define GDN_STORE(bufi) do { LAS bf16_t* _W = (LAS bf16_t*)(lds + (bufi) * BUFB); LAS bf16_t* _Q = _W + 64 * 136; LAS bf16_t* _K = _Q + 64 * 136; LAS bf16_t* _A = _K + 128 * 72; \
                *(LAS u32x4*)(_W + wrow0 * 136 + wch * 8) = pw[0]; *(LAS u32x4*)(_W + (wrow0 + 32) * 136 + wch * 8) = pw[1]; \
                *(LAS u32x4*)(_Q + wrow0 * 136 + wch * 8) = pq[0]; *(LAS u32x4*)(_Q + (wrow0 + 32) * 136 + wch * 8) = pq[1]; \
                *(LAS u32x4*)(_K + krow0 * 72 + kch * 8) = pk[0]; *(LAS u32x4*)(_K + (krow0 + 64) * 72 + kch * 8) = pk[1]; \
                *(LAS u32x4*)(_A + krow0 * 72 + kch * 8) = pa; } while (0)
            const int* ready = (const int*)(ws + WS_CTL + 32768);
#define GDN_WAIT(c0, cnt) do { if (wave == 0) { if (lane < (cnt)) { const int* f = ready + (((b * 64 + (c0) + lane) * 4) + h); while (__hip_atomic_load(f, __ATOMIC_RELAXED, __HIP_MEMORY_SCOPE_AGENT) == 0) __builtin_amdgcn_s_sleep(4); } \
                __builtin_amdgcn_fence(__ATOMIC_ACQUIRE, "agent"); asm volatile("s_waitcnt vmcnt(0)" ::: "memory"); } __syncthreads(); } while (0)
            GDN_WAIT(0, 5);
            GDN_LOAD((b * 64 + 0) * 4 + h); GDN_STORE(0);
            GDN_LOAD2((b * 64 + 0) * 4 + h, pu, glv);
            __syncthreads();
            for (int n = 0; n < 64; ++n) {
                if (n > 0 && (n & 3) == 0 && n + 1 < 64) GDN_WAIT(n + 1, (n + 5 <= 64) ? 4 : (63 - n));
                const int item = (b * 64 + n) * 4 + h, cur = n & 1;
                const int t0 = b * SEQ + n * 64;
                const LAS bf16_t* Wl = (const LAS bf16_t*)(lds + cur * BUFB); const LAS bf16_t* Ql = Wl + 64 * 136; const LAS bf16_t* Kl = Ql + 64 * 136; const LAS bf16_t* Al = Kl + 128 * 72;
                LAS bf16_t* Obuf = Obuf0 + cur * (64 * 136);
                if (n + 1 < 64) { GDN_LOAD(item + 4); GDN_LOAD2(item + 4, pun, glvn); }
                { const u32x4* pz = (const u32x4*)(proj0 + (size_t)(t0 + (tid >> 3)) * N0 + 2304 + h * 128 + (tid & 7) * 8); pz0 = pz[0]; pz1 = pz[8]; }
                bf16x8 Sb[4];
#pragma unroll
                for (int s = 0; s < 4; ++s) Sb[s] = mk8f(Sacc[2 * s], Sacc[2 * s + 1]);
                f32x4 WS[4], QS[4];
#pragma unroll
                for (int mt = 0; mt < 4; ++mt) { WS[mt] = (f32x4){0.f, 0.f, 0.f, 0.f}; QS[mt] = (f32x4){0.f, 0.f, 0.f, 0.f}; }
                {
                    bf16x8 wfr[2][4], qfr[2][4];
#define GDN_FRAGS(bufi, mt_) do { _Pragma("unroll") for (int s = 0; s < 4; ++s) { wfr[bufi][s] = *(const LAS bf16x8*)(Wl + (16 * (mt_) + fr) * 136 + 32 * s + 8 * fq); \
                        qfr[bufi][s] = *(const LAS bf16x8*)(Ql + (16 * (mt_) + fr) * 136 + 32 * s + 8 * fq); } } while (0)
                    GDN_FRAGS(0, 0);
#pragma unroll
                    for (int mt = 0; mt < 4; ++mt) {
                        if (mt + 1 < 4) GDN_FRAGS((mt + 1) & 1, mt + 1);
                        __builtin_amdgcn_sched_barrier(0);
#pragma unroll
                        for (int s = 0; s < 4; ++s) { WS[mt] = mfma16(wfr[mt & 1][s], Sb[s], WS[mt]); QS[mt] = mfma16(qfr[mt & 1][s], Sb[s], QS[mt]); }
                        __builtin_amdgcn_sched_barrier(0);
                    }
#undef GDN_FRAGS
                }
                bf16x8 afr[8], kfa[8], kfb[8];
#define GDN_KFR(dst, kt0) do { _Pragma("unroll") for (int k4 = 0; k4 < 4; ++k4) _Pragma("unroll") for (int s2 = 0; s2 < 2; ++s2) dst[k4 * 2 + s2] = *(const LAS bf16x8*)(Kl + (16 * ((kt0) + k4) + fr) * 72 + 32 * s2 + 8 * fq); } while (0)
#pragma unroll
                for (int mt = 0; mt < 4; ++mt)
#pragma unroll
                    for (int s2 = 0; s2 < 2; ++s2) afr[mt * 2 + s2] = *(const LAS bf16x8*)(Al + (16 * mt + fr) * 72 + 32 * s2 + 8 * fq);
                GDN_KFR(kfa, 0);
                __builtin_amdgcn_sched_barrier(0);
                f32x4 vn[4];
#pragma unroll
                for (int mt = 0; mt < 4; ++mt) { vn[mt][0] = lo_bf(pu[mt].x) - WS[mt][0]; vn[mt][1] = hi_bf(pu[mt].x) - WS[mt][1]; vn[mt][2] = lo_bf(pu[mt].y) - WS[mt][2]; vn[mt][3] = hi_bf(pu[mt].y) - WS[mt][3]; }
                bf16x8 Vb[2];
                Vb[0] = mk8f(vn[0], vn[1]); Vb[1] = mk8f(vn[2], vn[3]);
#pragma unroll
                for (int kt = 0; kt < 8; ++kt) Sacc[kt] = Sacc[kt] * glv;
                __builtin_amdgcn_sched_barrier(0);
#pragma unroll
                for (int k4 = 0; k4 < 4; ++k4)
#pragma unroll
                    for (int s2 = 0; s2 < 2; ++s2) Sacc[k4] = mfma16(kfa[k4 * 2 + s2], Vb[s2], Sacc[k4]);
                GDN_KFR(kfb, 4);
                __builtin_amdgcn_sched_barrier(0);
#pragma unroll
                for (int mt = 0; mt < 4; ++mt)
#pragma unroll
                    for (int s2 = 0; s2 < 2; ++s2) QS[mt] = mfma16(afr[mt * 2 + s2], Vb[s2], QS[mt]);
                __builtin_amdgcn_sched_barrier(0);
#pragma unroll
                for (int k4 = 0; k4 < 4; ++k4)
#pragma unroll
                    for (int s2 = 0; s2 < 2; ++s2) Sacc[4 + k4] = mfma16(kfb[k4 * 2 + s2], Vb[s2], Sacc[4 + k4]);
#undef GDN_KFR
#pragma unroll
                for (int mt = 0; mt < 4; ++mt)
#pragma unroll
                    for (int rg = 0; rg < 4; ++rg) Obuf[(16 * mt + 4 * fq + rg) * 136 + 16 * wave + fr] = f2bf(QS[mt][rg]);
                if (n + 1 < 64) GDN_STORE(cur ^ 1);
                __syncthreads();
                {
                    const int r = tid >> 3, c0 = (tid & 7) * 8;
                    const u32x4 o0 = *(const LAS u32x4*)(Obuf + r * 136 + c0), o1 = *(const LAS u32x4*)(Obuf + r * 136 + 64 + c0);
                    float ov[16], zv[16];
                    ov[0] = lo_bf(o0.x); ov[1] = hi_bf(o0.x); ov[2] = lo_bf(o0.y); ov[3] = hi_bf(o0.y); ov[4] = lo_bf(o0.z); ov[5] = hi_bf(o0.z); ov[6] = lo_bf(o0.w); ov[7] = hi_bf(o0.w);
                    ov[8] = lo_bf(o1.x); ov[9] = hi_bf(o1.x); ov[10] = lo_bf(o1.y); ov[11] = hi_bf(o1.y); ov[12] = lo_bf(o1.z); ov[13] = hi_bf(o1.z); ov[14] = lo_bf(o1.w); ov[15] = hi_bf(o1.w);
                    float ss = 0.f;
#pragma unroll
                    for (int d = 0; d < 16; ++d) ss += ov[d] * ov[d];
                    ss += __shfl_xor(ss, 1); ss += __shfl_xor(ss, 2); ss += __shfl_xor(ss, 4);
                    const float rstd = rsqrtf(ss * (1.f / 128.f) + EPS);
                    zv[0] = lo_bf(pz0.x); zv[1] = hi_bf(pz0.x); zv[2] = lo_bf(pz0.y); zv[3] = hi_bf(pz0.y); zv[4] = lo_bf(pz0.z); zv[5] = hi_bf(pz0.z); zv[6] = lo_bf(pz0.w); zv[7] = hi_bf(pz0.w);
                    zv[8] = lo_bf(pz1.x); zv[9] = hi_bf(pz1.x); zv[10] = lo_bf(pz1.y); zv[11] = hi_bf(pz1.y); zv[12] = lo_bf(pz1.z); zv[13] = hi_bf(pz1.z); zv[14] = lo_bf(pz1.w); zv[15] = hi_bf(pz1.w);
#pragma unroll
                    for (int d = 0; d < 16; ++d) ov[d] = ov[d] * rstd * zv[d];
                    u32x4 w0, w1;
                    w0.x = cvt_pk_bf16(ov[0], ov[1]); w0.y = cvt_pk_bf16(ov[2], ov[3]); w0.z = cvt_pk_bf16(ov[4], ov[5]); w0.w = cvt_pk_bf16(ov[6], ov[7]);
                    w1.x = cvt_pk_bf16(ov[8], ov[9]); w1.y = cvt_pk_bf16(ov[10], ov[11]); w1.z = cvt_pk_bf16(ov[12], ov[13]); w1.w = cvt_pk_bf16(ov[14], ov[15]);
                    u32x4* po = (u32x4*)(mix0 + (size_t)(t0 + r) * D + 512 + h * 128 + c0); po[0] = w0; po[8] = w1;
                }
#pragma unroll
                for (int mt = 0; mt < 4; ++mt) pu[mt] = pun[mt];
                glv = glvn;
            }
#undef GDN_LOAD2
#undef GDN_WAIT
#undef GDN_LOAD
#undef GDN_STORE
        } else {
            LAS bf16_t* Ks = (LAS bf16_t*)(lds);
            LAS bf16_t* Vt = (LAS bf16_t*)(lds + 27648);
            const float* qgain = args.in[I_QG]; const float* kgain = args.in[I_KG];
            const int nbk = G - 32;
            for (int it = bid - 32; it < 1024; it += nbk) {
                const int b = it >> 7, qb = (it >> 1) & 63, hk = it & 1;
                const int t0 = b * SEQ + qb * 64;
                __syncthreads();
#pragma unroll
                for (int i3 = 0; i3 < 3; ++i3) {
                    const int task = tid + NTHREADS * i3, key = task >> 3, dg = task & 7;
                    const int kp = qb * 64 - 128 + key;
                    u32x4 kr = (u32x4){0u, 0u, 0u, 0u}, vr = (u32x4){0u, 0u, 0u, 0u};
                    if (kp >= 0) { const bf16_t* pr = proj0 + (size_t)(b * SEQ + kp) * N0 + hk * 64 + 8 * dg; kr = *(const u32x4*)(pr + 512); vr = *(const u32x4*)(pr + 640); }
                    float kv[8];
                    kv[0] = lo_bf(kr.x); kv[1] = hi_bf(kr.x); kv[2] = lo_bf(kr.y); kv[3] = hi_bf(kr.y); kv[4] = lo_bf(kr.z); kv[5] = hi_bf(kr.z); kv[6] = lo_bf(kr.w); kv[7] = hi_bf(kr.w);
                    float ss = 0.f;
#pragma unroll
                    for (int i = 0; i < 8; ++i) ss += kv[i] * kv[i];
                    ss += __shfl_xor(ss, 1); ss += __shfl_xor(ss, 2); ss += __shfl_xor(ss, 4);
                    const float rstd = rsqrtf(ss * (1.f / 64.f) + EPS);
                    const f32x4 g0 = *(const f32x4*)(kgain + 8 * dg), g1 = *(const f32x4*)(kgain + 8 * dg + 4);
                    kv[0] *= rstd * g0[0]; kv[1] *= rstd * g0[1]; kv[2] *= rstd * g0[2]; kv[3] *= rstd * g0[3]; kv[4] *= rstd * g1[0]; kv[5] *= rstd * g1[1]; kv[6] *= rstd * g1[2]; kv[7] *= rstd * g1[3];
                    float pv[8];
#pragma unroll
                    for (int i = 0; i < 8; ++i) pv[i] = __shfl_xor(kv[i], 1);
                    if (dg < 2) {
#pragma unroll
                        for (int i = 0; i < 8; ++i) { float sn, cs; sincos_rev((float)kp * exp2f(-2.36644607f * (float)i), sn, cs);
                            kv[i] = (dg == 0) ? (kv[i] * cs - pv[i] * sn) : (kv[i] * cs + pv[i] * sn); }
                    }
                    u32x4 kw; kw.x = cvt_pk_bf16(kv[0], kv[1]); kw.y = cvt_pk_bf16(kv[2], kv[3]); kw.z = cvt_pk_bf16(kv[4], kv[5]); kw.w = cvt_pk_bf16(kv[6], kv[7]);
                    *(LAS u32x4*)(Ks + key * 72 + 8 * dg) = kw;
                    const int kpm = (key & ~31) | pg8::perm32(key & 31);
                    Vt[(8 * dg + 0) * 200 + kpm] = (bf16_t)(vr.x & 0xffffu); Vt[(8 * dg + 1) * 200 + kpm] = (bf16_t)(vr.x >> 16);
                    Vt[(8 * dg + 2) * 200 + kpm] = (bf16_t)(vr.y & 0xffffu); Vt[(8 * dg + 3) * 200 + kpm] = (bf16_t)(vr.y >> 16);
                    Vt[(8 * dg + 4) * 200 + kpm] = (bf16_t)(vr.z & 0xffffu); Vt[(8 * dg + 5) * 200 + kpm] = (bf16_t)(vr.z >> 16);
                    Vt[(8 * dg + 6) * 200 + kpm] = (bf16_t)(vr.w & 0xffffu); Vt[(8 * dg + 7) * 200 + kpm] = (bf16_t)(vr.w >> 16);
                }
                __syncthreads();
                const int g = wave >> 1, qs = wave & 1, hq = hk * 4 + g;
                const float sinkv = args.in[I_SINK][hq];
#pragma unroll
                for (int j2 = 0; j2 < 2; ++j2) {
                    const int qrow = 32 * qs + 16 * j2 + fr;
                    const int tq = t0 + qrow, qpos = qb * 64 + qrow;
                    bf16x8 Qf[2];
                    {
                        const u32x4 r0 = *(const u32x4*)(proj0 + (size_t)tq * N0 + hq * 64 + 8 * fq), r1 = *(const u32x4*)(proj0 + (size_t)tq * N0 + hq * 64 + 32 + 8 * fq);
                        float q0[8], q1[8];
                        q0[0] = lo_bf(r0.x); q0[1] = hi_bf(r0.x); q0[2] = lo_bf(r0.y); q0[3] = hi_bf(r0.y); q0[4] = lo_bf(r0.z); q0[5] = hi_bf(r0.z); q0[6] = lo_bf(r0.w); q0[7] = hi_bf(r0.w);
                        q1[0] = lo_bf(r1.x); q1[1] = hi_bf(r1.x); q1[2] = lo_bf(r1.y); q1[3] = hi_bf(r1.y); q1[4] = lo_bf(r1.z); q1[5] = hi_bf(r1.z); q1[6] = lo_bf(r1.w); q1[7] = hi_bf(r1.w);
                        float ss = 0.f;
#pragma unroll
                        for (int i = 0; i < 8; ++i) ss += q0[i] * q0[i] + q1[i] * q1[i];
                        ss += __shfl_xor(ss, 16); ss += __shfl_xor(ss, 32);
                        const float rstd = rsqrtf(ss * (1.f / 64.f) + EPS) * 0.125f;
#pragma unroll
                        for (int i = 0; i < 8; ++i) { q0[i] *= rstd * qgain[8 * fq + i]; q1[i] *= rstd * qgain[32 + 8 * fq + i]; }
                        float pv[8];
#pragma unroll
                        for (int i = 0; i < 8; ++i) pv[i] = __shfl_xor(q0[i], 16);
                        if (fq < 2) {
#pragma unroll
                            for (int i = 0; i < 8; ++i) { float sn, cs; sincos_rev((float)qpos * exp2f(-2.36644607f * (float)i), sn, cs);
                                q0[i] = (fq == 0) ? (q0[i] * cs - pv[i] * sn) : (q0[i] * cs + pv[i] * sn); }
                        }
                        u32x4 w0, w1;
                        w0.x = cvt_pk_bf16(q0[0], q0[1]); w0.y = cvt_pk_bf16(q0[2], q0[3]); w0.z = cvt_pk_bf16(q0[4], q0[5]); w0.w = cvt_pk_bf16(q0[6], q0[7]);
                        w1.x = cvt_pk_bf16(q1[0], q1[1]); w1.y = cvt_pk_bf16(q1[2], q1[3]); w1.z = cvt_pk_bf16(q1[4], q1[5]); w1.w = cvt_pk_bf16(q1[6], q1[7]);
                        Qf[0] = __builtin_bit_cast(bf16x8, w0); Qf[1] = __builtin_bit_cast(bf16x8, w1);
                    }
                    float mrun = sinkv, lrun = (fq == 0) ? 1.f : 0.f;
                    f32x4 Oa[4];
#pragma unroll
                    for (int dt = 0; dt < 4; ++dt) Oa[dt] = (f32x4){0.f, 0.f, 0.f, 0.f};
#pragma unroll
                    for (int kt = 0; kt < 3; ++kt) {
                        f32x4 sc[4];
                        float tmax = -1e30f;
#pragma unroll
                        for (int mt = 0; mt < 4; ++mt) { sc[mt] = (f32x4){0.f, 0.f, 0.f, 0.f};
#pragma unroll
                            for (int s = 0; s < 2; ++s) sc[mt] = mfma16(*(const LAS bf16x8*)(Ks + (64 * kt + 16 * mt + fr) * 72 + 32 * s + 8 * fq), Qf[s], sc[mt]);
#pragma unroll
                            for (int rg = 0; rg < 4; ++rg) { const int key = 64 * kt + 16 * mt + 4 * fq + rg; const int rel = 128 + qrow - key; const int kp = qb * 64 - 128 + key;
                                const bool ok = (rel >= 0) && (rel < 128) && (kp >= 0);
                                sc[mt][rg] = ok ? sc[mt][rg] : -1e30f; tmax = fmaxf(tmax, sc[mt][rg]); } }
                        tmax = fmaxf(tmax, __shfl_xor(tmax, 16)); tmax = fmaxf(tmax, __shfl_xor(tmax, 32));
                        const float mnew = fmaxf(mrun, tmax), alpha = __expf(mrun - mnew);
                        float ps = 0.f;
#pragma unroll
                        for (int mt = 0; mt < 4; ++mt)
#pragma unroll
                            for (int rg = 0; rg < 4; ++rg) { const float p = (sc[mt][rg] > -1e29f) ? __expf(sc[mt][rg] - mnew) : 0.f; sc[mt][rg] = p; ps += p; }
                        lrun = lrun * alpha + ps; mrun = mnew;
                        bf16x8 Pb[2]; Pb[0] = mk8f(sc[0], sc[1]); Pb[1] = mk8f(sc[2], sc[3]);
#pragma unroll
                        for (int dt = 0; dt < 4; ++dt) { Oa[dt] = Oa[dt] * alpha;
#pragma unroll
                            for (int s2 = 0; s2 < 2; ++s2) Oa[dt] = mfma16(*(const LAS bf16x8*)(Vt + (16 * dt + fr) * 200 + 64 * kt + 32 * s2 + 8 * fq), Pb[s2], Oa[dt]); }
                    }
                    lrun += __shfl_xor(lrun, 16); lrun += __shfl_xor(lrun, 32);
                    const float inv = 1.f / lrun;
#pragma unroll
                    for (int dt = 0; dt < 4; ++dt) { u32x2 w; w.x = cvt_pk_bf16(Oa[dt][0] * inv, Oa[dt][1] * inv); w.y = cvt_pk_bf16(Oa[dt][2] * inv, Oa[dt][3] * inv);
                        *(u32x2*)(mix0 + (size_t)tq * D + hq * 64 + 16 * dt + 4 * fq) = w; }
                }
            }
            __syncthreads();
            {
                LAS float* scr = (LAS float*)(lds + wave * 8448);
                const int gw2 = (bid - 32) * NWAVES + wave, ngw2 = nbk * NWAVES;
                constexpr int I1 = (D / 64) * (D / 32), I2 = (D / 64) * (ODD_IN / 32), I3 = (2048 / 64) * (D / 32);
                for (int it = gw2; it < I1 + I2 + I3; it += ngw2) {
                    int r = it;
                    if (r < I1) { transpose_item(args.in[I_WOUTE], D, D, D, (bf16_t*)(ws + WS_WOUT0), 0, scr, r, lane); continue; } r -= I1;
                    if (r < I2) { transpose_item(args.in[I_WINO], D, ODD_IN, ODD_IN, (bf16_t*)(ws + WS_WIN1), 0, scr, r, lane); continue; } r -= I2;
                    transpose_item(args.in[I_WOUTO], 2048, D, D, (bf16_t*)(ws + WS_WOUT1), 0, scr, r, lane);
                }
                convert_moe(args, 0, scr, gw2, ngw2, lane);
            }
        }
    }
    SEAM(3);

    if (RUN(4)) { PHASE_IDS;
        pg8::Gemm g{(const bf16_t*)(ws + WS_HMIX0), (const bf16_t*)(ws + WS_WOUT0), D, D, nullptr};
        pg8::DenseOrder S; S.init(T, D, G, bid, D, D);
        pg8::EpiResF32 E{args.in[I_X], args.out, D};
        pg8::gemm_phase(lds, g, S, E);
    }
    SEAM(4);

    if (RUN(5)) { PHASE_IDS; moe_route2(args, 0, lds, bid, G, tid, lane, wave); }
    SEAM(5);
    if (RUN(6)) { PHASE_IDS; moe_scatter(args, 0, lds, bid, G, tid, lane, wave); }
    SEAM(6);
    if (RUN(7)) { PHASE_IDS; moe_gemm1(args, 0, lds, bid, G, tid); }
    SEAM(7);
    if (RUN(8)) { PHASE_IDS; moe_gemm2(args, 0, lds, bid, G, tid); }
    SEAM(8);
    if (RUN(9)) { PHASE_IDS; moe_combine<true>(args, args.in[I_LNO], (bf16_t*)(ws + WS_H1), gw, ngw, lane); }
    SEAM(9);

    if (RUN(10)) { PHASE_IDS;
        pg8::Gemm g{(const bf16_t*)(ws + WS_H1), (const bf16_t*)(ws + WS_WIN1), D, D, nullptr};
        pg8::DenseOrder S; S.init(T, ODD_IN, G, bid, D, D);
        pg8::EpiBf16 E{(bf16_t*)(ws + WS_PROJ1), ODD_IN};
        pg8::gemm_phase(lds, g, S, E);
    }
    SEAM(10);

    if (RUN(11)) { PHASE_IDS;
        bf16_t* proj1 = (bf16_t*)(ws + WS_PROJ1); bf16_t* inner = (bf16_t*)(ws + WS_INNER); bf16_t* kzT = (bf16_t*)(ws + WS_KZT);
        LAS bf16_t* Qs = (LAS bf16_t*)lds;
        LAS bf16_t* Ks = (LAS bf16_t*)(lds + 67584);
        const int fr = lane & 15, fq = lane >> 4;
        LAS float* gtab = (LAS float*)(lds + 135168);
        float frq[4];
#pragma unroll
        for (int pp = 0; pp < 4; ++pp) frq[pp] = exp2f(-0.10462765655f * (float)(4 * (lane & 31) + pp));
        for (int item = bid; item < 1024; item += G) {
            const int b = item >> 7, n = (item >> 2) & 31, h = item & 3;
            const int t0 = b * SEQ + n * 128;
            const float l2g = logf(1.0f - exp2f(-5.0f - (float)h)) * 1.4426950408889634f;
            __syncthreads();
            if (tid < 128) gtab[tid] = exp2f((float)tid * l2g);
            {
                const int p = lane & 31;
#pragma unroll
                for (int c = 0; c < 8; ++c) {
                    const int r = 16 * wave + 2 * c + (lane >> 5);
                    const float pos = (float)(n * 128 + r);
                    const bf16_t* pq = proj1 + (size_t)(t0 + r) * ODD_IN + h * 256 + 8 * p;
                    const u32x4 qr = *(const u32x4*)pq, kr = *(const u32x4*)(pq + 1024);
                    unsigned qw[4] = {qr.x, qr.y, qr.z, qr.w}, kw[4] = {kr.x, kr.y, kr.z, kr.w};
#pragma unroll
                    for (int pp = 0; pp < 4; ++pp) {
                        float sn, cs; sincos_rev(pos * frq[pp], sn, cs);
                        const float q1 = lo_bf(qw[pp]), q2 = hi_bf(qw[pp]), k1 = lo_bf(kw[pp]) * 0.0625f, k2 = hi_bf(kw[pp]) * 0.0625f;
                        qw[pp] = cvt_pk_bf16(q1 * cs - q2 * sn, q2 * cs + q1 * sn);
                        kw[pp] = cvt_pk_bf16(k1 * cs - k2 * sn, k2 * cs + k1 * sn);
                    }
                    *(LAS u32x4*)(Qs + r * 264 + 8 * p) = (u32x4){qw[0], qw[1], qw[2], qw[3]};
                    *(LAS u32x4*)(Ks + r * 264 + 8 * p) = (u32x4){kw[0], kw[1], kw[2], kw[3]};
                }
            }
            __syncthreads();
            {
#pragma unroll
                for (int s8 = 0; s8 < 8; ++s8) {
                    const u32x4 v = *(const LAS u32x4*)(Qs + (16 * wave + fr) * 264 + 32 * s8 + 8 * fq);
                    *(u32x4*)(proj1 + (size_t)(t0 + 16 * wave + 2 * s8 + (lane >> 5)) * ODD_IN + h * 256 + 8 * (lane & 31)) = v;
                }
            }
            {
                for (int t = wave; t < 64; t += 8) {
                    int it, jt;
                    if (t < 36) { it = 0; int rem = t; while (rem > it) { rem -= it + 1; ++it; } jt = rem; }
                    else { const int u = t - 36; it = 0; int rem = u; while (rem >= 7 - it) { rem -= 7 - it; ++it; } jt = it + 1 + rem; }
                    f32x4 acc = (f32x4){0.f, 0.f, 0.f, 0.f};
                    if (t < 36) {
#pragma unroll
                        for (int s8 = 0; s8 < 8; ++s8)
                            acc = mfma16(*(const LAS bf16x8*)(Ks + (16 * jt + fr) * 264 + 32 * s8 + 8 * fq), *(const LAS bf16x8*)(Qs + (16 * it + fr) * 264 + 32 * s8 + 8 * fq), acc);
                    }
                    const int i = 16 * it + fr;
                    float vv[4];
#pragma unroll
                    for (int rg = 0; rg < 4; ++rg) { const int j = 16 * jt + 4 * fq + rg; vv[rg] = (i >= j) ? acc[rg] * gtab[i - j] : 0.f; }
                    u32x2 w; w.x = cvt_pk_bf16(vv[0], vv[1]); w.y = cvt_pk_bf16(vv[2], vv[3]);
                    *(u32x2*)(inner + (size_t)item * 16384 + (((it * 4 + (jt >> 1)) * 64 + ((jt & 1) * 2 + (fq >> 1)) * 16 + fr) * 8 + 4 * (fq & 1))) = w;
                }
            }
            {
                const int d = tid >> 1, half = tid & 1;
                bf16_t* po = kzT + (size_t)item * 32768 + ((size_t)(((d >> 5) * 2 + ((d >> 4) & 1)) * 4 + 2 * half) * 64 + (d & 15)) * 8;
#pragma unroll
                for (int i8 = 0; i8 < 8; ++i8) {
                    float kv[8];
#pragma unroll
                    for (int e = 0; e < 8; ++e) { const int r = 64 * half + 8 * i8 + e; kv[e] = bf2f((unsigned)Ks[r * 264 + d]) * gtab[127 - r]; }
                    u32x4 o; o.x = cvt_pk_bf16(kv[0], kv[1]); o.y = cvt_pk_bf16(kv[2], kv[3]); o.z = cvt_pk_bf16(kv[4], kv[5]); o.w = cvt_pk_bf16(kv[6], kv[7]);
                    *(u32x4*)(po + ((i8 >> 2) * 64 + (i8 & 3) * 16) * 8) = o;
                }
            }
        }
    }
    SEAM(11);

    if (RUN(12)) { PHASE_IDS;
        bf16_t* proj1 = (bf16_t*)(ws + WS_PROJ1); const bf16_t* inner = (const bf16_t*)(ws + WS_INNER); const bf16_t* kzT = (const bf16_t*)(ws + WS_KZT);
        float* SSQ = (float*)(ws + WS_SSQ);
        LAS bf16_t* Vt0 = (LAS bf16_t*)lds;
        LAS bf16_t* St0 = (LAS bf16_t*)(lds + 2 * 17408);
        const int fr = lane & 15, fq = lane >> 4;
        for (int wi = bid; wi < 256; wi += G) {
            const int xcd = wi & 7, jj = wi >> 3, bh = xcd * 4 + (jj >> 3), sl = jj & 7, b = bh >> 2, h = bh & 3;
            const float l2g = logf(1.0f - exp2f(-5.0f - (float)h)) * 1.4426950408889634f;
            const float gC = exp2f(128.0f * l2g);
            const float xi = exp2f((float)(16 * wave + fr + 1) * l2g);
            f32x4 Sacc[2][4];
#pragma unroll
            for (int mt = 0; mt < 2; ++mt)
#pragma unroll
                for (int nt = 0; nt < 4; ++nt) Sacc[mt][nt] = (f32x4){0.f, 0.f, 0.f, 0.f};
            __syncthreads();
            for (int i = tid; i < 64 * 264 / 2; i += NTHREADS) ((LAS unsigned*)St0)[i] = 0u;
            LAS bf16_t* Vt = Vt0; LAS bf16_t* St = St0;
            const int vr = tid >> 2, vcs = tid & 3;
            const size_t vcol = 2048 + h * 512 + 64 * sl;
            u32x4 pv0, pv1;
            { const u32x4* pvp = (const u32x4*)(proj1 + (size_t)(b * SEQ + vr) * ODD_IN + vcol + 16 * vcs); pv0 = pvp[0]; pv1 = pvp[1]; }
#define RET_VSTORE_TO(VD) do { const unsigned _w[8] = {pv0.x, pv0.y, pv0.z, pv0.w, pv1.x, pv1.y, pv1.z, pv1.w}; \
                _Pragma("unroll") for (int _e = 0; _e < 8; ++_e) { (VD)[(16 * vcs + 2 * _e) * 136 + vr] = (bf16_t)(_w[_e] & 0xffffu); (VD)[(16 * vcs + 2 * _e + 1) * 136 + vr] = (bf16_t)(_w[_e] >> 16); } } while (0)
#define RET_VSTORE() RET_VSTORE_TO(Vt)
            RET_VSTORE();
            __syncthreads();
            bf16x8 qf[8], nf[4], kf[2][4];
            {
                const int item0 = (b * 32) * 4 + h;
                const bf16_t* pq = proj1 + (size_t)(b * SEQ + 16 * wave + (lane >> 5)) * ODD_IN + h * 256 + 8 * (lane & 31);
#pragma unroll
                for (int s = 0; s < 8; ++s) qf[s] = *(const bf16x8*)(pq + (size_t)(2 * s) * ODD_IN);
                const bf16_t* pin = inner + (size_t)item0 * 16384 + ((wave * 4) * 64 + lane) * 8;
#pragma unroll
                for (int s = 0; s < 4; ++s) nf[s] = *(const bf16x8*)(pin + s * 512);
                const bf16_t* pk = kzT + (size_t)item0 * 32768 + ((wave * 8) * 64 + lane) * 8;
#pragma unroll
                for (int mt = 0; mt < 2; ++mt)
#pragma unroll
                    for (int s = 0; s < 4; ++s) kf[mt][s] = *(const bf16x8*)(pk + (mt * 4 + s) * 512);
            }
            for (int n = 0; n < 32; ++n) {
                Vt = Vt0 + (n & 1) * (64 * 136); St = St0 + (n & 1) * (64 * 264);
                LAS bf16_t* Vtn = Vt0 + ((n + 1) & 1) * (64 * 136); LAS bf16_t* Stn = St0 + ((n + 1) & 1) * (64 * 264);
                const int item = (b * 32 + n) * 4 + h, t0 = b * SEQ + n * 128;
                const int ti = t0 + 16 * wave + fr;
                const bool more = (n + 1 < 32);
                if (more) { const u32x4* pvp = (const u32x4*)(proj1 + (size_t)(t0 + 128 + vr) * ODD_IN + vcol + 16 * vcs); pv0 = pvp[0]; pv1 = pvp[1]; }
                f32x4 ac[4], ai[4];
#pragma unroll
                for (int ct = 0; ct < 4; ++ct) { ac[ct] = (f32x4){0.f, 0.f, 0.f, 0.f}; ai[ct] = (f32x4){0.f, 0.f, 0.f, 0.f}; }
                {
                    bf16x8 sf[3][4];
#pragma unroll
                    for (int ct = 0; ct < 4; ++ct) { sf[0][ct] = *(const LAS bf16x8*)(St + (16 * ct + fr) * 264 + 8 * fq); sf[1][ct] = *(const LAS bf16x8*)(St + (16 * ct + fr) * 264 + 32 + 8 * fq); }
#pragma unroll
                    for (int s = 0; s < 8; ++s) {
                        if (s + 2 < 8) {
#pragma unroll
                            for (int ct = 0; ct < 4; ++ct) sf[(s + 2) % 3][ct] = *(const LAS bf16x8*)(St + (16 * ct + fr) * 264 + 32 * (s + 2) + 8 * fq); }
                        __builtin_amdgcn_sched_barrier(0);
#pragma unroll
                        for (int ct = 0; ct < 4; ++ct) ac[ct] = mfma16(sf[s % 3][ct], qf[s], ac[ct]);
                        __builtin_amdgcn_sched_barrier(0);
                    }
                }
                if (more) { const bf16_t* pq = proj1 + (size_t)(t0 + 128 + 16 * wave + (lane >> 5)) * ODD_IN + h * 256 + 8 * (lane & 31);
#pragma unroll
                    for (int s = 0; s < 8; ++s) qf[s] = *(const bf16x8*)(pq + (size_t)(2 * s) * ODD_IN); }
#pragma unroll
                for (int s = 0; s < 4; ++s)
#pragma unroll
                    for (int ct = 0; ct < 4; ++ct) ai[ct] = mfma16(*(const LAS bf16x8*)(Vt + (16 * ct + fr) * 136 + 32 * s + 8 * fq), nf[s], ai[ct]);
                if (more) { const bf16_t* pin = inner + (size_t)(item + 4) * 16384 + ((wave * 4) * 64 + lane) * 8;
#pragma unroll
                    for (int s = 0; s < 4; ++s) nf[s] = *(const bf16x8*)(pin + s * 512); }
                {
                    float ssq = 0.f;
                    LAS bf16_t* Ow = (LAS bf16_t*)(lds + 102400 + wave * 2304);
#pragma unroll
                    for (int ct = 0; ct < 4; ++ct) {
                        f32x4 o = ai[ct] + ac[ct] * xi;
                        ssq += (o[0] * o[0] + o[1] * o[1]) + (o[2] * o[2] + o[3] * o[3]);
                        u32x2 w; w.x = cvt_pk_bf16(o[0], o[1]); w.y = cvt_pk_bf16(o[2], o[3]);
                        *(LAS u32x2*)(Ow + fr * 72 + 16 * ct + 4 * fq) = w;
                    }
                    {
                        const int rr = lane >> 3, pc = lane & 7;
                        const u32x4 w0 = *(const LAS u32x4*)(Ow + rr * 72 + 8 * pc), w1 = *(const LAS u32x4*)(Ow + (rr + 8) * 72 + 8 * pc);
                        bf16_t* po = proj1 + (size_t)(t0 + 16 * wave + rr) * ODD_IN + vcol + 8 * pc;
                        *(u32x4*)po = w0; *(u32x4*)(po + (size_t)8 * ODD_IN) = w1;
                    }
                    ssq += __shfl_xor(ssq, 16); ssq += __shfl_xor(ssq, 32);
                    if (fq == 0) SSQ[((size_t)(h * 8 + sl)) * T + ti] = ssq;
                }
#pragma unroll
                for (int mt = 0; mt < 2; ++mt)
#pragma unroll
                    for (int nt = 0; nt < 4; ++nt) { Sacc[mt][nt] = Sacc[mt][nt] * gC;
#pragma unroll
                        for (int s = 0; s < 4; ++s) Sacc[mt][nt] = mfma16(kf[mt][s], *(const LAS bf16x8*)(Vt + (16 * nt + fr) * 136 + 32 * s + 8 * fq), Sacc[mt][nt]); }
                if (more) { const bf16_t* pk = kzT + (size_t)(item + 4) * 32768 + ((wave * 8) * 64 + lane) * 8;
#pragma unroll
                    for (int mt = 0; mt < 2; ++mt)
#pragma unroll
                        for (int s = 0; s < 4; ++s) kf[mt][s] = *(const bf16x8*)(pk + (mt * 4 + s) * 512); }
#pragma unroll
                for (int mt = 0; mt < 2; ++mt)
#pragma unroll
                    for (int nt = 0; nt < 4; ++nt) { u32x2 w; w.x = cvt_pk_bf16(Sacc[mt][nt][0], Sacc[mt][nt][1]); w.y = cvt_pk_bf16(Sacc[mt][nt][2], Sacc[mt][nt][3]);
                        *(LAS u32x2*)(Stn + (16 * nt + fr) * 264 + 32 * wave + 16 * mt + 4 * fq) = w; }
                if (more) RET_VSTORE_TO(Vtn);
                __syncthreads();
            }
#undef RET_VSTORE
#undef RET_VSTORE_TO
        }
    }
    SEAM(12);

    if (RUN(13)) { PHASE_IDS;
        bf16_t* proj1 = (bf16_t*)(ws + WS_PROJ1); const float* SSQ = (const float*)(ws + WS_SSQ);
        {
            u32x4 vv[4], zz[4], vn_[4], zn_[4]; float sq = 0.f, sqn = 0.f;
#define FIN_LOAD(tt, V, Z, SQ) do { _Pragma("unroll") for (int j = 0; j < 4; ++j) { const u32x4* _p = (const u32x4*)(proj1 + (size_t)(tt) * ODD_IN + 2048 + j * 512) + lane; V[j] = _p[0]; Z[j] = _p[256]; } \
                SQ = (lane < 32) ? SSQ[(size_t)lane * T + (tt)] : 0.f; } while (0)
            if (gw < T) FIN_LOAD(gw, vv, zz, sq);
            for (int t = gw; t < T; t += ngw) {
                if (t + ngw < T) FIN_LOAD(t + ngw, vn_, zn_, sqn);
                float s8 = sq; s8 += __shfl_xor(s8, 1); s8 += __shfl_xor(s8, 2); s8 += __shfl_xor(s8, 4);
#pragma unroll
                for (int j = 0; j < 4; ++j) {
                    const float rstd = rsqrtf(__builtin_bit_cast(float, __builtin_amdgcn_readlane(__builtin_bit_cast(int, s8), 8 * j)) * (1.f / 512.f) + EPS);
                    const u32x4 v = vv[j], z = zz[j]; u32x4 o;
                    o.x = cvt_pk_bf16(lo_bf(v.x) * rstd * silu_f(lo_bf(z.x)), hi_bf(v.x) * rstd * silu_f(hi_bf(z.x))); o.y = cvt_pk_bf16(lo_bf(v.y) * rstd * silu_f(lo_bf(z.y)), hi_bf(v.y) * rstd * silu_f(hi_bf(z.y)));
                    o.z = cvt_pk_bf16(lo_bf(v.z) * rstd * silu_f(lo_bf(z.z)), hi_bf(v.z) * rstd * silu_f(hi_bf(z.z))); o.w = cvt_pk_bf16(lo_bf(v.w) * rstd * silu_f(lo_bf(z.w)), hi_bf(v.w) * rstd * silu_f(hi_bf(z.w)));
                    *((u32x4*)(proj1 + (size_t)t * ODD_IN + 2048 + j * 512) + lane) = o;
                }
#pragma unroll
                for (int j = 0; j < 4; ++j) { vv[j] = vn_[j]; zz[j] = zn_[j]; }
                sq = sqn;
            }
#undef FIN_LOAD
        }
        convert_moe(args, 1, (LAS float*)(lds + wave * 8448), gw, ngw, lane, 1);
    }
    SEAM(13);

    if (RUN(14)) { PHASE_IDS;
        pg8::Gemm g{(const bf16_t*)(ws + WS_PROJ1) + 2048, (const bf16_t*)(ws + WS_WOUT1), ODD_IN, 2048, nullptr};
        pg8::DenseOrder S; S.init(T, D, G, bid, ODD_IN, 2048);
        pg8::EpiResF32 E{args.out, args.out, D};
        pg8::gemm_phase(lds, g, S, E);
    }
    SEAM(14);

    if (RUN(15)) { PHASE_IDS; moe_route2(args, 1, lds, bid, G, tid, lane, wave); }
    SEAM(15);
    if (RUN(16)) { PHASE_IDS; moe_scatter(args, 1, lds, bid, G, tid, lane, wave); }
    SEAM(16);
    if (RUN(17)) { PHASE_IDS; moe_gemm1(args, 1, lds, bid, G, tid); }
    SEAM(17);
    if (RUN(18)) { PHASE_IDS; moe_gemm2(args, 1, lds, bid, G, tid); }
    SEAM(18);
    if (RUN(19)) { PHASE_IDS; moe_combine<false>(args, nullptr, nullptr, gw, ngw, lane); }
#undef IN
#undef SEAM
}

extern "C" void kernel_launch(void* const* d_in, const int* in_sizes, int n_in, void* d_out, int out_size, void* d_ws, size_t ws_size, hipStream_t stream) {
    static int grid = 0;
    if (grid == 0) {
        if (n_in != 22 || in_sizes[0] != T * D || out_size != T * D || ws_size < WS_END) { fprintf(stderr, "kernel_launch: unexpected shapes / workspace (n_in %d, ws %zu, need %zu)\n", n_in, ws_size, (size_t)WS_END); grid = -1; return; }
        int dev = 0, cus = 0, per_cu = 0;
        (void)hipGetDevice(&dev); (void)hipDeviceGetAttribute(&cus, hipDeviceAttributeMultiprocessorCount, dev);
        if (hipFuncSetAttribute((const void*)fwd_kernel, hipFuncAttributeMaxDynamicSharedMemorySize, LDS_BYTES) != hipSuccess) { fprintf(stderr, "kernel_launch: hipFuncSetAttribute failed\n"); grid = -1; return; }
        if (hipOccupancyMaxActiveBlocksPerMultiprocessor(&per_cu, (const void*)fwd_kernel, NTHREADS, LDS_BYTES) != hipSuccess || per_cu < 1) { fprintf(stderr, "kernel_launch: occupancy query says %d\n", per_cu); grid = -1; return; }
        (void)hipGetLastError();
        grid = cus;
    }
    if (grid < 0) return;
    (void)hipMemsetAsync((char*)d_ws + WS_CTL, 0, 65536, stream);
    Args a{};
    for (int i = 0; i < 22; ++i) a.in[i] = (const float*)d_in[i];
    a.out = (float*)d_out; a.ws = (unsigned char*)d_ws; a.ph_lo = 0; a.ph_hi = PHHI;
    void* kargs[] = {&a};
    hipError_t e = hipLaunchCooperativeKernel((const void*)fwd_kernel, dim3(grid), dim3(NTHREADS), kargs, LDS_BYTES, stream);
    if (e != hipSuccess) fprintf(stderr, "kernel_launch: cooperative launch failed: %s (grid %d)\n", hipGetErrorString(e), grid);
}
```

```cpp
#include <hip/hip_runtime.h>
#include <utility>
#include <hip/hip_cooperative_groups.h>
#include <cstdio>
#include <cstdint>
namespace cg = cooperative_groups;

#define LAS __attribute__((address_space(3)))
typedef unsigned short bf16_t;
typedef short bf16x8 __attribute__((ext_vector_type(8)));
typedef float f32x4 __attribute__((ext_vector_type(4)));
typedef float f32x2 __attribute__((ext_vector_type(2)));
typedef unsigned u32x4 __attribute__((ext_vector_type(4)));
typedef unsigned u32x2 __attribute__((ext_vector_type(2)));

constexpr int NB = 8, SEQ = 4096, D = 1024, T = NB * SEQ;
constexpr int EVEN_IN = 2824, N0 = 2816;
constexpr int ODD_IN = 6144;
constexpr int NEXP = 32, DEXP = 512;
constexpr int ROWS_PAD = 73728;
constexpr float EPS = 1e-6f;
constexpr int NWAVES = 8, NTHREADS = 512;
constexpr int LDS_BYTES = 163840;

constexpr size_t MiB = 1u << 20;
constexpr size_t WS_CTL = 0;
constexpr size_t WS_WIN0 = 1 * MiB;
constexpr size_t WS_WOUT0 = 7 * MiB;
constexpr size_t WS_WIN1 = 9 * MiB;
constexpr size_t WS_WOUT1 = 21 * MiB;
constexpr size_t WS_X = 25 * MiB;
constexpr size_t WS_XB1 = WS_X;
constexpr size_t WS_XB2 = WS_X + 64 * MiB;
constexpr size_t WS_H1 = WS_X;
constexpr size_t WS_INNER = WS_X;
constexpr size_t WS_KZT = WS_X + 32 * MiB;
constexpr size_t WS_SM = 121 * MiB;
constexpr size_t WS_BAB = WS_SM;
constexpr size_t WS_RE = WS_SM + 1 * MiB;
constexpr size_t WS_RG = WS_RE + 256 * 1024;
constexpr size_t WS_RS = WS_RG + 256 * 1024;
constexpr size_t WS_RP = WS_RS + 256 * 1024;
constexpr size_t WS_SSQ = WS_SM + 2 * MiB;
constexpr size_t WS_GL = WS_SM + 6 * MiB;
constexpr size_t WS_ROWTOK = WS_SM + 7 * MiB + 65536;
constexpr size_t WS_BC = WS_SM + 7 * MiB;
constexpr size_t WS_A = 129 * MiB;
constexpr size_t WS_PROJ0 = WS_A;
constexpr size_t WS_HMIX0 = WS_A + 176 * MiB;
constexpr size_t WS_GU = WS_A + 240 * MiB;
constexpr size_t WS_GW = WS_A + 272 * MiB;
constexpr size_t WS_GQD = WS_A + 304 * MiB;
constexpr size_t WS_GKDT = WS_A + 336 * MiB;
constexpr size_t WS_GA = WS_A + 368 * MiB;
constexpr size_t WS_XN = WS_A;
constexpr size_t WS_XROWS = WS_A + 64 * MiB;
constexpr size_t WS_HID = WS_A + 208 * MiB;
constexpr size_t WS_PROJ1 = WS_A;
constexpr size_t WS_XB2L1 = 513 * MiB;
constexpr size_t WS_END = 545 * MiB;

__device__ __forceinline__ float bf2f(unsigned b) { return __uint_as_float(b << 16); }
typedef __bf16 bf16x2_t __attribute__((ext_vector_type(2)));
__device__ __forceinline__ unsigned cvt_pk_bf16(float lo, float hi) { f32x2 v = {lo, hi}; bf16x2_t b = __builtin_convertvector(v, bf16x2_t); return __builtin_bit_cast(unsigned, b); }
__device__ __forceinline__ unsigned short f2bf(float f) { return (unsigned short)(cvt_pk_bf16(f, 0.f) & 0xffffu); }
__device__ __forceinline__ float lo_bf(unsigned w) { return __uint_as_float(w << 16); }
__device__ __forceinline__ float hi_bf(unsigned w) { return __uint_as_float(w & 0xffff0000u); }
__device__ __forceinline__ float silu_f(float x) { return x * __builtin_amdgcn_rcpf(1.0f + __expf(-x)); }
__device__ __forceinline__ float sigmoid_f(float x) { return __builtin_amdgcn_rcpf(1.0f + __expf(-x)); }
__device__ __forceinline__ f32x4 mfma16(bf16x8 a, bf16x8 b, f32x4 c) { return __builtin_amdgcn_mfma_f32_16x16x32_bf16(a, b, c, 0, 0, 0); }
__device__ __forceinline__ bf16x8 mk8(u32x2 lo, u32x2 hi) { u32x4 v; v.x = lo.x; v.y = lo.y; v.z = hi.x; v.w = hi.y; return __builtin_bit_cast(bf16x8, v); }
__device__ __forceinline__ bf16x8 mk8f(f32x4 a, f32x4 b) { u32x4 v; v.x = cvt_pk_bf16(a[0], a[1]); v.y = cvt_pk_bf16(a[2], a[3]); v.z = cvt_pk_bf16(b[0], b[1]); v.w = cvt_pk_bf16(b[2], b[3]); return __builtin_bit_cast(bf16x8, v); }
template <int J> __device__ __forceinline__ void fmac_bc(float& acc, int l, float u) {
    if constexpr (J == 0) asm("s_nop 1\n\tv_fmac_f32_dpp %0, %1, %2 row_newbcast:0 row_mask:0xf bank_mask:0xf" : "+v"(acc) : "v"(l), "v"(u));
    else asm("v_fmac_f32_dpp %0, %1, %2 row_newbcast:%3 row_mask:0xf bank_mask:0xf" : "+v"(acc) : "v"(l), "v"(u), "n"(J));
}
template <int... Js> __device__ __forceinline__ void solve_terms(float (&s)[4], const int (&lc)[4], const float (&U)[64], std::integer_sequence<int, Js...>) { (fmac_bc<(Js & 15)>(s[Js & 3], lc[Js >> 4], U[Js]), ...); }
template <int I> __device__ __forceinline__ void solve_row(float (&U)[64], int (&ln)[4], const LAS float* Lm, const LAS unsigned short* Rb, int l16, int c) {
    const int lc[4] = {ln[0], ln[1], ln[2], ln[3]};
    if constexpr (I + 1 < 64) {
#pragma unroll
        for (int k = 0; k < 4; ++k) if (16 * k < I + 1) ln[k] = __builtin_bit_cast(int, Lm[(I + 1) * 64 + 16 * k + l16]);
    }
    float s[4] = {__uint_as_float((unsigned)Rb[I * 264 + c] << 16), 0.f, 0.f, 0.f};
    solve_terms(s, lc, U, std::make_integer_sequence<int, I>{});
    U[I] = (s[0] + s[1]) + (s[2] + s[3]);
}
template <int... Is> __device__ __forceinline__ void solve_rows(float (&U)[64], int (&ln)[4], const LAS float* Lm, const LAS unsigned short* Rb, int l16, int c, std::integer_sequence<int, Is...>) { (solve_row<Is + 1>(U, ln, Lm, Rb, l16, c), ...); }
__device__ __forceinline__ float wave_sum(float v) {
#pragma unroll
    for (int o = 1; o < 64; o <<= 1) v += __shfl_xor(v, o);
    return v;
}
__device__ __forceinline__ void sincos_rev(float ang, float& s, float& c) {
    float r = ang * 0.15915494309189535f; r = r - floorf(r);
    s = __builtin_amdgcn_sinf(r); c = __builtin_amdgcn_cosf(r);
}

namespace pg8 {
constexpr int BM = 256, BK = 64, HALF = 128, HTB = HALF * BK * 2, STAGE_BYTES = 8 * HTB, NXCD = 8, WGM = 4;
__device__ __forceinline__ int lds_byte(int r, int c) { const int st = (r >> 4) * 2 + (c >> 5), rr = r & 15, cc = c & 31, ob = rr * 64 + cc * 2; return st * 1024 + (ob ^ (((ob >> 9) & 1) << 5)); }
__device__ __forceinline__ void stage_rc(int b, int& R, int& C) { const int st = b / 1024, sb = b % 1024, swz = sb ^ (((sb >> 9) & 1) << 5); R = (st >> 1) * 16 + swz / 64; C = (st & 1) * 32 + (swz % 64) / 2; }
__device__ __forceinline__ int perm32(int rho) { const int n = rho >> 4, i = rho & 15; return 8 * (i >> 2) + 4 * n + (i & 3); }

struct Unit { size_t aoff, boff; int pm, pn; };
struct Gemm { const bf16_t* A; const bf16_t* Bt; int lda, K; const int* rowtok; };

struct DenseOrder {
    int nM, nN, nwg, G, c, lda, K;
    __device__ void init(int M, int N, int G_, int c_, int lda_, int K_) { nM = M / BM; nN = N / BM; nwg = nM * nN; G = G_; c = c_; lda = lda_; K = K_; }
    __device__ bool next(int i, Unit& u) const {
        const long L = (long)i * G + c; if (L >= nwg) return false;
        int wgid = (int)L; { const int q = nwg / NXCD, r = nwg % NXCD, xcd = wgid % NXCD, off = wgid / NXCD; wgid = (xcd < r ? xcd * (q + 1) : r * (q + 1) + (xcd - r) * q) + off; }
        const int nig = WGM * nN, gid = wgid / nig, fm = gid * WGM, gsz = (nM - fm) < WGM ? (nM - fm) : WGM;
        u.pm = fm + ((wgid % nig) % gsz); u.pn = (wgid % nig) / gsz;
        u.aoff = (size_t)u.pm * BM * lda * 2; u.boff = (size_t)u.pn * BM * K * 2; return true;
    }
};
struct GroupedOrder {
    const LAS int* tile_e; int ntiles, G, c, lda, K; size_t estride;
    __device__ bool next(int i, Unit& u) const {
        const int L = i * G + c; if (L >= ntiles * 4) return false;
        const int rt = L >> 2, pn = L & 3; const int e = tile_e[rt];
        u.pm = rt; u.pn = pn; u.aoff = (size_t)rt * BM * lda * 2; u.boff = (size_t)e * estride + (size_t)pn * BM * K * 2; return true;
    }
};

struct EpiBf16 {
    static constexpr bool PERM = true;
    bf16_t* O; int ldc;
    __device__ __forceinline__ void operator()(const f32x4 (&acc)[2][2][4][2], const Unit& u, int wr, int wc, int fr, int fq) const {
        const int row0 = u.pm * BM + wr * 64 + fr; const int col0 = u.pn * BM + wc * 32 + 8 * fq;
#pragma unroll
        for (int ai = 0; ai < 2; ++ai)
#pragma unroll
            for (int m = 0; m < 4; ++m) { bf16_t* rowp = O + (size_t)(row0 + ai * HALF + m * 16) * ldc + col0;
#pragma unroll
                for (int bj = 0; bj < 2; ++bj) { const f32x4 v0 = acc[ai][bj][m][0], v1 = acc[ai][bj][m][1];
                    u32x4 w; w.x = cvt_pk_bf16(v0[0], v0[1]); w.y = cvt_pk_bf16(v0[2], v0[3]); w.z = cvt_pk_bf16(v1[0], v1[1]); w.w = cvt_pk_bf16(v1[2], v1[3]);
                    *(u32x4*)(rowp + bj * HALF) = w; } }
    }
};
struct EpiResF32 {
    static constexpr bool PERM = false;
    const float* base; float* out; int ldc;
    __device__ __forceinline__ void operator()(const f32x4 (&acc)[2][2][4][2], const Unit& u, int wr, int wc, int fr, int fq) const {
        const int row0 = u.pm * BM + wr * 64 + fr, col0 = u.pn * BM + wc * 32 + 4 * fq;
#pragma unroll
        for (int ai = 0; ai < 2; ++ai)
#pragma unroll
            for (int m = 0; m < 4; ++m) { const size_t off = (size_t)(row0 + ai * HALF + m * 16) * ldc + col0;
#pragma unroll
                for (int bj = 0; bj < 2; ++bj)
#pragma unroll
                    for (int n = 0; n < 2; ++n) { const f32x4 b = *(const f32x4*)(base + off + bj * HALF + n * 16); *(f32x4*)(out + off + bj * HALF + n * 16) = b + acc[ai][bj][m][n]; } }
    }
};
struct EpiSwiGLU {
    static constexpr bool PERM = false;
    bf16_t* H;
    __device__ __forceinline__ void operator()(const f32x4 (&acc)[2][2][4][2], const Unit& u, int wr, int wc, int fr, int fq) const {
        const int row0 = u.pm * BM + wr * 64 + fr;
#pragma unroll
        for (int ai = 0; ai < 2; ++ai)
#pragma unroll
            for (int m = 0; m < 4; ++m) { bf16_t* rowp = H + (size_t)(row0 + ai * HALF + m * 16) * DEXP;
#pragma unroll
                for (int bj = 0; bj < 2; ++bj) { const f32x4 g = acc[ai][bj][m][0], up = acc[ai][bj][m][1];
                    const int hc = 16 * (8 * u.pn + 4 * bj + wc) + 4 * fq;
                    u32x2 w; w.x = cvt_pk_bf16(silu_f(g[0]) * up[0], silu_f(g[1]) * up[1]); w.y = cvt_pk_bf16(silu_f(g[2]) * up[2], silu_f(g[3]) * up[3]);
                    *(u32x2*)(rowp + hc) = w; } }
    }
};

template <class Epi, class Sched, bool GATHER = false>
__device__ __forceinline__ void gemm_phase(LAS unsigned char* lds, const Gemm g, const Sched& S, const Epi& E) {
    const int tid = threadIdx.x, wid = __builtin_amdgcn_readfirstlane(tid >> 6), lane = tid & 63, wr = wid >> 2, wc = wid & 3, fr = lane & 15, fq = lane >> 4;
    const int K = g.K, nt = K / BK;
    unsigned voffA[2], voffB[2]; int gR[2]; unsigned gC[2];
#pragma unroll
    for (int i = 0; i < 2; ++i) { int R, C; stage_rc(tid * 16 + i * 8192, R, C); const int Rb = Epi::PERM ? ((R & ~31) + perm32(R & 31)) : R;
        voffA[i] = (unsigned)(R * g.lda + C) * 2u; voffB[i] = (unsigned)(Rb * K + C) * 2u; gR[i] = R; gC[i] = (unsigned)C * 2u; }
    unsigned gA[2][2], gN[2][2];
#define PG8_GLOAD(dst, pm_) do { _Pragma("unroll") for (int _h = 0; _h < 2; ++_h) _Pragma("unroll") for (int _i = 0; _i < 2; ++_i) \
        dst[_h][_i] = (unsigned)g.rowtok[(pm_) * BM + _h * HALF + gR[_i]] * (unsigned)(g.lda * 2) + gC[_i]; } while (0)
    const size_t kstep = (size_t)(BK * 2);
    const size_t hstepA = (size_t)HALF * g.lda * 2, hstepB = (size_t)HALF * K * 2;
    const unsigned ldsw = (unsigned)wid * 1024u;
    const int aoff = lds_byte(wr * 64 + fr, fq * 8), boff = lds_byte(wc * 32 + fr, fq * 8);
#define PG8_SA(b, h) (((b) * 2 + (h)) * HTB)
#define PG8_SB(b, h) ((4 + (b) * 2 + (h)) * HTB)
#define PG8_STAGE(bufoff, gbase, voff) do { _Pragma("unroll") for (int _i = 0; _i < 2; ++_i) \
        __builtin_amdgcn_global_load_lds((const unsigned*)((const char*)(gbase) + (voff)[_i]), (LAS unsigned*)(lds + (bufoff) + ldsw + _i * 8192), 16, 0, 0); } while (0)
#define PG8_STAGE_A(bufoff, gbase, h, OFFS) do { if constexpr (GATHER) { PG8_STAGE(bufoff, gbase, OFFS[h]); } else { PG8_STAGE(bufoff, (gbase) + (h) * hstepA, voffA); } } while (0)
#define PG8_LDA(dst, b, h) do { _Pragma("unroll") for (int m = 0; m < 4; ++m) _Pragma("unroll") for (int k = 0; k < 2; ++k) dst[m][k] = *(const LAS bf16x8*)(lds + PG8_SA(b, h) + aoff + m * 2048 + k * 1024); } while (0)
#define PG8_LDB(dst, b, h) do { _Pragma("unroll") for (int n = 0; n < 2; ++n) _Pragma("unroll") for (int k = 0; k < 2; ++k) dst[n][k] = *(const LAS bf16x8*)(lds + PG8_SB(b, h) + boff + n * 2048 + k * 1024); } while (0)
#define PG8_MMA(ai, bj, At, Bt) do { __builtin_amdgcn_s_setprio(1); _Pragma("unroll") for (int m = 0; m < 4; ++m) _Pragma("unroll") for (int n = 0; n < 2; ++n) _Pragma("unroll") for (int k = 0; k < 2; ++k) \
        acc[ai][bj][m][n] = __builtin_amdgcn_mfma_f32_16x16x32_bf16(Bt[n][k], At[m][k], acc[ai][bj][m][n], 0, 0, 0); __builtin_amdgcn_s_setprio(0); } while (0)
#define PG8_WAIT_V(n) asm volatile("s_waitcnt vmcnt(" #n ")" ::: "memory")
#define PG8_WAIT_L(n) asm volatile("s_waitcnt lgkmcnt(" #n ")" ::: "memory")
#define PG8_BAR __builtin_amdgcn_s_barrier()
#define PG8_SCHED __builtin_amdgcn_sched_barrier(0)
    Unit cur, nxt; int ui = 0;
    if (!S.next(0, cur)) return;
    f32x4 acc[2][2][4][2];
#pragma unroll
    for (int a = 0; a < 2; ++a)
#pragma unroll
        for (int b = 0; b < 2; ++b)
#pragma unroll
            for (int m = 0; m < 4; ++m)
#pragma unroll
                for (int n = 0; n < 2; ++n) acc[a][b][m][n] = (f32x4){0.f, 0.f, 0.f, 0.f};
    bf16x8 At[4][2], B0[2][2], B1[2][2];
    const char* cA = (const char*)g.A + cur.aoff; const char* cB = (const char*)g.Bt + cur.boff;
    if constexpr (GATHER) { PG8_GLOAD(gA, cur.pm); } else { gA[0][0] = gA[0][1] = gA[1][0] = gA[1][1] = 0u; }
#pragma unroll
    for (int _h = 0; _h < 2; ++_h) { gN[_h][0] = gA[_h][0]; gN[_h][1] = gA[_h][1]; }
    PG8_STAGE(PG8_SB(0, 0), cB, voffB); PG8_STAGE(PG8_SB(0, 1), cB + hstepB, voffB); PG8_STAGE_A(PG8_SA(0, 0), cA, 0, gA); PG8_STAGE_A(PG8_SA(0, 1), cA, 1, gA);
    if (wr == 1) PG8_BAR;
    PG8_WAIT_V(2); PG8_BAR;
    PG8_STAGE(PG8_SB(1, 0), cB + kstep, voffB); PG8_STAGE_A(PG8_SA(1, 0), cA + kstep, 0, gA); PG8_STAGE(PG8_SB(1, 1), cB + hstepB + kstep, voffB);
    PG8_WAIT_V(6); PG8_BAR;
    for (;;) {
        const bool has_next = S.next(ui + 1, nxt);
        const char* nA = has_next ? (const char*)g.A + nxt.aoff : cA; const char* nB = has_next ? (const char*)g.Bt + nxt.boff : cB;
        if constexpr (GATHER) { if (has_next) { PG8_GLOAD(gN, nxt.pm); } else {
#pragma unroll
            for (int _h = 0; _h < 2; ++_h) { gN[_h][0] = gA[_h][0]; gN[_h][1] = gA[_h][1]; } } }
        asm volatile(".p2align 6\n\ts_nop 0" ::: "memory");
        for (int t = 0; t < nt; t += 2) {
            const bool last = (t == nt - 2);
            const char* a1 = cA + (size_t)(t + 1) * kstep;
            const char* a2 = last ? nA : cA + (size_t)(t + 2) * kstep; const char* b2 = last ? nB : cB + (size_t)(t + 2) * kstep;
            const char* a3 = a2 + kstep; const char* b3 = b2 + kstep;
            unsigned g2[2][2];
#pragma unroll
            for (int _h = 0; _h < 2; ++_h) { g2[_h][0] = last ? gN[_h][0] : gA[_h][0]; g2[_h][1] = last ? gN[_h][1] : gA[_h][1]; }
            PG8_LDB(B0, 0, 0); PG8_LDB(B1, 0, 1); PG8_SCHED; PG8_LDA(At, 0, 0); PG8_STAGE_A(PG8_SA(1, 1), a1, 1, gA);
            PG8_WAIT_V(8); PG8_WAIT_L(0); PG8_BAR; PG8_MMA(0, 0, At, B0); PG8_MMA(0, 1, At, B1); PG8_BAR; PG8_SCHED;
            PG8_LDA(At, 0, 1); PG8_STAGE(PG8_SB(0, 0), b2, voffB); PG8_STAGE(PG8_SB(0, 1), b2 + hstepB, voffB); PG8_STAGE_A(PG8_SA(0, 0), a2, 0, g2);
            PG8_WAIT_V(8); PG8_WAIT_L(0); PG8_BAR; PG8_MMA(1, 0, At, B0); PG8_MMA(1, 1, At, B1); PG8_BAR; PG8_SCHED;
            PG8_LDB(B0, 1, 0); PG8_LDB(B1, 1, 1); PG8_SCHED; PG8_LDA(At, 1, 0); PG8_STAGE_A(PG8_SA(0, 1), a2, 1, g2);
            PG8_WAIT_V(8); PG8_WAIT_L(0); PG8_BAR; PG8_MMA(0, 0, At, B0); PG8_MMA(0, 1, At, B1); PG8_BAR; PG8_SCHED;
            PG8_LDA(At, 1, 1); PG8_STAGE(PG8_SB(1, 0), b3, voffB); PG8_STAGE(PG8_SB(1, 1), b3 + hstepB, voffB); PG8_STAGE_A(PG8_SA(1, 0), a3, 0, g2);
            PG8_WAIT_V(8); PG8_WAIT_L(0); PG8_BAR; PG8_MMA(1, 0, At, B0); PG8_MMA(1, 1, At, B1); PG8_BAR; PG8_SCHED;
        }
        if (wr == 0) PG8_BAR;
        E(acc, cur, wr, wc, fr, fq);
        if (!has_next) break;
#pragma unroll
        for (int a = 0; a < 2; ++a)
#pragma unroll
            for (int b = 0; b < 2; ++b)
#pragma unroll
                for (int m = 0; m < 4; ++m)
#pragma unroll
                    for (int n = 0; n < 2; ++n) acc[a][b][m][n] = (f32x4){0.f, 0.f, 0.f, 0.f};
        cur = nxt; cA = nA; cB = nB; ++ui;
#pragma unroll
        for (int _h = 0; _h < 2; ++_h) { gA[_h][0] = gN[_h][0]; gA[_h][1] = gN[_h][1]; }
        if (wr == 1) PG8_BAR;
    }
    PG8_WAIT_V(0);
    PG8_BAR;
#undef PG8_SA
#undef PG8_SB
#undef PG8_STAGE
#undef PG8_STAGE_A
#undef PG8_GLOAD
#undef PG8_LDA
#undef PG8_LDB
#undef PG8_MMA
#undef PG8_WAIT_V
#undef PG8_WAIT_L
#undef PG8_BAR
#undef PG8_SCHED
}
}

#define XB_TMO      128
#define XB_XCNT(j)  (256  + 64 * (j))
#define XB_XSUB(j)  (1280 + 64 * (j))
#define XB_XGEN(j)  (2304 + 64 * (j))
#define XB_TOP      3328
#define XB_TOPGEN   3392
#define XCD_BAR_WORDS 3456
#define XB_SPIN_CAP (1u << 18)
__device__ __forceinline__ unsigned xb_ld(unsigned* p)              { return __hip_atomic_load(p, __ATOMIC_RELAXED, __HIP_MEMORY_SCOPE_AGENT); }
__device__ __forceinline__ unsigned xb_add(unsigned* p, unsigned v) { return __hip_atomic_fetch_add(p, v, __ATOMIC_RELAXED, __HIP_MEMORY_SCOPE_AGENT); }
__device__ __forceinline__ unsigned xb_xcc_id() { return (unsigned)__builtin_amdgcn_s_getreg((3 << 11) | 20) & 0xFu; }
#define XB_SPIN(cond, bar) do { unsigned _sp = 0; while (cond) { __builtin_amdgcn_s_sleep(1); \
    if ((++_sp & 255u) == 0u) { if (xb_ld(&(bar)[XB_TMO])) break; if (_sp > XB_SPIN_CAP) { atomicAdd(&(bar)[XB_TMO], 1u); break; } } } } while (0)
struct XcdBarrier { unsigned* bar; unsigned x; volatile LAS unsigned* st; };
__device__ __forceinline__ XcdBarrier xcd_barrier_post(unsigned* bar, volatile LAS unsigned* st) {
    XcdBarrier b; b.bar = bar; b.x = xb_xcc_id(); b.st = st;
    if (threadIdx.x == 0) (void)xb_add(&bar[XB_XCNT(b.x)], 1u);
    return b;
}
__device__ __forceinline__ void xcd_barrier_complete(unsigned* bar, unsigned x, unsigned& nloc, unsigned& nx) {
    const unsigned G = gridDim.x * gridDim.y * gridDim.z;
    unsigned sum, cnt, mine, sp = 0u;
    for (;;) {
        sum = 0u; cnt = 0u; mine = 0u;
#pragma unroll
        for (unsigned j = 0; j < 16; ++j) { const unsigned c = xb_ld(&bar[XB_XCNT(j)]); sum += c; cnt += (c > 0u) ? 1u : 0u; mine = (j == x) ? c : mine; }
        if (sum == G) break;
        __builtin_amdgcn_s_sleep(1);
        if ((++sp & 255u) == 0u) { if (xb_ld(&bar[XB_TMO])) break; if (sp > XB_SPIN_CAP) { atomicAdd(&bar[XB_TMO], 1u); break; } }
    }
    nloc = mine > 0u ? mine : 1u; nx = cnt > 0u ? cnt : 1u;
}
__device__ __forceinline__ void xcd_barrier(const XcdBarrier& b) {
    asm volatile("s_waitcnt vmcnt(0)" ::: "memory");
    __syncthreads();
    if (threadIdx.x == 0) {
        unsigned* bar = b.bar;
        __builtin_amdgcn_s_waitcnt(0);
        unsigned nloc = b.st[0], nx = b.st[1];
        if (nloc == 0u) { xcd_barrier_complete(bar, b.x, nloc, nx); b.st[0] = nloc; b.st[1] = nx; }
        const unsigned old = xb_add(&bar[XB_XSUB(b.x)], 1u);
        const unsigned gen = old / nloc;
        if (old + 1u == (gen + 1u) * nloc) {
            __builtin_amdgcn_fence(__ATOMIC_RELEASE, "agent");
            asm volatile("s_waitcnt vmcnt(0)" ::: "memory");
            const unsigned og = xb_add(&bar[XB_TOP], 1u);
            const unsigned tg = og / nx;
            if (og + 1u == (tg + 1u) * nx) xb_add(&bar[XB_TOPGEN], 1u);
            else XB_SPIN(xb_ld(&bar[XB_TOPGEN]) == tg, bar);
            __builtin_amdgcn_fence(__ATOMIC_ACQUIRE, "agent");
            xb_add(&bar[XB_XGEN(b.x)], 1u);
            asm volatile("s_waitcnt vmcnt(0)" ::: "memory");
        } else {
            XB_SPIN(xb_ld(&bar[XB_XGEN(b.x)]) == gen, bar);
            __builtin_amdgcn_fence(__ATOMIC_ACQUIRE, "agent");
            asm volatile("s_waitcnt vmcnt(0)" ::: "memory");
        }
    }
    __syncthreads();
}

struct Args {
    const float* in[22];
    float* out; unsigned char* ws;
    int ph_lo, ph_hi;
};
enum { I_X = 0, I_LNE, I_WINE, I_CONVW, I_ALOG, I_DTB, I_QG, I_KG, I_SINK, I_GDNG, I_WOUTE, I_LNO, I_WINO, I_WOUTO, I_LNF, I_WRG, I_BRG, I_WRE, I_BRE, I_WG, I_WU, I_WD };

__device__ __forceinline__ void transpose_item(const float* W, int K, int ldw, int ncols, bf16_t* WT, int mode, LAS float* scr, int item, int lane) {
    const int nblk = ncols / 32, kb = item / nblk, nb = item % nblk, k0 = 64 * kb, n0 = 32 * nb;
#pragma unroll 8
    for (int i = 0; i < 32; ++i) { const int kk = 2 * i + (lane >> 5); scr[kk * 33 + (lane & 31)] = W[(size_t)(k0 + kk) * ldw + n0 + (lane & 31)]; }
    asm volatile("s_waitcnt lgkmcnt(0)" ::: "memory");
    const int c = lane & 7;
#pragma unroll
    for (int j = 0; j < 4; ++j) { const int n = (lane >> 3) + 8 * j; const LAS float* s = scr + (8 * c) * 33 + n;
        u32x4 o; o.x = cvt_pk_bf16(s[0 * 33], s[1 * 33]); o.y = cvt_pk_bf16(s[2 * 33], s[3 * 33]); o.z = cvt_pk_bf16(s[4 * 33], s[5 * 33]); o.w = cvt_pk_bf16(s[6 * 33], s[7 * 33]);
        const int ng = n0 + n; const int row = (mode == 0) ? ng : (32 * (ng >> 4) + (ng & 15) + (mode == 2 ? 16 : 0));
        *(u32x4*)(WT + (size_t)row * K + k0 + 8 * c) = o; }
    asm volatile("s_waitcnt lgkmcnt(0)" ::: "memory");
}
__device__ __forceinline__ void convert_moe(const Args& a, int layer, LAS float* scr, int gw, int ngw, int lane, int which = 3) {
    bf16_t* B1 = (bf16_t*)(a.ws + WS_XB1); bf16_t* B2 = (bf16_t*)(a.ws + (layer == 1 ? WS_XB2L1 : WS_XB2));
    const float* wg = a.in[I_WG] + (size_t)layer * NEXP * D * DEXP; const float* wu = a.in[I_WU] + (size_t)layer * NEXP * D * DEXP; const float* wd = a.in[I_WD] + (size_t)layer * NEXP * DEXP * D;
    constexpr int IG = (D / 64) * (DEXP / 32);
    constexpr int ID = (DEXP / 64) * (D / 32);
    constexpr int PER_E = 2 * IG + ID;
    for (int it = gw; it < NEXP * PER_E; it += ngw) {
        const int e = it / PER_E; int r = it % PER_E;
        if (((r < 2 * IG) ? 1 : 2) & ~which) continue;
        if (r < IG) { transpose_item(wg + (size_t)e * D * DEXP, D, DEXP, DEXP, B1 + (size_t)e * 1024 * 1024, 1, scr, r, lane); continue; } r -= IG;
        if (r < IG) { transpose_item(wu + (size_t)e * D * DEXP, D, DEXP, DEXP, B1 + (size_t)e * 1024 * 1024, 2, scr, r, lane); continue; } r -= IG;
        transpose_item(wd + (size_t)e * DEXP * D, DEXP, D, D, B2 + (size_t)e * 1024 * 512, 0, scr, r, lane);
    }
}

__device__ __forceinline__ void moe_route(const Args& a, int layer, LAS unsigned char* lds, int bid, int G, int tid, int lane, int wave) {
    LAS float* wT = (LAS float*)lds;
    LAS float* lng = (LAS float*)(lds + 147456);
    LAS float* bias = (LAS float*)(lds + 151552);
    LAS int* lcnt = (LAS int*)(lds + 151552 + 256);
    LAS int* lbase = lcnt + 32;
    LAS int* tokE = lbase + 32;
    LAS int* tokR = tokE + 256;
    const float* wrg = a.in[I_WRG] + (size_t)layer * D * 4; const float* wre = a.in[I_WRE] + (size_t)layer * D * 32;
    for (int i = tid; i < 4 * 1024; i += NTHREADS) { const int k = i >> 2, o = i & 3; wT[o * 1024 + k] = wrg[i]; }
    for (int i = tid; i < 32 * 1024; i += NTHREADS) { const int k = i >> 5, o = i & 31; wT[(4 + o) * 1024 + k] = wre[i]; }
    for (int i = tid; i < 1024; i += NTHREADS) lng[i] = a.in[I_LNF][layer * D + i];
    if (tid < 4) bias[tid] = a.in[I_BRG][layer * 4 + tid];
    if (tid >= 64 && tid < 96) bias[4 + tid - 64] = a.in[I_BRE][layer * 32 + tid - 64];
    const float* x = a.out;
    bf16_t* xn = (bf16_t*)(a.ws + WS_XN);
    int* RE = (int*)(a.ws + WS_RE); float* RG = (float*)(a.ws + WS_RG); int* RS = (int*)(a.ws + WS_RS);
    int* gcnt = (int*)(a.ws + WS_CTL) + layer * 32; int* BC = (int*)(a.ws + WS_BC);
    const int tsub = lane >> 4, l16 = lane & 15;
    for (int tile = bid; tile < T / 128; tile += G) {
        __syncthreads();
        if (tid < 32) lcnt[tid] = 0;
        __syncthreads();
        for (int iter = 0; iter < 4; ++iter) {
            const int tl = wave * 16 + iter * 4 + tsub, t = tile * 128 + tl;
            const f32x4* xr = (const f32x4*)(x + (size_t)t * D) + l16;
            f32x4 v[16]; float ss = 0.f;
#pragma unroll
            for (int j = 0; j < 16; ++j) { v[j] = xr[16 * j]; ss += (v[j][0] * v[j][0] + v[j][1] * v[j][1]) + (v[j][2] * v[j][2] + v[j][3] * v[j][3]); }
            ss += __shfl_xor(ss, 1); ss += __shfl_xor(ss, 2); ss += __shfl_xor(ss, 4); ss += __shfl_xor(ss, 8);
            const float rstd = rsqrtf(ss * (1.f / D) + EPS);
            unsigned long long* o8 = (unsigned long long*)(xn + (size_t)t * D) + l16;
#pragma unroll
            for (int j = 0; j < 16; ++j) { v[j] = v[j] * rstd * *((const LAS f32x4*)lng + l16 + 16 * j);
                o8[16 * j] = (unsigned long long)cvt_pk_bf16(v[j][0], v[j][1]) | ((unsigned long long)cvt_pk_bf16(v[j][2], v[j][3]) << 32); }
            LAS float* lgs = (LAS float*)(lds + 154624) + (wave * 4 + tsub) * 40;
#pragma unroll 2
            for (int o = 0; o < 36; ++o) { float acc = 0.f;
#pragma unroll
                for (int j = 0; j < 16; ++j) { const f32x4 w = *((const LAS f32x4*)(wT + o * 1024) + l16 + 16 * j); acc += (v[j][0] * w[0] + v[j][1] * w[1]) + (v[j][2] * w[2] + v[j][3] * w[3]); }
                acc += __shfl_xor(acc, 1); acc += __shfl_xor(acc, 2); acc += __shfl_xor(acc, 4); acc += __shfl_xor(acc, 8);
                if (l16 == 0) lgs[o] = acc + bias[o]; }
            asm volatile("s_waitcnt lgkmcnt(0)" ::: "memory");
            int gi = 0; float gm = lgs[0];
            for (int o = 1; o < 4; ++o) { const float lv = lgs[o]; if (lv > gm) { gm = lv; gi = o; } }
            float gs = 0.f;
            for (int o = 0; o < 4; ++o) gs += __expf(lgs[o] - gm);
            const float grp_p = 1.f / gs;
            const LAS float* le = lgs + 4 + 8 * gi;
            int e1 = 0; float m1 = le[0];
            for (int k = 1; k < 8; ++k) { const float lv = le[k]; if (lv > m1) { m1 = lv; e1 = k; } }
            int e2 = -1; float m2 = -3.0e38f;
            for (int k = 0; k < 8; ++k) { const float lv = le[k]; if (k != e1 && lv > m2) { m2 = lv; e2 = k; } }
            const float p2 = __expf(m2 - m1);
            const float g1 = grp_p / (1.f + p2), g2 = grp_p * p2 / (1.f + p2);
            if (l16 == 0) {
                const int ea = gi * 8 + e1, eb = gi * 8 + e2;
                RE[(size_t)t * 2] = ea; RE[(size_t)t * 2 + 1] = eb; RG[(size_t)t * 2] = g1; RG[(size_t)t * 2 + 1] = g2;
                tokE[tl * 2] = ea; tokE[tl * 2 + 1] = eb;
                atomicAdd((int*)(lcnt + ea), 1); atomicAdd((int*)(lcnt + eb), 1);
            }
        }
        __syncthreads();
        if (tid < 32) { const int c = lcnt[tid]; BC[tile * 32 + tid] = c; atomicAdd(gcnt + tid, c); }
        if (tid < 256) { const int e = tokE[tid]; int rank = 0; for (int j = 0; j < tid; ++j) rank += (tokE[j] == e) ? 1 : 0; RS[(size_t)tile * 256 + tid] = rank; }
    }
}
__device__ __forceinline__ void moe_route2(const Args& a, int layer, LAS unsigned char* lds, int bid, int G, int tid, int lane, int wave) {
    LAS bf16_t* wh = (LAS bf16_t*)lds;
    LAS bf16_t* wl = (LAS bf16_t*)(lds + 74304);
    LAS float* lng = (LAS float*)(lds + 148608);
    LAS float* bias = (LAS float*)(lds + 152704);
    LAS int* lcnt = (LAS int*)(lds + 152704 + 256);
    LAS int* tokE = lcnt + 64;
    LAS float* lgs = (LAS float*)lds;
    const float* wrg = a.in[I_WRG] + (size_t)layer * D * 4; const float* wre = a.in[I_WRE] + (size_t)layer * D * 32;
    const float* x = a.out;
    bf16_t* xn = (bf16_t*)(a.ws + WS_XN);
    int* RE = (int*)(a.ws + WS_RE); float* RG = (float*)(a.ws + WS_RG); int* RS = (int*)(a.ws + WS_RS);
    int* gcnt = (int*)(a.ws + WS_CTL) + layer * 32; int* BC = (int*)(a.ws + WS_BC);
    const int fr = lane & 15, fq = lane >> 4;
    { int* rowtok = (int*)(a.ws + WS_ROWTOK); for (int i = bid * NTHREADS + tid; i < ROWS_PAD; i += G * NTHREADS) rowtok[i] = 0; }
    for (int tile = bid; tile < T / 128; tile += G) {
        __syncthreads();
#pragma unroll 1
        for (int i0 = tid; i0 < 32 * 1024; i0 += 16 * NTHREADS) { float wv[16];
#pragma unroll
            for (int j = 0; j < 16; ++j) wv[j] = wre[i0 + j * NTHREADS];
#pragma unroll
            for (int j = 0; j < 16; ++j) { const int i = i0 + j * NTHREADS, k = i >> 5, o = i & 31; const float w = wv[j]; const unsigned short h = f2bf(w); wh[o * 1032 + k] = h; wl[o * 1032 + k] = f2bf(w - bf2f(h)); } }
        { float wv[8];
#pragma unroll
            for (int j = 0; j < 8; ++j) wv[j] = wrg[tid + j * NTHREADS];
#pragma unroll
            for (int j = 0; j < 8; ++j) { const int i = tid + j * NTHREADS, k = i >> 2, o = i & 3; const float w = wv[j]; const unsigned short h = f2bf(w); wh[(32 + o) * 1032 + k] = h; wl[(32 + o) * 1032 + k] = f2bf(w - bf2f(h)); } }
        { const float l0 = a.in[I_LNF][layer * D + tid], l1 = a.in[I_LNF][layer * D + NTHREADS + tid]; lng[tid] = l0; lng[NTHREADS + tid] = l1; }
        if (tid < 32) bias[tid] = a.in[I_BRE][layer * 32 + tid];
        if (tid >= 64 && tid < 68) bias[32 + tid - 64] = a.in[I_BRG][layer * 4 + tid - 64];
        if (tid < 32) lcnt[tid] = 0;
        __syncthreads();
        const int t = tile * 128 + wave * 16 + fr;
        const f32x4* xr = (const f32x4*)(x + (size_t)t * D) + 2 * fq;
        float ss = 0.f;
#pragma unroll 8
        for (int s = 0; s < 32; ++s) { const f32x4 v0 = xr[8 * s], v1 = xr[8 * s + 1]; ss += (v0[0] * v0[0] + v0[1] * v0[1]) + (v0[2] * v0[2] + v0[3] * v0[3]) + (v1[0] * v1[0] + v1[1] * v1[1]) + (v1[2] * v1[2] + v1[3] * v1[3]); }
        ss += __shfl_xor(ss, 16); ss += __shfl_xor(ss, 32);
        const float rstd = rsqrtf(ss * (1.f / D) + EPS);
        f32x4 acc[3];
#pragma unroll
        for (int nt = 0; nt < 3; ++nt) acc[nt] = (f32x4){0.f, 0.f, 0.f, 0.f};
        const int brow2 = (32 + fr) < 36 ? (32 + fr) : 35;
#pragma unroll 2
        for (int s = 0; s < 32; ++s) {
            const f32x4 v0 = xr[8 * s], v1 = xr[8 * s + 1];
            const f32x4 g0 = *(const LAS f32x4*)(lng + 32 * s + 8 * fq), g1 = *(const LAS f32x4*)(lng + 32 * s + 8 * fq + 4);
            float v[8] = {v0[0] * rstd * g0[0], v0[1] * rstd * g0[1], v0[2] * rstd * g0[2], v0[3] * rstd * g0[3], v1[0] * rstd * g1[0], v1[1] * rstd * g1[1], v1[2] * rstd * g1[2], v1[3] * rstd * g1[3]};
            u32x4 hw; hw.x = cvt_pk_bf16(v[0], v[1]); hw.y = cvt_pk_bf16(v[2], v[3]); hw.z = cvt_pk_bf16(v[4], v[5]); hw.w = cvt_pk_bf16(v[6], v[7]);
            *(u32x4*)(xn + (size_t)t * D + 32 * s + 8 * fq) = hw;
            u32x4 lw; lw.x = cvt_pk_bf16(v[0] - lo_bf(hw.x), v[1] - hi_bf(hw.x)); lw.y = cvt_pk_bf16(v[2] - lo_bf(hw.y), v[3] - hi_bf(hw.y)); lw.z = cvt_pk_bf16(v[4] - lo_bf(hw.z), v[5] - hi_bf(hw.z)); lw.w = cvt_pk_bf16(v[6] - lo_bf(hw.w), v[7] - hi_bf(hw.w));
            const bf16x8 ah = __builtin_bit_cast(bf16x8, hw), al = __builtin_bit_cast(bf16x8, lw);
#pragma unroll
            for (int nt = 0; nt < 3; ++nt) {
                const int row = (nt < 2) ? (16 * nt + fr) : brow2;
                const bf16x8 bh = *(const LAS bf16x8*)(wh + row * 1032 + 32 * s + 8 * fq), bl = *(const LAS bf16x8*)(wl + row * 1032 + 32 * s + 8 * fq);
                acc[nt] = mfma16(ah, bh, acc[nt]); acc[nt] = mfma16(al, bh, acc[nt]); acc[nt] = mfma16(ah, bl, acc[nt]);
            }
        }
        __syncthreads();
        {
            LAS float* lw_ = lgs + wave * (16 * 40);
#pragma unroll
            for (int nt = 0; nt < 3; ++nt) { const int o = 16 * nt + fr; if (o < 36) { const float bo = bias[o];
#pragma unroll
                for (int rg = 0; rg < 4; ++rg) lw_[(4 * fq + rg) * 40 + o] = acc[nt][rg] + bo; } }
        }
        asm volatile("s_waitcnt lgkmcnt(0)" ::: "memory");
        if (lane < 16) {
            const LAS float* lg = lgs + wave * (16 * 40) + lane * 40;
            const int tl = wave * 16 + lane, tt = tile * 128 + tl;
            int gi = 0; float gm = lg[32];
            for (int o = 1; o < 4; ++o) { const float lv = lg[32 + o]; if (lv > gm) { gm = lv; gi = o; } }
            float gs = 0.f;
            for (int o = 0; o < 4; ++o) gs += __expf(lg[32 + o] - gm);
            const float grp_p = 1.f / gs;
            const LAS float* le = lg + 8 * gi;
            int e1 = 0; float m1 = le[0];
            for (int k = 1; k < 8; ++k) { const float lv = le[k]; if (lv > m1) { m1 = lv; e1 = k; } }
            int e2 = (e1 == 0) ? 1 : 0; float m2 = le[e2];
            for (int k = 0; k < 8; ++k) { const float lv = le[k]; if (k != e1 && lv > m2) { m2 = lv; e2 = k; } }
            const float p2 = __expf(m2 - m1);
            const float g1 = grp_p / (1.f + p2), g2 = grp_p * p2 / (1.f + p2);
            const int ea = gi * 8 + e1, eb = gi * 8 + e2;
            RE[(size_t)tt * 2] = ea; RE[(size_t)tt * 2 + 1] = eb; RG[(size_t)tt * 2] = g1; RG[(size_t)tt * 2 + 1] = g2;
            tokE[tl * 2] = ea; tokE[tl * 2 + 1] = eb;
            atomicAdd((int*)(lcnt + ea), 1); atomicAdd((int*)(lcnt + eb), 1);
        }
        __syncthreads();
        if (tid < 32) { const int c = lcnt[tid]; BC[tile * 32 + tid] = c; atomicAdd(gcnt + tid, c); }
        if (tid < 256) { const int e = tokE[tid]; int rank = 0; for (int j = 0; j < tid; ++j) rank += (tokE[j] == e) ? 1 : 0; RS[(size_t)tile * 256 + tid] = rank; }
    }
}
__device__ __forceinline__ void moe_tables(const Args& a, int layer, LAS int* tab, int tid) {
    __syncthreads();
    if (tid == 0) {
        const int* gcnt = (const int*)(a.ws + WS_CTL) + layer * 32; int t = 0;
        for (int e = 0; e < 32; ++e) { const int c = __hip_atomic_load(gcnt + e, __ATOMIC_RELAXED, __HIP_MEMORY_SCOPE_AGENT); const int nt = (c + 255) >> 8; tab[e] = t * 256; for (int i = 0; i < nt; ++i) tab[64 + t + i] = e; t += nt; }
        tab[32] = t;
    }
    __syncthreads();
}
__device__ __forceinline__ void moe_scatter(const Args& a, int layer, LAS unsigned char* lds, int bid, int G, int tid, int lane, int wave) {
    LAS int* tab = (LAS int*)(lds + 131072);
    LAS int* psum = (LAS int*)(lds + 131072 + 4096);
    moe_tables(a, layer, tab, tid);
    int* rowtok = (int*)(a.ws + WS_ROWTOK);
    const int* RE = (const int*)(a.ws + WS_RE); const int* RS = (const int*)(a.ws + WS_RS); int* RP = (int*)(a.ws + WS_RP); const int* BC = (const int*)(a.ws + WS_BC);
    for (int tile = bid; tile < T / 128; tile += G) {
        __syncthreads();
        { const int e = tid & 31, part = tid >> 5; int sacc = 0; for (int b2 = part * 16; b2 < part * 16 + 16; ++b2) if (b2 < tile) sacc += BC[b2 * 32 + e]; psum[part * 32 + e] = sacc; }
        __syncthreads();
        if (tid < 32) { int sacc = 0; for (int p2 = 0; p2 < 16; ++p2) sacc += psum[p2 * 32 + tid]; psum[512 + tid] = sacc + tab[tid]; }
        __syncthreads();
        if (tid < 128) {
            const int t = tile * 128 + tid;
            const int e0 = RE[(size_t)t * 2], e1 = RE[(size_t)t * 2 + 1];
            const int r0 = psum[512 + e0] + RS[(size_t)t * 2], r1 = psum[512 + e1] + RS[(size_t)t * 2 + 1];
            RP[(size_t)t * 2] = r0; RP[(size_t)t * 2 + 1] = r1; rowtok[r0] = t; rowtok[r1] = t;
        }
    }
}
__device__ __forceinline__ void moe_gemm1(const Args& a, int layer, LAS unsigned char* lds, int bid, int G, int tid) {
    LAS int* tab = (LAS int*)(lds + 131072);
    moe_tables(a, layer, tab, tid);
    pg8::Gemm g{(const bf16_t*)(a.ws + WS_XN), (const bf16_t*)(a.ws + WS_XB1), D, D, (const int*)(a.ws + WS_ROWTOK)};
    pg8::GroupedOrder S{tab + 64, tab[32], G, bid, 0, D, (size_t)1024 * 1024 * 2};
    pg8::EpiSwiGLU E{(bf16_t*)(a.ws + WS_HID)};
    pg8::gemm_phase<pg8::EpiSwiGLU, pg8::GroupedOrder, true>(lds, g, S, E);
}
__device__ __forceinline__ void moe_gemm2(const Args& a, int layer, LAS unsigned char* lds, int bid, int G, int tid) {
    LAS int* tab = (LAS int*)(lds + 131072);
    moe_tables(a, layer, tab, tid);
    pg8::Gemm g{(const bf16_t*)(a.ws + WS_HID), (const bf16_t*)(a.ws + (layer == 1 ? WS_XB2L1 : WS_XB2)), DEXP, DEXP, nullptr};
    pg8::GroupedOrder S{tab + 64, tab[32], G, bid, DEXP, DEXP, (size_t)1024 * 512 * 2};
    pg8::EpiBf16 E{(bf16_t*)(a.ws + WS_XROWS), D};
    pg8::gemm_phase(lds, g, S, E);
}
template <bool NORM>
__device__ __forceinline__ void moe_combine(const Args& a, const float* gain, bf16_t* hout, int gw, int ngw, int lane) {
    const bf16_t* y = (const bf16_t*)(a.ws + WS_XROWS);
    const int* RP = (const int*)(a.ws + WS_RP); const float* RG = (const float*)(a.ws + WS_RG);
    f32x4 gn[4];
    if (NORM) {
#pragma unroll
        for (int j = 0; j < 4; ++j) gn[j] = *((const f32x4*)gain + lane + 64 * j);
    }
    const int ntok = (T - gw + ngw - 1) / ngw;
    int lp0 = 0, lp1 = 0; float lg0 = 0.f, lg1 = 0.f;
    if (lane < ntok) { const size_t tt = (size_t)(gw + lane * ngw); lp0 = RP[tt * 2]; lp1 = RP[tt * 2 + 1]; lg0 = RG[tt * 2]; lg1 = RG[tt * 2 + 1]; }
    f32x4 xv[4], xn_[4]; u32x2 ya[4], yb[4], yan[4], ybn[4];
#define CMB_LOAD(k, XV, YA, YB) do { const int _p0 = __builtin_amdgcn_readlane(lp0, (k)), _p1 = __builtin_amdgcn_readlane(lp1, (k)); \
        const f32x4* _xr = (const f32x4*)(a.out + (size_t)(gw + (k) * ngw) * D) + lane; const u32x2* _y0 = (const u32x2*)(y + (size_t)_p0 * D) + lane; const u32x2* _y1 = (const u32x2*)(y + (size_t)_p1 * D) + lane; \
        _Pragma("unroll") for (int j = 0; j < 4; ++j) { XV[j] = _xr[64 * j]; YA[j] = _y0[64 * j]; YB[j] = _y1[64 * j]; } } while (0)
    if (ntok > 0) CMB_LOAD(0, xv, ya, yb);
    for (int k = 0; k < ntok; ++k) {
        const int t = gw + k * ngw;
        if (k + 1 < ntok) CMB_LOAD(k + 1, xn_, yan, ybn);
        const float g0 = __builtin_bit_cast(float, __builtin_amdgcn_readlane(__builtin_bit_cast(int, lg0), k)), g1 = __builtin_bit_cast(float, __builtin_amdgcn_readlane(__builtin_bit_cast(int, lg1), k));
        f32x4* xr = (f32x4*)(a.out + (size_t)t * D) + lane;
        f32x4 v[4]; float s = 0.f;
#pragma unroll
        for (int j = 0; j < 4; ++j) { v[j] = xv[j]; const u32x2 a0 = ya[j], a1 = yb[j];
            v[j][0] += g0 * lo_bf(a0.x) + g1 * lo_bf(a1.x); v[j][1] += g0 * hi_bf(a0.x) + g1 * hi_bf(a1.x); v[j][2] += g0 * lo_bf(a0.y) + g1 * lo_bf(a1.y); v[j][3] += g0 * hi_bf(a0.y) + g1 * hi_bf(a1.y);
            xr[64 * j] = v[j]; s += (v[j][0] * v[j][0] + v[j][1] * v[j][1]) + (v[j][2] * v[j][2] + v[j][3] * v[j][3]); }
        if (NORM) {
            const float rstd = rsqrtf(wave_sum(s) * (1.f / D) + EPS);
            unsigned long long* o8 = (unsigned long long*)(hout + (size_t)t * D) + lane;
#pragma unroll
            for (int j = 0; j < 4; ++j) { const f32x4 w = v[j] * rstd * gn[j]; o8[64 * j] = (unsigned long long)cvt_pk_bf16(w[0], w[1]) | ((unsigned long long)cvt_pk_bf16(w[2], w[3]) << 32); }
        }
#pragma unroll
        for (int j = 0; j < 4; ++j) { xv[j] = xn_[j]; ya[j] = yan[j]; yb[j] = ybn[j]; }
    }
#undef CMB_LOAD
}


__device__ __forceinline__ Args load_args() {
#if defined(__HIP_DEVICE_COMPILE__)
    const __attribute__((address_space(4))) Args* kap = (const __attribute__((address_space(4))) Args*)__builtin_amdgcn_kernarg_segment_ptr(); asm volatile("" : "+s"(kap));
    Args a;
#pragma unroll
    for (int i = 0; i < 22; ++i) a.in[i] = kap->in[i];
    a.out = kap->out; a.ws = kap->ws; a.ph_lo = kap->ph_lo; a.ph_hi = kap->ph_hi; return a;
#else
    return Args{};
#endif
}
constexpr int NPHASE = 20;
#define PHASE_IDS int tid_o = threadIdx.x; asm volatile("" : "+v"(tid_o)); const int tid = tid_o, lane = tid & 63, wave = __builtin_amdgcn_readfirstlane(tid >> 6); const int gw = bid * NWAVES + wave; (void)gw; (void)lane; \
    const Args args = load_args(); unsigned char* const ws = args.ws; (void)ws
#ifndef PHHI
#define PHHI NPHASE
#endif

__global__ void __launch_bounds__(NTHREADS, 2) fwd_kernel(Args args_) {
    extern __shared__ __attribute__((aligned(16))) unsigned char lds_raw[];
    LAS unsigned char* lds = (LAS unsigned char*)lds_raw;
    const int tid = threadIdx.x, lane = tid & 63, wave = __builtin_amdgcn_readfirstlane(tid >> 6);
    const int G = gridDim.x, bid = blockIdx.x;
    const int gw = bid * NWAVES + wave, ngw = G * NWAVES;
    unsigned char* ws = args_.ws;
    const int lo = args_.ph_lo, hi = args_.ph_hi;
    cg::grid_group grid = cg::this_grid();
    if (tid < 4) ((LAS unsigned*)(lds + LDS_BYTES - 16))[tid] = 0u;
    __syncthreads();
    const XcdBarrier xbar = xcd_barrier_post((unsigned*)(ws + WS_CTL) + 1024, (volatile LAS unsigned*)(lds + LDS_BYTES - 16));
    if (lo < 0) grid.sync();
#ifndef ONLYP
#define ONLYP -1
#endif
#define IN(k) ((ONLYP < 0 || ONLYP == (k)) && lo <= (k) && (k) < hi)
#ifndef SKIPLO
#define SKIPLO 100
#define SKIPHI 100
#endif
#define RUN(k) (IN(k) && !((k) >= SKIPLO && (k) <= SKIPHI))
#define SEAM(k) do { if (IN(k) && IN((k) + 1)) xcd_barrier(xbar); else __syncthreads(); } while (0)

    if (RUN(0)) { PHASE_IDS;
        LAS float* scr = (LAS float*)(lds + wave * 8448);
        {
            constexpr int I0 = (D / 64) * (N0 / 32);
            for (int it = gw; it < I0; it += ngw) transpose_item(args.in[I_WINE], D, EVEN_IN, N0, (bf16_t*)(ws + WS_WIN0), 0, scr, it, lane);
        }
        LAS float* wab = (LAS float*)(lds + 72 * 1024);
        __syncthreads();
        { float wv[16];
#pragma unroll
            for (int j = 0; j < 16; ++j) { const int i = tid + j * NTHREADS; wv[j] = args.in[I_WINE][(size_t)(i >> 3) * EVEN_IN + N0 + (i & 7)]; }
#pragma unroll
            for (int j = 0; j < 16; ++j) { const int i = tid + j * NTHREADS; wab[(i & 7) * 1024 + (i >> 3)] = wv[j]; } }
        __syncthreads();
        const float* x = args.in[I_X]; const float* gain = args.in[I_LNE];
        bf16_t* h0 = (bf16_t*)(ws + WS_HMIX0); float* bab = (float*)(ws + WS_BAB);
        f32x4 gn[4];
#pragma unroll
        for (int j = 0; j < 4; ++j) gn[j] = *((const f32x4*)gain + lane + 64 * j);
        for (int m = gw; m < T; m += ngw) {
            const f32x4* xr = (const f32x4*)(x + (size_t)m * D) + lane;
            f32x4 v[4]; float s = 0.f;
#pragma unroll
            for (int j = 0; j < 4; ++j) { v[j] = xr[64 * j]; s += (v[j][0] * v[j][0] + v[j][1] * v[j][1]) + (v[j][2] * v[j][2] + v[j][3] * v[j][3]); }
            const float rstd = rsqrtf(wave_sum(s) * (1.f / D) + EPS);
            float p[8];
#pragma unroll
            for (int o = 0; o < 8; ++o) p[o] = 0.f;
            unsigned long long* o8 = (unsigned long long*)(h0 + (size_t)m * D) + lane;
#pragma unroll
            for (int j = 0; j < 4; ++j) { v[j] = v[j] * rstd * gn[j];
                o8[64 * j] = (unsigned long long)cvt_pk_bf16(v[j][0], v[j][1]) | ((unsigned long long)cvt_pk_bf16(v[j][2], v[j][3]) << 32);
#pragma unroll
                for (int o = 0; o < 8; ++o) { const f32x4 w = *((const LAS f32x4*)(wab + o * 1024) + lane + 64 * j); p[o] += (v[j][0] * w[0] + v[j][1] * w[1]) + (v[j][2] * w[2] + v[j][3] * w[3]); } }
#pragma unroll
            for (int o = 0; o < 8; ++o) p[o] = wave_sum(p[o]);
            if (lane == 0) { *(f32x4*)(bab + (size_t)m * 8) = (f32x4){p[0], p[1], p[2], p[3]}; *(f32x4*)(bab + (size_t)m * 8 + 4) = (f32x4){p[4], p[5], p[6], p[7]}; }
        }
    }
    SEAM(0);

    if (RUN(1)) { PHASE_IDS;
        pg8::Gemm g{(const bf16_t*)(ws + WS_HMIX0), (const bf16_t*)(ws + WS_WIN0), D, D, nullptr};
        pg8::DenseOrder S; S.init(T, N0, G, bid, D, D);
        pg8::EpiBf16 E{(bf16_t*)(ws + WS_PROJ0), N0};
        pg8::gemm_phase(lds, g, S, E);
        {
            const int nfull = ((T / 256) * (N0 / 256)) % G;
            if (bid >= nfull) {
                asm volatile("s_waitcnt vmcnt(0) lgkmcnt(0)" ::: "memory"); __syncthreads();
                convert_moe(args, 1, (LAS float*)(lds + wave * 8448), (bid - nfull) * NWAVES + wave, (G - nfull) * NWAVES, lane, 2);
            }
        }
    }
    SEAM(1);

    if (RUN(2)) { PHASE_IDS;
        const bf16_t* proj0 = (const bf16_t*)(ws + WS_PROJ0);
        const float* bab = (const float*)(ws + WS_BAB);
        bf16_t* gUT = (bf16_t*)(ws + WS_GU); bf16_t* gW = (bf16_t*)(ws + WS_GW); bf16_t* gQD = (bf16_t*)(ws + WS_GQD); bf16_t* gKDT = (bf16_t*)(ws + WS_GKDT); bf16_t* gA = (bf16_t*)(ws + WS_GA);
        float* gGL = (float*)(ws + WS_GL);
        LAS bf16_t* Kb = (LAS bf16_t*)(lds);
        LAS bf16_t* Qb = (LAS bf16_t*)(lds + 17408);
        LAS bf16_t* Rb = (LAS bf16_t*)(lds + 34816);
        LAS float* Lm = (LAS float*)(lds + 68608);
        LAS bf16_t* raw = (LAS bf16_t*)(lds + 84992);
        LAS float* cw = (LAS float*)(lds + 137520);
        LAS float* gcs = (LAS float*)(lds + 162096);
        LAS float* bts = gcs + 64;
        const int fr = lane & 15, fq = lane >> 4;
        { float wv[12];
#pragma unroll
            for (int j = 0; j < 12; ++j) wv[j] = args.in[I_CONVW][tid + j * NTHREADS];
#pragma unroll
            for (int j = 0; j < 12; ++j) cw[tid + j * NTHREADS] = wv[j]; }
        const float alog_e[4] = {-__expf(args.in[I_ALOG][0]), -__expf(args.in[I_ALOG][1]), -__expf(args.in[I_ALOG][2]), -__expf(args.in[I_ALOG][3])};
        const float dtb[4] = {args.in[I_DTB][0], args.in[I_DTB][1], args.in[I_DTB][2], args.in[I_DTB][3]};
        u32x4 praw[7]; float pa_ = 0.f, pb_ = 0.f;
#define P2_PREFETCH(itm) do { const int _b = (itm) >> 8, _n = ((itm) >> 2) & 63, _h = (itm) & 3; \
            _Pragma("unroll") for (int i7 = 0; i7 < 7; ++i7) { const int idx = tid + NTHREADS * i7; const int row = idx / 48, rem = idx - row * 48, part = rem >> 4, ch = rem & 15; const int srow = _n * 64 - 3 + row; \
                praw[i7] = (u32x4){0u, 0u, 0u, 0u}; \
                if (idx < 67 * 48 && srow >= 0) praw[i7] = *(const u32x4*)(proj0 + (size_t)(_b * SEQ + srow) * N0 + 768 + part * 512 + _h * 128 + ch * 8); } \
            if (wave == 0) { const int t = _b * SEQ + _n * 64 + lane; pa_ = bab[(size_t)t * 8 + _h]; pb_ = bab[(size_t)t * 8 + 4 + _h]; } } while (0)
        const int npb = G - 32;
        int* ready = (int*)(ws + WS_CTL + 32768);
#define P2_ITEM(q) ((((((q) & 31) >> 2) * 64 + ((q) >> 5)) * 4) + ((q) & 3))
        if (bid >= 32) P2_PREFETCH(P2_ITEM(bid - 32));
        __syncthreads();
        int pend = -1, pend2 = -1, held = -1;
        for (int q = bid - 32; bid >= 32 && q < 2048; q += npb) {
            const int item = P2_ITEM(q);
            const int h = item & 3;
#pragma unroll
            for (int i7 = 0; i7 < 7; ++i7) { const int idx = tid + NTHREADS * i7; const int row = idx / 48, rem = idx - row * 48; if (idx < 67 * 48) *(LAS u32x4*)(raw + row * 392 + rem * 8) = praw[i7]; }
            if (wave == 0) {
                const float a = pa_ + (h == 0 ? dtb[0] : h == 1 ? dtb[1] : h == 2 ? dtb[2] : dtb[3]);
                const float sp = fmaxf(a, 0.f) + log1pf(__expf(-fabsf(a)));
                float gv = (h == 0 ? alog_e[0] : h == 1 ? alog_e[1] : h == 2 ? alog_e[2] : alog_e[3]) * sp;
#pragma unroll
                for (int o = 1; o < 64; o <<= 1) { const float y = __shfl_up(gv, o); if (lane >= o) gv += y; }
                gcs[lane] = gv; bts[lane] = sigmoid_f(pb_);
            }
            __syncthreads();
            if (q + npb < 2048) P2_PREFETCH(P2_ITEM(q + npb));
            {
                const int r = tid >> 3, d0 = (tid & 7) * 16;
                const float gc = gcs[r], beta = bts[r], glast = gcs[63];
                const float eg = __expf(gc), ekd = __expf(glast - gc);
#define P2_CONV(P, OUT) do { float acc[16]; _Pragma("unroll") for (int d = 0; d < 16; ++d) acc[d] = 0.f; \
                    _Pragma("unroll") for (int j = 0; j < 4; ++j) { \
                        const LAS u32x4* px = (const LAS u32x4*)(raw + (r + j) * 392 + (P) * 128 + d0); const u32x4 x0 = px[0], x1 = px[1]; \
                        const LAS f32x4* pw = (const LAS f32x4*)(cw + j * 1536 + (P) * 512 + h * 128 + d0); const f32x4 w0 = pw[0], w1 = pw[1], w2 = pw[2], w3 = pw[3]; \
                        acc[0] += w0[0] * lo_bf(x0.x); acc[1] += w0[1] * hi_bf(x0.x); acc[2] += w0[2] * lo_bf(x0.y); acc[3] += w0[3] * hi_bf(x0.y); \
                        acc[4] += w1[0] * lo_bf(x0.z); acc[5] += w1[1] * hi_bf(x0.z); acc[6] += w1[2] * lo_bf(x0.w); acc[7] += w1[3] * hi_bf(x0.w); \
                        acc[8] += w2[0] * lo_bf(x1.x); acc[9] += w2[1] * hi_bf(x1.x); acc[10] += w2[2] * lo_bf(x1.y); acc[11] += w2[3] * hi_bf(x1.y); \
                        acc[12] += w3[0] * lo_bf(x1.z); acc[13] += w3[1] * hi_bf(x1.z); acc[14] += w3[2] * lo_bf(x1.w); acc[15] += w3[3] * hi_bf(x1.w); } \
                    _Pragma("unroll") for (int d = 0; d < 16; ++d) OUT[d] = silu_f(acc[d]); } while (0)
#define P2_PACK(W0, W1, X, SC) do { W0.x = cvt_pk_bf16(X[0] * (SC), X[1] * (SC)); W0.y = cvt_pk_bf16(X[2] * (SC), X[3] * (SC)); W0.z = cvt_pk_bf16(X[4] * (SC), X[5] * (SC)); W0.w = cvt_pk_bf16(X[6] * (SC), X[7] * (SC)); \
                    W1.x = cvt_pk_bf16(X[8] * (SC), X[9] * (SC)); W1.y = cvt_pk_bf16(X[10] * (SC), X[11] * (SC)); W1.z = cvt_pk_bf16(X[12] * (SC), X[13] * (SC)); W1.w = cvt_pk_bf16(X[14] * (SC), X[15] * (SC)); } while (0)
                u32x4 w0_, w1_;
                {
                    float kk[16]; P2_CONV(1, kk);
                    float sk = 0.f;
#pragma unroll
                    for (int d = 0; d < 16; ++d) sk += kk[d] * kk[d];
                    sk += __shfl_xor(sk, 1); sk += __shfl_xor(sk, 2); sk += __shfl_xor(sk, 4);
                    const float kinv = rsqrtf(sk + EPS);
                    P2_PACK(w0_, w1_, kk, kinv); *(LAS u32x4*)(Kb + r * 136 + d0) = w0_; *(LAS u32x4*)(Kb + r * 136 + d0 + 8) = w1_;
                    P2_PACK(w0_, w1_, kk, kinv * beta * eg); *(LAS u32x4*)(Rb + r * 264 + 128 + d0) = w0_; *(LAS u32x4*)(Rb + r * 264 + 128 + d0 + 8) = w1_;
                    const float ks = kinv * ekd;
#pragma unroll
                    for (int d = 0; d < 16; ++d) gKDT[((size_t)item * 128 + d0 + d) * 64 + ((r & 32) | pg8::perm32(r & 31))] = f2bf(kk[d] * ks);
                }
                __builtin_amdgcn_sched_barrier(0);
                {
                    float qq[16]; P2_CONV(0, qq);
                    float sq = 0.f;
#pragma unroll
                    for (int d = 0; d < 16; ++d) sq += qq[d] * qq[d];
                    sq += __shfl_xor(sq, 1); sq += __shfl_xor(sq, 2); sq += __shfl_xor(sq, 4);
                    const float qinv = rsqrtf(sq + EPS) * 0.08838834764831845f;
                    P2_PACK(w0_, w1_, qq, qinv); *(LAS u32x4*)(Qb + r * 136 + d0) = w0_; *(LAS u32x4*)(Qb + r * 136 + d0 + 8) = w1_;
                    P2_PACK(w0_, w1_, qq, qinv * eg); { bf16_t* pqd = gQD + ((size_t)item * 64 + r) * 128 + (d0 & ~31) + 4 * ((d0 >> 4) & 1); *(u32x2*)(pqd) = (u32x2){w0_.x, w0_.y}; *(u32x2*)(pqd + 8) = (u32x2){w0_.z, w0_.w}; *(u32x2*)(pqd + 16) = (u32x2){w1_.x, w1_.y}; *(u32x2*)(pqd + 24) = (u32x2){w1_.z, w1_.w}; }
                }
                __builtin_amdgcn_sched_barrier(0);
                {
                    float vv[16]; P2_CONV(2, vv);
                    P2_PACK(w0_, w1_, vv, beta); *(LAS u32x4*)(Rb + r * 264 + d0) = w0_; *(LAS u32x4*)(Rb + r * 264 + d0 + 8) = w1_;
                }
#undef P2_CONV
#undef P2_PACK
                if (tid == 0) gGL[(size_t)item * 32] = __expf(glast);
            }
            __syncthreads();
            u32x4 gz0, gz1;
            bf16_t* const pgz = (bf16_t*)(ws + WS_PROJ0) + (size_t)((item >> 8) * SEQ + ((item >> 2) & 63) * 64 + (tid >> 3)) * N0 + 2304 + h * 128 + (tid & 7) * 16;
            { const u32x4* pz = (const u32x4*)pgz; gz0 = pz[0]; gz1 = pz[1]; }
            {
                const int which = wave >> 2, mt = wave & 3;
                const LAS bf16_t* X = which ? Qb : Kb;
                for (int nt = 0; nt < 4; ++nt) {
                    f32x4 acc = (f32x4){0.f, 0.f, 0.f, 0.f};
                    if (nt <= mt) {
#pragma unroll
                        for (int s4 = 0; s4 < 4; ++s4) {
                            const bf16x8 af = *(const LAS bf16x8*)(X + (16 * mt + fr) * 136 + 32 * s4 + 8 * fq);
                            const bf16x8 bfr = *(const LAS bf16x8*)(Kb + (16 * nt + fr) * 136 + 32 * s4 + 8 * fq);
                            acc = mfma16(af, bfr, acc);
                        }
                    }
                    const int j = 16 * nt + fr; const float gj = gcs[j];
#pragma unroll
                    for (int rg = 0; rg < 4; ++rg) {
                        const int i = 16 * mt + 4 * fq + rg;
                        const float dec = __expf(fminf(gcs[i] - gj, 0.f));
                        if (which == 0) Lm[i * 64 + j] = (i > j) ? -(bts[i] * acc[rg] * dec) : 0.f;
                        else gA[((size_t)item * 64 + i) * 64 + ((j & 32) | pg8::perm32(j & 31))] = f2bf((i >= j) ? acc[rg] * dec : 0.f);
                    }
                }
            }
            {
                const float* gng = args.in[I_GDNG] + (tid & 7) * 16;
                unsigned zw[8] = {gz0.x, gz0.y, gz0.z, gz0.w, gz1.x, gz1.y, gz1.z, gz1.w};
#pragma unroll
                for (int d = 0; d < 8; ++d) zw[d] = cvt_pk_bf16(gng[2 * d] * silu_f(lo_bf(zw[d])), gng[2 * d + 1] * silu_f(hi_bf(zw[d])));
                u32x4* po = (u32x4*)pgz; po[0] = (u32x4){zw[0], zw[1], zw[2], zw[3]}; po[1] = (u32x4){zw[4], zw[5], zw[6], zw[7]};
            }
            __syncthreads();
            if (tid < 256) {
                const int c = tid, l16 = lane & 15;
                float U[64];
                int ln[4] = {0, 0, 0, 0};
                ln[0] = __builtin_bit_cast(int, Lm[64 + l16]);
                U[0] = bf2f((unsigned)Rb[c]);
                solve_rows(U, ln, Lm, (const LAS unsigned short*)Rb, l16, c, std::make_integer_sequence<int, 63>{});
                if (c < 128) {
                    u32x4* pu = (u32x4*)(gUT + ((size_t)item * 128 + c) * 64);
#pragma unroll
                    for (int i8 = 0; i8 < 8; ++i8) { u32x4 o; o.x = cvt_pk_bf16(U[8 * i8], U[8 * i8 + 1]); o.y = cvt_pk_bf16(U[8 * i8 + 2], U[8 * i8 + 3]); o.z = cvt_pk_bf16(U[8 * i8 + 4], U[8 * i8 + 5]); o.w = cvt_pk_bf16(U[8 * i8 + 6], U[8 * i8 + 7]); pu[i8] = o; }
                } else {
#pragma unroll
                    for (int i = 0; i < 64; ++i) gW[((size_t)item * 64 + i) * 128 + (((c - 128) & ~31) | pg8::perm32((c - 128) & 31))] = f2bf(U[i]);
                }
            }
            else if (tid == 448 && pend >= 0) {
                asm volatile("s_waitcnt vmcnt(0)" ::: "memory");
                __hip_atomic_store(ready + pend, 1, __ATOMIC_RELAXED, __HIP_MEMORY_SCOPE_AGENT);
                if (pend2 >= 0) __hip_atomic_store(ready + pend2, 1, __ATOMIC_RELAXED, __HIP_MEMORY_SCOPE_AGENT);
            }
            pend = -1; pend2 = -1;
            asm volatile("s_waitcnt vmcnt(0)" ::: "memory");
            __syncthreads();
            if (held >= 0 || q + npb >= 2048) { if (tid == 448) asm volatile("buffer_wbl2 sc1" ::: "memory"); pend = item; pend2 = held; held = -1; }
            else held = item;
        }
        if (tid == 448 && pend >= 0) { asm volatile("s_waitcnt vmcnt(0)" ::: "memory"); __hip_atomic_store(ready + pend, 1, __ATOMIC_RELAXED, __HIP_MEMORY_SCOPE_AGENT); if (pend2 >= 0) __hip_atomic_store(ready + pend2, 1, __ATOMIC_RELAXED, __HIP_MEMORY_SCOPE_AGENT); }
#undef P2_PREFETCH
#undef P2_ITEM
    }
    __syncthreads();

    if (RUN(3)) { PHASE_IDS;
        const bf16_t* proj0 = (const bf16_t*)(ws + WS_PROJ0);
        bf16_t* mix0 = (bf16_t*)(ws + WS_HMIX0);
        const int fr = lane & 15, fq = lane >> 4;
        if (bid < 32) {
            const bf16_t* gUT = (const bf16_t*)(ws + WS_GU); const bf16_t* gW = (const bf16_t*)(ws + WS_GW); const bf16_t* gQD = (const bf16_t*)(ws + WS_GQD); const bf16_t* gKDT = (const bf16_t*)(ws + WS_GKDT); const bf16_t* gA = (const bf16_t*)(ws + WS_GA);
            const float* gGL = (const float*)(ws + WS_GL);
            const int b = bid >> 2, h = bid & 3;
            constexpr int BUFB = 62464;
            LAS bf16_t* Obuf0 = (LAS bf16_t*)(lds + 2 * BUFB);
            const int wrow0 = tid >> 4, wch = tid & 15;
            const int krow0 = tid >> 3, kch = tid & 7;
            u32x4 pw[2], pq[2], pk[2], pa;
            u32x2 pu[4], pun[4]; u32x4 pz0, pz1; float glv, glvn = 0.f;
            f32x4 Sacc[8];
#pragma unroll
            for (int k = 0; k < 8; ++k) Sacc[k] = (f32x4){0.f, 0.f, 0.f, 0.f};
            LAS float* gnl = (LAS float*)(lds + 2 * BUFB + 2 * 17408);
            if (tid < 128) gnl[tid] = args.in[I_GDNG][tid];
#define GDN_LOAD(itm) do { const size_t _it = (size_t)(itm); \
                pw[0] = *(const u32x4*)(gW + (_it * 64 + wrow0) * 128 + wch * 8); pw[1] = *(const u32x4*)(gW + (_it * 64 + wrow0 + 32) * 128 + wch * 8); \
                pq[0] = *(const u32x4*)(gQD + (_it * 64 + wrow0) * 128 + wch * 8); pq[1] = *(const u32x4*)(gQD + (_it * 64 + wrow0 + 32) * 128 + wch * 8); \
                pk[0] = *(const u32x4*)(gKDT + (_it * 128 + krow0) * 64 + kch * 8); pk[1] = *(const u32x4*)(gKDT + (_it * 128 + krow0 + 64) * 64 + kch * 8); \
                pa = *(const u32x4*)(gA + (_it * 64 + krow0) * 64 + kch * 8); } while (0)
#define GDN_LOAD2(itm, U, GLV) do { const size_t _it = (size_t)(itm); \
                _Pragma("unroll") for (int mt = 0; mt < 4; ++mt) U[mt] = *(const u32x2*)(gUT + (_it * 128 + 16 * wave + fr) * 64 + 16 * mt + 4 * fq); \
                GLV = gGL[_it * 32]; } while (0)
#define GDN_STORE(bufi) do { LAS bf16_t* _W = (LAS bf16_t*)(lds + (bufi) * BUFB); LAS bf16_t* _Q = _W + 64 * 136; LAS bf16_t* _K = _Q + 64 * 136; LAS bf16_t* _A = _K + 128 * 72; \
                *(LAS u32x4*)(_W + wrow0 * 136 + wch * 8) = pw[0]; *(LAS u32x4*)(_W + (wrow0 + 32) * 136 + wch * 8) = pw[1]; \
                *(LAS u32x4*)(_Q + wrow0 * 136 + wch * 8) = pq[0]; *(LAS u32x4*)(_Q + (wrow0 + 32) * 136 + wch * 8) = pq[1]; \
                *(LAS u32x4*)(_K + krow0 * 72 + kch * 8) = pk[0]; *(LAS u32x4*)(_K + (krow0 + 64) * 72 + kch * 8) = pk[1]; \
                *(LAS u32x4*)(_A + krow0 * 72 + kch * 8) = pa; } while (0)
            const int* ready = (const int*)(ws + WS_CTL + 32768);
#define GDN_WAIT(c0, cnt) do { if (wave == 0) { if (lane < (cnt)) { const int* f = ready + (((b * 64 + (c0) + lane) * 4) + h); while (__hip_atomic_load(f, __ATOMIC_RELAXED, __HIP_MEMORY_SCOPE_AGENT) == 0) __builtin_amdgcn_s_sleep(4); } \
                __builtin_amdgcn_fence(__ATOMIC_ACQUIRE, "agent"); asm volatile("s_waitcnt vmcnt(0)" ::: "memory"); } __syncthreads(); } while (0)
            GDN_WAIT(0, 5);
            GDN_LOAD((b * 64 + 0) * 4 + h); GDN_STORE(0);
            GDN_LOAD2((b * 64 + 0) * 4 + h, pu, glv);
            __syncthreads();
            for (int n = 0; n < 64; ++n) {
                if (n > 0 && (n & 3) == 0 && n + 1 < 64) GDN_WAIT(n + 1, (n + 5 <= 64) ? 4 : (63 - n));
                const int item = (b * 64 + n) * 4 + h, cur = n & 1;
                const int t0 = b * SEQ + n * 64;
                const LAS bf16_t* Wl = (const LAS bf16_t*)(lds + cur * BUFB); const LAS bf16_t* Ql = Wl + 64 * 136; const LAS bf16_t* Kl = Ql + 64 * 136; const LAS bf16_t* Al = Kl + 128 * 72;
                LAS bf16_t* Obuf = Obuf0 + cur * (64 * 136);
                if (n + 1 < 64) { GDN_LOAD(item + 4); GDN_LOAD2(item + 4, pun, glvn); }
                { const u32x4* pz = (const u32x4*)(proj0 + (size_t)(t0 + (tid >> 3)) * N0 + 2304 + h * 128 + (tid & 7) * 16); pz0 = pz[0]; pz1 = pz[1]; }
                bf16x8 Sb[4];
#pragma unroll
                for (int s = 0; s < 4; ++s) Sb[s] = mk8f(Sacc[2 * s], Sacc[2 * s + 1]);
                f32x4 WS[4], QS[4];
#pragma unroll
                for (int mt = 0; mt < 4; ++mt) { WS[mt] = (f32x4){0.f, 0.f, 0.f, 0.f}; QS[mt] = (f32x4){0.f, 0.f, 0.f, 0.f}; }
                {
                    bf16x8 wfr[2][4], qfr[2][4];
#define GDN_FRAGS(bufi, mt_) do { _Pragma("unroll") for (int s = 0; s < 4; ++s) { wfr[bufi][s] = *(const LAS bf16x8*)(Wl + (16 * (mt_) + fr) * 136 + 32 * s + 8 * fq); \
                        qfr[bufi][s] = *(const LAS bf16x8*)(Ql + (16 * (mt_) + fr) * 136 + 32 * s + 8 * fq); } } while (0)
                    GDN_FRAGS(0, 0);
#pragma unroll
                    for (int mt = 0; mt < 4; ++mt) {
                        if (mt + 1 < 4) GDN_FRAGS((mt + 1) & 1, mt + 1);
                        __builtin_amdgcn_sched_barrier(0);
#pragma unroll
                        for (int s = 0; s < 4; ++s) { WS[mt] = mfma16(wfr[mt & 1][s], Sb[s], WS[mt]); QS[mt] = mfma16(qfr[mt & 1][s], Sb[s], QS[mt]); }
                        __builtin_amdgcn_sched_barrier(0);
                    }
#undef GDN_FRAGS
                }
                bf16x8 afr[8], kfa[8], kfb[8];
#define GDN_KFR(dst, kt0) do { _Pragma("unroll") for (int k4 = 0; k4 < 4; ++k4) _Pragma("unroll") for (int s2 = 0; s2 < 2; ++s2) dst[k4 * 2 + s2] = *(const LAS bf16x8*)(Kl + (16 * ((kt0) + k4) + fr) * 72 + 32 * s2 + 8 * fq); } while (0)
#pragma unroll
                for (int mt = 0; mt < 4; ++mt)
#pragma unroll
                    for (int s2 = 0; s2 < 2; ++s2) afr[mt * 2 + s2] = *(const LAS bf16x8*)(Al + (16 * mt + fr) * 72 + 32 * s2 + 8 * fq);
                GDN_KFR(kfa, 0);
                __builtin_amdgcn_sched_barrier(0);
                f32x4 vn[4];
#pragma unroll
                for (int mt = 0; mt < 4; ++mt) { vn[mt][0] = lo_bf(pu[mt].x) - WS[mt][0]; vn[mt][1] = hi_bf(pu[mt].x) - WS[mt][1]; vn[mt][2] = lo_bf(pu[mt].y) - WS[mt][2]; vn[mt][3] = hi_bf(pu[mt].y) - WS[mt][3]; }
                bf16x8 Vb[2];
                Vb[0] = mk8f(vn[0], vn[1]); Vb[1] = mk8f(vn[2], vn[3]);
#pragma unroll
                for (int kt = 0; kt < 8; ++kt) Sacc[kt] = Sacc[kt] * glv;
                __builtin_amdgcn_sched_barrier(0);
#pragma unroll
                for (int k4 = 0; k4 < 4; ++k4)
#pragma unroll
                    for (int s2 = 0; s2 < 2; ++s2) Sacc[k4] = mfma16(kfa[k4 * 2 + s2], Vb[s2], Sacc[k4]);
                GDN_KFR(kfb, 4);
                __builtin_amdgcn_sched_barrier(0);
#pragma unroll
                for (int mt = 0; mt < 4; ++mt)
#pragma unroll
                    for (int s2 = 0; s2 < 2; ++s2) QS[mt] = mfma16(afr[mt * 2 + s2], Vb[s2], QS[mt]);
                __builtin_amdgcn_sched_barrier(0);
#pragma unroll
                for (int k4 = 0; k4 < 4; ++k4)
#pragma unroll
                    for (int s2 = 0; s2 < 2; ++s2) Sacc[4 + k4] = mfma16(kfb[k4 * 2 + s2], Vb[s2], Sacc[4 + k4]);
#undef GDN_KFR
#pragma unroll
                for (int mt = 0; mt < 4; ++mt)
#pragma unroll
                    for (int rg = 0; rg < 4; ++rg) Obuf[(16 * mt + 4 * fq + rg) * 136 + 16 * wave + fr] = f2bf(QS[mt][rg]);
                if (n + 1 < 64) GDN_STORE(cur ^ 1);
                __syncthreads();
                {
                    const int r = tid >> 3, c0 = (tid & 7) * 16;
                    const u32x4 o0 = *(const LAS u32x4*)(Obuf + r * 136 + c0), o1 = *(const LAS u32x4*)(Obuf + r * 136 + c0 + 8);
                    float ov[16], zv[16];
                    ov[0] = lo_bf(o0.x); ov[1] = hi_bf(o0.x); ov[2] = lo_bf(o0.y); ov[3] = hi_bf(o0.y); ov[4] = lo_bf(o0.z); ov[5] = hi_bf(o0.z); ov[6] = lo_bf(o0.w); ov[7] = hi_bf(o0.w);
                    ov[8] = lo_bf(o1.x); ov[9] = hi_bf(o1.x); ov[10] = lo_bf(o1.y); ov[11] = hi_bf(o1.y); ov[12] = lo_bf(o1.z); ov[13] = hi_bf(o1.z); ov[14] = lo_bf(o1.w); ov[15] = hi_bf(o1.w);
                    float ss = 0.f;
#pragma unroll
                    for (int d = 0; d < 16; ++d) ss += ov[d] * ov[d];
                    ss += __shfl_xor(ss, 1); ss += __shfl_xor(ss, 2); ss += __shfl_xor(ss, 4);
                    const float rstd = rsqrtf(ss * (1.f / 128.f) + EPS);
                    zv[0] = lo_bf(pz0.x); zv[1] = hi_bf(pz0.x); zv[2] = lo_bf(pz0.y); zv[3] = hi_bf(pz0.y); zv[4] = lo_bf(pz0.z); zv[5] = hi_bf(pz0.z); zv[6] = lo_bf(pz0.w); zv[7] = hi_bf(pz0.w);
                    zv[8] = lo_bf(pz1.x); zv[9] = hi_bf(pz1.x); zv[10] = lo_bf(pz1.y); zv[11] = hi_bf(pz1.y); zv[12] = lo_bf(pz1.z); zv[13] = hi_bf(pz1.z); zv[14] = lo_bf(pz1.w); zv[15] = hi_bf(pz1.w);
#pragma unroll
                    for (int d = 0; d < 16; ++d) ov[d] = ov[d] * rstd * zv[d];
                    u32x4 w0, w1;
                    w0.x = cvt_pk_bf16(ov[0], ov[1]); w0.y = cvt_pk_bf16(ov[2], ov[3]); w0.z = cvt_pk_bf16(ov[4], ov[5]); w0.w = cvt_pk_bf16(ov[6], ov[7]);
                    w1.x = cvt_pk_bf16(ov[8], ov[9]); w1.y = cvt_pk_bf16(ov[10], ov[11]); w1.z = cvt_pk_bf16(ov[12], ov[13]); w1.w = cvt_pk_bf16(ov[14], ov[15]);
                    u32x4* po = (u32x4*)(mix0 + (size_t)(t0 + r) * D + 512 + h * 128 + c0); po[0] = w0; po[1] = w1;
                }
#pragma unroll
                for (int mt = 0; mt < 4; ++mt) pu[mt] = pun[mt];
                glv = glvn;
            }
#undef GDN_LOAD2
#undef GDN_WAIT
#undef GDN_LOAD
#undef GDN_STORE
        } else {
            LAS bf16_t* Ks = (LAS bf16_t*)(lds);
            LAS bf16_t* Vt = (LAS bf16_t*)(lds + 27648);
            const float* qgain = args.in[I_QG]; const float* kgain = args.in[I_KG];
            const int nbk = G - 32;
            for (int it = bid - 32; it < 1024; it += nbk) {
                const int b = it >> 7, qb = (it >> 1) & 63, hk = it & 1;
                const int t0 = b * SEQ + qb * 64;
                __syncthreads();
#pragma unroll
                for (int i3 = 0; i3 < 3; ++i3) {
                    const int task = tid + NTHREADS * i3, key = task >> 3, dg = task & 7;
                    const int kp = qb * 64 - 128 + key;
                    u32x4 kr = (u32x4){0u, 0u, 0u, 0u}, vr = (u32x4){0u, 0u, 0u, 0u};
                    if (kp >= 0) { const bf16_t* pr = proj0 + (size_t)(b * SEQ + kp) * N0 + hk * 64 + 8 * dg; kr = *(const u32x4*)(pr + 512); vr = *(const u32x4*)(pr + 640); }
                    float kv[8];
                    kv[0] = lo_bf(kr.x); kv[1] = hi_bf(kr.x); kv[2] = lo_bf(kr.y); kv[3] = hi_bf(kr.y); kv[4] = lo_bf(kr.z); kv[5] = hi_bf(kr.z); kv[6] = lo_bf(kr.w); kv[7] = hi_bf(kr.w);
                    float ss = 0.f;
#pragma unroll
                    for (int i = 0; i < 8; ++i) ss += kv[i] * kv[i];
                    ss += __shfl_xor(ss, 1); ss += __shfl_xor(ss, 2); ss += __shfl_xor(ss, 4);
                    const float rstd = rsqrtf(ss * (1.f / 64.f) + EPS);
                    const f32x4 g0 = *(const f32x4*)(kgain + 8 * dg), g1 = *(const f32x4*)(kgain + 8 * dg + 4);
                    kv[0] *= rstd * g0[0]; kv[1] *= rstd * g0[1]; kv[2] *= rstd * g0[2]; kv[3] *= rstd * g0[3]; kv[4] *= rstd * g1[0]; kv[5] *= rstd * g1[1]; kv[6] *= rstd * g1[2]; kv[7] *= rstd * g1[3];
                    float pv[8];
#pragma unroll
                    for (int i = 0; i < 8; ++i) pv[i] = __shfl_xor(kv[i], 1);
                    if (dg < 2) {
#pragma unroll
                        for (int i = 0; i < 8; ++i) { float sn, cs; sincos_rev((float)kp * exp2f(-2.36644607f * (float)i), sn, cs);
                            kv[i] = (dg == 0) ? (kv[i] * cs - pv[i] * sn) : (kv[i] * cs + pv[i] * sn); }
                    }
                    u32x4 kw; kw.x = cvt_pk_bf16(kv[0], kv[1]); kw.y = cvt_pk_bf16(kv[2], kv[3]); kw.z = cvt_pk_bf16(kv[4], kv[5]); kw.w = cvt_pk_bf16(kv[6], kv[7]);
                    *(LAS u32x4*)(Ks + key * 72 + 8 * dg) = kw;
                    const int kpm = (key & ~31) | pg8::perm32(key & 31);
                    Vt[(8 * dg + 0) * 200 + kpm] = (bf16_t)(vr.x & 0xffffu); Vt[(8 * dg + 1) * 200 + kpm] = (bf16_t)(vr.x >> 16);
                    Vt[(8 * dg + 2) * 200 + kpm] = (bf16_t)(vr.y & 0xffffu); Vt[(8 * dg + 3) * 200 + kpm] = (bf16_t)(vr.y >> 16);
                    Vt[(8 * dg + 4) * 200 + kpm] = (bf16_t)(vr.z & 0xffffu); Vt[(8 * dg + 5) * 200 + kpm] = (bf16_t)(vr.z >> 16);
                    Vt[(8 * dg + 6) * 200 + kpm] = (bf16_t)(vr.w & 0xffffu); Vt[(8 * dg + 7) * 200 + kpm] = (bf16_t)(vr.w >> 16);
                }
                __syncthreads();
                const int g = wave >> 1, qs = wave & 1, hq = hk * 4 + g;
                const float sinkv = args.in[I_SINK][hq];
#pragma unroll
                for (int j2 = 0; j2 < 2; ++j2) {
                    const int qrow = 32 * qs + 16 * j2 + fr;
                    const int tq = t0 + qrow, qpos = qb * 64 + qrow;
                    bf16x8 Qf[2];
                    {
                        const u32x4 r0 = *(const u32x4*)(proj0 + (size_t)tq * N0 + hq * 64 + 8 * fq), r1 = *(const u32x4*)(proj0 + (size_t)tq * N0 + hq * 64 + 32 + 8 * fq);
                        float q0[8], q1[8];
                        q0[0] = lo_bf(r0.x); q0[1] = hi_bf(r0.x); q0[2] = lo_bf(r0.y); q0[3] = hi_bf(r0.y); q0[4] = lo_bf(r0.z); q0[5] = hi_bf(r0.z); q0[6] = lo_bf(r0.w); q0[7] = hi_bf(r0.w);
                        q1[0] = lo_bf(r1.x); q1[1] = hi_bf(r1.x); q1[2] = lo_bf(r1.y); q1[3] = hi_bf(r1.y); q1[4] = lo_bf(r1.z); q1[5] = hi_bf(r1.z); q1[6] = lo_bf(r1.w); q1[7] = hi_bf(r1.w);
                        float ss = 0.f;
#pragma unroll
                        for (int i = 0; i < 8; ++i) ss += q0[i] * q0[i] + q1[i] * q1[i];
                        ss += __shfl_xor(ss, 16); ss += __shfl_xor(ss, 32);
                        const float rstd = rsqrtf(ss * (1.f / 64.f) + EPS) * 0.125f;
#pragma unroll
                        for (int i = 0; i < 8; ++i) { q0[i] *= rstd * qgain[8 * fq + i]; q1[i] *= rstd * qgain[32 + 8 * fq + i]; }
                        float pv[8];
#pragma unroll
                        for (int i = 0; i < 8; ++i) pv[i] = __shfl_xor(q0[i], 16);
                        if (fq < 2) {
#pragma unroll
                            for (int i = 0; i < 8; ++i) { float sn, cs; sincos_rev((float)qpos * exp2f(-2.36644607f * (float)i), sn, cs);
                                q0[i] = (fq == 0) ? (q0[i] * cs - pv[i] * sn) : (q0[i] * cs + pv[i] * sn); }
                        }
                        u32x4 w0, w1;
                        w0.x = cvt_pk_bf16(q0[0], q0[1]); w0.y = cvt_pk_bf16(q0[2], q0[3]); w0.z = cvt_pk_bf16(q0[4], q0[5]); w0.w = cvt_pk_bf16(q0[6], q0[7]);
                        w1.x = cvt_pk_bf16(q1[0], q1[1]); w1.y = cvt_pk_bf16(q1[2], q1[3]); w1.z = cvt_pk_bf16(q1[4], q1[5]); w1.w = cvt_pk_bf16(q1[6], q1[7]);
                        Qf[0] = __builtin_bit_cast(bf16x8, w0); Qf[1] = __builtin_bit_cast(bf16x8, w1);
                    }
                    float mrun = sinkv, lrun = (fq == 0) ? 1.f : 0.f;
                    f32x4 Oa[4];
#pragma unroll
                    for (int dt = 0; dt < 4; ++dt) Oa[dt] = (f32x4){0.f, 0.f, 0.f, 0.f};
#pragma unroll
                    for (int kt = 0; kt < 3; ++kt) {
                        f32x4 sc[4];
                        float tmax = -1e30f;
#pragma unroll
                        for (int mt = 0; mt < 4; ++mt) { sc[mt] = (f32x4){0.f, 0.f, 0.f, 0.f};
#pragma unroll
                            for (int s = 0; s < 2; ++s) sc[mt] = mfma16(*(const LAS bf16x8*)(Ks + (64 * kt + 16 * mt + fr) * 72 + 32 * s + 8 * fq), Qf[s], sc[mt]);
#pragma unroll
                            for (int rg = 0; rg < 4; ++rg) { const int key = 64 * kt + 16 * mt + 4 * fq + rg; const int rel = 128 + qrow - key; const int kp = qb * 64 - 128 + key;
                                const bool ok = (rel >= 0) && (rel < 128) && (kp >= 0);
                                sc[mt][rg] = ok ? sc[mt][rg] : -1e30f; tmax = fmaxf(tmax, sc[mt][rg]); } }
                        tmax = fmaxf(tmax, __shfl_xor(tmax, 16)); tmax = fmaxf(tmax, __shfl_xor(tmax, 32));
                        const float mnew = fmaxf(mrun, tmax), alpha = __expf(mrun - mnew);
                        float ps = 0.f;
#pragma unroll
                        for (int mt = 0; mt < 4; ++mt)
#pragma unroll
                            for (int rg = 0; rg < 4; ++rg) { const float p = (sc[mt][rg] > -1e29f) ? __expf(sc[mt][rg] - mnew) : 0.f; sc[mt][rg] = p; ps += p; }
                        lrun = lrun * alpha + ps; mrun = mnew;
                        bf16x8 Pb[2]; Pb[0] = mk8f(sc[0], sc[1]); Pb[1] = mk8f(sc[2], sc[3]);
#pragma unroll
                        for (int dt = 0; dt < 4; ++dt) { Oa[dt] = Oa[dt] * alpha;
#pragma unroll
                            for (int s2 = 0; s2 < 2; ++s2) Oa[dt] = mfma16(*(const LAS bf16x8*)(Vt + (16 * dt + fr) * 200 + 64 * kt + 32 * s2 + 8 * fq), Pb[s2], Oa[dt]); }
                    }
                    lrun += __shfl_xor(lrun, 16); lrun += __shfl_xor(lrun, 32);
                    const float inv = 1.f / lrun;
#pragma unroll
                    for (int dt = 0; dt < 4; ++dt) { u32x2 w; w.x = cvt_pk_bf16(Oa[dt][0] * inv, Oa[dt][1] * inv); w.y = cvt_pk_bf16(Oa[dt][2] * inv, Oa[dt][3] * inv);
                        *(u32x2*)(mix0 + (size_t)tq * D + hq * 64 + 16 * dt + 4 * fq) = w; }
                }
            }
            __syncthreads();
            {
                LAS float* scr = (LAS float*)(lds + wave * 8448);
                const int gw2 = (bid - 32) * NWAVES + wave, ngw2 = nbk * NWAVES;
                constexpr int I1 = (D / 64) * (D / 32), I2 = (D / 64) * (ODD_IN / 32), I3 = (2048 / 64) * (D / 32);
                for (int it = gw2; it < I1 + I2 + I3; it += ngw2) {
                    int r = it;
                    if (r < I1) { transpose_item(args.in[I_WOUTE], D, D, D, (bf16_t*)(ws + WS_WOUT0), 0, scr, r, lane); continue; } r -= I1;
                    if (r < I2) { transpose_item(args.in[I_WINO], D, ODD_IN, ODD_IN, (bf16_t*)(ws + WS_WIN1), 0, scr, r, lane); continue; } r -= I2;
                    transpose_item(args.in[I_WOUTO], 2048, D, D, (bf16_t*)(ws + WS_WOUT1), 0, scr, r, lane);
                }
                convert_moe(args, 0, scr, gw2, ngw2, lane);
            }
        }
    }
    SEAM(3);

    if (RUN(4)) { PHASE_IDS;
        pg8::Gemm g{(const bf16_t*)(ws + WS_HMIX0), (const bf16_t*)(ws + WS_WOUT0), D, D, nullptr};
        pg8::DenseOrder S; S.init(T, D, G, bid, D, D);
        pg8::EpiResF32 E{args.in[I_X], args.out, D};
        pg8::gemm_phase(lds, g, S, E);
    }
    SEAM(4);

    if (RUN(5)) { PHASE_IDS; moe_route2(args, 0, lds, bid, G, tid, lane, wave); }
    SEAM(5);
    if (RUN(6)) { PHASE_IDS; moe_scatter(args, 0, lds, bid, G, tid, lane, wave); }
    SEAM(6);
    if (RUN(7)) { PHASE_IDS; moe_gemm1(args, 0, lds, bid, G, tid); }
    SEAM(7);
    if (RUN(8)) { PHASE_IDS; moe_gemm2(args, 0, lds, bid, G, tid); }
    SEAM(8);
    if (RUN(9)) { PHASE_IDS; moe_combine<true>(args, args.in[I_LNO], (bf16_t*)(ws + WS_H1), gw, ngw, lane); }
    SEAM(9);

    if (RUN(10)) { PHASE_IDS;
        pg8::Gemm g{(const bf16_t*)(ws + WS_H1), (const bf16_t*)(ws + WS_WIN1), D, D, nullptr};
        pg8::DenseOrder S; S.init(T, ODD_IN, G, bid, D, D);
        pg8::EpiBf16 E{(bf16_t*)(ws + WS_PROJ1), ODD_IN};
        pg8::gemm_phase(lds, g, S, E);
    }
    SEAM(10);

    if (RUN(11)) { PHASE_IDS;
        bf16_t* proj1 = (bf16_t*)(ws + WS_PROJ1); bf16_t* inner = (bf16_t*)(ws + WS_INNER); bf16_t* kzT = (bf16_t*)(ws + WS_KZT);
        LAS bf16_t* Qs = (LAS bf16_t*)lds;
        LAS bf16_t* Ks = (LAS bf16_t*)(lds + 67584);
        const int fr = lane & 15, fq = lane >> 4;
        LAS float* gtab = (LAS float*)(lds + 135168);
        float frq[4];
#pragma unroll
        for (int pp = 0; pp < 4; ++pp) frq[pp] = exp2f(-0.10462765655f * (float)(4 * (lane & 31) + pp));
        for (int item = bid; item < 1024; item += G) {
            const int b = item >> 7, n = (item >> 2) & 31, h = item & 3;
            const int t0 = b * SEQ + n * 128;
            const float l2g = logf(1.0f - exp2f(-5.0f - (float)h)) * 1.4426950408889634f;
            __syncthreads();
            if (tid < 128) gtab[tid] = exp2f((float)tid * l2g);
            {
                const int p = lane & 31;
#pragma unroll
                for (int c = 0; c < 8; ++c) {
                    const int r = 16 * wave + 2 * c + (lane >> 5);
                    const float pos = (float)(n * 128 + r);
                    const bf16_t* pq = proj1 + (size_t)(t0 + r) * ODD_IN + h * 256 + 8 * p;
                    const u32x4 qr = *(const u32x4*)pq, kr = *(const u32x4*)(pq + 1024);
                    unsigned qw[4] = {qr.x, qr.y, qr.z, qr.w}, kw[4] = {kr.x, kr.y, kr.z, kr.w};
#pragma unroll
                    for (int pp = 0; pp < 4; ++pp) {
                        float sn, cs; sincos_rev(pos * frq[pp], sn, cs);
                        const float q1 = lo_bf(qw[pp]), q2 = hi_bf(qw[pp]), k1 = lo_bf(kw[pp]) * 0.0625f, k2 = hi_bf(kw[pp]) * 0.0625f;
                        qw[pp] = cvt_pk_bf16(q1 * cs - q2 * sn, q2 * cs + q1 * sn);
                        kw[pp] = cvt_pk_bf16(k1 * cs - k2 * sn, k2 * cs + k1 * sn);
                    }
                    *(LAS u32x4*)(Qs + r * 264 + 8 * p) = (u32x4){qw[0], qw[1], qw[2], qw[3]};
                    *(LAS u32x4*)(Ks + r * 264 + 8 * p) = (u32x4){kw[0], kw[1], kw[2], kw[3]};
                }
            }
            __syncthreads();
            {
#pragma unroll
                for (int s8 = 0; s8 < 8; ++s8) {
                    const u32x4 v = *(const LAS u32x4*)(Qs + (16 * wave + fr) * 264 + 32 * s8 + 8 * fq);
                    *(u32x4*)(proj1 + (size_t)(t0 + 16 * wave + 2 * s8 + (lane >> 5)) * ODD_IN + h * 256 + 8 * (lane & 31)) = v;
                }
            }
            {
                for (int t = wave; t < 64; t += 8) {
                    int it, jt;
                    if (t < 36) { it = 0; int rem = t; while (rem > it) { rem -= it + 1; ++it; } jt = rem; }
                    else { const int u = t - 36; it = 0; int rem = u; while (rem >= 7 - it) { rem -= 7 - it; ++it; } jt = it + 1 + rem; }
                    f32x4 acc = (f32x4){0.f, 0.f, 0.f, 0.f};
                    if (t < 36) {
#pragma unroll
                        for (int s8 = 0; s8 < 8; ++s8)
                            acc = mfma16(*(const LAS bf16x8*)(Ks + (16 * jt + fr) * 264 + 32 * s8 + 8 * fq), *(const LAS bf16x8*)(Qs + (16 * it + fr) * 264 + 32 * s8 + 8 * fq), acc);
                    }
                    const int i = 16 * it + fr;
                    float vv[4];
#pragma unroll
                    for (int rg = 0; rg < 4; ++rg) { const int j = 16 * jt + 4 * fq + rg; vv[rg] = (i >= j) ? acc[rg] * gtab[i - j] : 0.f; }
                    u32x2 w; w.x = cvt_pk_bf16(vv[0], vv[1]); w.y = cvt_pk_bf16(vv[2], vv[3]);
                    *(u32x2*)(inner + (size_t)item * 16384 + (((it * 4 + (jt >> 1)) * 64 + ((jt & 1) * 2 + (fq >> 1)) * 16 + fr) * 8 + 4 * (fq & 1))) = w;
                }
            }
            {
                const int d = tid >> 1, half = tid & 1;
                bf16_t* po = kzT + (size_t)item * 32768 + ((size_t)(((d >> 5) * 2 + ((d >> 4) & 1)) * 4 + 2 * half) * 64 + (d & 15)) * 8;
#pragma unroll
                for (int i8 = 0; i8 < 8; ++i8) {
                    float kv[8];
#pragma unroll
                    for (int e = 0; e < 8; ++e) { const int r = 64 * half + 8 * i8 + e; kv[e] = bf2f((unsigned)Ks[r * 264 + d]) * gtab[127 - r]; }
                    u32x4 o; o.x = cvt_pk_bf16(kv[0], kv[1]); o.y = cvt_pk_bf16(kv[2], kv[3]); o.z = cvt_pk_bf16(kv[4], kv[5]); o.w = cvt_pk_bf16(kv[6], kv[7]);
                    *(u32x4*)(po + ((i8 >> 2) * 64 + (i8 & 3) * 16) * 8) = o;
                }
            }
        }
    }
    SEAM(11);

    if (RUN(12)) { PHASE_IDS;
        bf16_t* proj1 = (bf16_t*)(ws + WS_PROJ1); const bf16_t* inner = (const bf16_t*)(ws + WS_INNER); const bf16_t* kzT = (const bf16_t*)(ws + WS_KZT);
        float* SSQ = (float*)(ws + WS_SSQ);
        LAS bf16_t* Vt0 = (LAS bf16_t*)lds;
        LAS bf16_t* St0 = (LAS bf16_t*)(lds + 2 * 17408);
        const int fr = lane & 15, fq = lane >> 4;
        for (int wi = bid; wi < 256; wi += G) {
            const int xcd = wi & 7, jj = wi >> 3, bh = xcd * 4 + (jj >> 3), sl = jj & 7, b = bh >> 2, h = bh & 3;
            const float l2g = logf(1.0f - exp2f(-5.0f - (float)h)) * 1.4426950408889634f;
            const float gC = exp2f(128.0f * l2g);
            const float xi = exp2f((float)(16 * wave + fr + 1) * l2g);
            f32x4 Sacc[2][4];
#pragma unroll
            for (int mt = 0; mt < 2; ++mt)
#pragma unroll
                for (int nt = 0; nt < 4; ++nt) Sacc[mt][nt] = (f32x4){0.f, 0.f, 0.f, 0.f};
            __syncthreads();
            for (int i = tid; i < 64 * 264 / 2; i += NTHREADS) ((LAS unsigned*)St0)[i] = 0u;
            LAS bf16_t* Vt = Vt0; LAS bf16_t* St = St0;
            const int vr = tid >> 2, vcs = tid & 3;
            const size_t vcol = 2048 + h * 512 + 64 * sl;
            u32x4 pv0, pv1;
            { const u32x4* pvp = (const u32x4*)(proj1 + (size_t)(b * SEQ + vr) * ODD_IN + vcol + 16 * vcs); pv0 = pvp[0]; pv1 = pvp[1]; }
#define RET_VSTORE_TO(VD) do { const unsigned _w[8] = {pv0.x, pv0.y, pv0.z, pv0.w, pv1.x, pv1.y, pv1.z, pv1.w}; \
                _Pragma("unroll") for (int _e = 0; _e < 8; ++_e) { (VD)[(16 * vcs + 2 * _e) * 136 + vr] = (bf16_t)(_w[_e] & 0xffffu); (VD)[(16 * vcs + 2 * _e + 1) * 136 + vr] = (bf16_t)(_w[_e] >> 16); } } while (0)
#define RET_VSTORE() RET_VSTORE_TO(Vt)
            RET_VSTORE();
            __syncthreads();
            bf16x8 qf[8], nf[4], kf[2][4];
            {
                const int item0 = (b * 32) * 4 + h;
                const bf16_t* pq = proj1 + (size_t)(b * SEQ + 16 * wave + (lane >> 5)) * ODD_IN + h * 256 + 8 * (lane & 31);
#pragma unroll
                for (int s = 0; s < 8; ++s) qf[s] = *(const bf16x8*)(pq + (size_t)(2 * s) * ODD_IN);
                const bf16_t* pin = inner + (size_t)item0 * 16384 + ((wave * 4) * 64 + lane) * 8;
#pragma unroll
                for (int s = 0; s < 4; ++s) nf[s] = *(const bf16x8*)(pin + s * 512);
                const bf16_t* pk = kzT + (size_t)item0 * 32768 + ((wave * 8) * 64 + lane) * 8;
#pragma unroll
                for (int mt = 0; mt < 2; ++mt)
#pragma unroll
                    for (int s = 0; s < 4; ++s) kf[mt][s] = *(const bf16x8*)(pk + (mt * 4 + s) * 512);
            }
            for (int n = 0; n < 32; ++n) {
                Vt = Vt0 + (n & 1) * (64 * 136); St = St0 + (n & 1) * (64 * 264);
                LAS bf16_t* Vtn = Vt0 + ((n + 1) & 1) * (64 * 136); LAS bf16_t* Stn = St0 + ((n + 1) & 1) * (64 * 264);
                const int item = (b * 32 + n) * 4 + h, t0 = b * SEQ + n * 128;
                const int ti = t0 + 16 * wave + fr;
                const bool more = (n + 1 < 32);
                if (more) { const u32x4* pvp = (const u32x4*)(proj1 + (size_t)(t0 + 128 + vr) * ODD_IN + vcol + 16 * vcs); pv0 = pvp[0]; pv1 = pvp[1]; }
                f32x4 ac[4], ai[4];
#pragma unroll
                for (int ct = 0; ct < 4; ++ct) { ac[ct] = (f32x4){0.f, 0.f, 0.f, 0.f}; ai[ct] = (f32x4){0.f, 0.f, 0.f, 0.f}; }
                {
                    bf16x8 sf[3][4];
#pragma unroll
                    for (int ct = 0; ct < 4; ++ct) { sf[0][ct] = *(const LAS bf16x8*)(St + (16 * ct + fr) * 264 + 8 * fq); sf[1][ct] = *(const LAS bf16x8*)(St + (16 * ct + fr) * 264 + 32 + 8 * fq); }
#pragma unroll
                    for (int s = 0; s < 8; ++s) {
                        if (s + 2 < 8) {
#pragma unroll
                            for (int ct = 0; ct < 4; ++ct) sf[(s + 2) % 3][ct] = *(const LAS bf16x8*)(St + (16 * ct + fr) * 264 + 32 * (s + 2) + 8 * fq); }
                        __builtin_amdgcn_sched_barrier(0);
#pragma unroll
                        for (int ct = 0; ct < 4; ++ct) ac[ct] = mfma16(sf[s % 3][ct], qf[s], ac[ct]);
                        __builtin_amdgcn_sched_barrier(0);
                    }
                }
                if (more) { const bf16_t* pq = proj1 + (size_t)(t0 + 128 + 16 * wave + (lane >> 5)) * ODD_IN + h * 256 + 8 * (lane & 31);
#pragma unroll
                    for (int s = 0; s < 8; ++s) qf[s] = *(const bf16x8*)(pq + (size_t)(2 * s) * ODD_IN); }
#pragma unroll
                for (int s = 0; s < 4; ++s)
#pragma unroll
                    for (int ct = 0; ct < 4; ++ct) ai[ct] = mfma16(*(const LAS bf16x8*)(Vt + (16 * ct + fr) * 136 + 32 * s + 8 * fq), nf[s], ai[ct]);
                if (more) { const bf16_t* pin = inner + (size_t)(item + 4) * 16384 + ((wave * 4) * 64 + lane) * 8;
#pragma unroll
                    for (int s = 0; s < 4; ++s) nf[s] = *(const bf16x8*)(pin + s * 512); }
                {
                    float ssq = 0.f;
                    LAS bf16_t* Ow = (LAS bf16_t*)(lds + 102400 + wave * 2304);
#pragma unroll
                    for (int ct = 0; ct < 4; ++ct) {
                        f32x4 o = ai[ct] + ac[ct] * xi;
                        ssq += (o[0] * o[0] + o[1] * o[1]) + (o[2] * o[2] + o[3] * o[3]);
                        u32x2 w; w.x = cvt_pk_bf16(o[0], o[1]); w.y = cvt_pk_bf16(o[2], o[3]);
                        *(LAS u32x2*)(Ow + fr * 72 + 16 * ct + 4 * fq) = w;
                    }
                    {
                        const int rr = lane >> 3, pc = lane & 7;
                        const u32x4 w0 = *(const LAS u32x4*)(Ow + rr * 72 + 8 * pc), w1 = *(const LAS u32x4*)(Ow + (rr + 8) * 72 + 8 * pc);
                        bf16_t* po = proj1 + (size_t)(t0 + 16 * wave + rr) * ODD_IN + vcol + 8 * pc;
                        *(u32x4*)po = w0; *(u32x4*)(po + (size_t)8 * ODD_IN) = w1;
                    }
                    ssq += __shfl_xor(ssq, 16); ssq += __shfl_xor(ssq, 32);
                    if (fq == 0) SSQ[((size_t)(h * 8 + sl)) * T + ti] = ssq;
                }
#pragma unroll
                for (int mt = 0; mt < 2; ++mt)
#pragma unroll
                    for (int nt = 0; nt < 4; ++nt) { Sacc[mt][nt] = Sacc[mt][nt] * gC;
#pragma unroll
                        for (int s = 0; s < 4; ++s) Sacc[mt][nt] = mfma16(kf[mt][s], *(const LAS bf16x8*)(Vt + (16 * nt + fr) * 136 + 32 * s + 8 * fq), Sacc[mt][nt]); }
                if (more) { const bf16_t* pk = kzT + (size_t)(item + 4) * 32768 + ((wave * 8) * 64 + lane) * 8;
#pragma unroll
                    for (int mt = 0; mt < 2; ++mt)
#pragma unroll
                        for (int s = 0; s < 4; ++s) kf[mt][s] = *(const bf16x8*)(pk + (mt * 4 + s) * 512); }
#pragma unroll
                for (int mt = 0; mt < 2; ++mt)
#pragma unroll
                    for (int nt = 0; nt < 4; ++nt) { u32x2 w; w.x = cvt_pk_bf16(Sacc[mt][nt][0], Sacc[mt][nt][1]); w.y = cvt_pk_bf16(Sacc[mt][nt][2], Sacc[mt][nt][3]);
                        *(LAS u32x2*)(Stn + (16 * nt + fr) * 264 + 32 * wave + 16 * mt + 4 * fq) = w; }
                if (more) RET_VSTORE_TO(Vtn);
                __syncthreads();
            }
#undef RET_VSTORE
#undef RET_VSTORE_TO
        }
    }
    SEAM(12);

    if (RUN(13)) { PHASE_IDS;
        bf16_t* proj1 = (bf16_t*)(ws + WS_PROJ1); const float* SSQ = (const float*)(ws + WS_SSQ);
        {
            u32x4 vv[4], zz[4], vn_[4], zn_[4]; float sq = 0.f, sqn = 0.f;
#define FIN_LOAD(tt, V, Z, SQ) do { _Pragma("unroll") for (int j = 0; j < 4; ++j) { const u32x4* _p = (const u32x4*)(proj1 + (size_t)(tt) * ODD_IN + 2048 + j * 512) + lane; V[j] = _p[0]; Z[j] = _p[256]; } \
                SQ = (lane < 32) ? SSQ[(size_t)lane * T + (tt)] : 0.f; } while (0)
            if (gw < T) FIN_LOAD(gw, vv, zz, sq);
            for (int t = gw; t < T; t += ngw) {
                if (t + ngw < T) FIN_LOAD(t + ngw, vn_, zn_, sqn);
                float s8 = sq; s8 += __shfl_xor(s8, 1); s8 += __shfl_xor(s8, 2); s8 += __shfl_xor(s8, 4);
#pragma unroll
                for (int j = 0; j < 4; ++j) {
                    const float rstd = rsqrtf(__builtin_bit_cast(float, __builtin_amdgcn_readlane(__builtin_bit_cast(int, s8), 8 * j)) * (1.f / 512.f) + EPS);
                    const u32x4 v = vv[j], z = zz[j]; u32x4 o;
                    o.x = cvt_pk_bf16(lo_bf(v.x) * rstd * silu_f(lo_bf(z.x)), hi_bf(v.x) * rstd * silu_f(hi_bf(z.x))); o.y = cvt_pk_bf16(lo_bf(v.y) * rstd * silu_f(lo_bf(z.y)), hi_bf(v.y) * rstd * silu_f(hi_bf(z.y)));
                    o.z = cvt_pk_bf16(lo_bf(v.z) * rstd * silu_f(lo_bf(z.z)), hi_bf(v.z) * rstd * silu_f(hi_bf(z.z))); o.w = cvt_pk_bf16(lo_bf(v.w) * rstd * silu_f(lo_bf(z.w)), hi_bf(v.w) * rstd * silu_f(hi_bf(z.w)));
                    *((u32x4*)(proj1 + (size_t)t * ODD_IN + 2048 + j * 512) + lane) = o;
                }
#pragma unroll
                for (int j = 0; j < 4; ++j) { vv[j] = vn_[j]; zz[j] = zn_[j]; }
                sq = sqn;
            }
#undef FIN_LOAD
        }
        convert_moe(args, 1, (LAS float*)(lds + wave * 8448), gw, ngw, lane, 1);
    }
    SEAM(13);

    if (RUN(14)) { PHASE_IDS;
        pg8::Gemm g{(const bf16_t*)(ws + WS_PROJ1) + 2048, (const bf16_t*)(ws + WS_WOUT1), ODD_IN, 2048, nullptr};
        pg8::DenseOrder S; S.init(T, D, G, bid, ODD_IN, 2048);
        pg8::EpiResF32 E{args.out, args.out, D};
        pg8::gemm_phase(lds, g, S, E);
    }
    SEAM(14);

    if (RUN(15)) { PHASE_IDS; moe_route2(args, 1, lds, bid, G, tid, lane, wave); }
    SEAM(15);
    if (RUN(16)) { PHASE_IDS; moe_scatter(args, 1, lds, bid, G, tid, lane, wave); }
    SEAM(16);
    if (RUN(17)) { PHASE_IDS; moe_gemm1(args, 1, lds, bid, G, tid); }
    SEAM(17);
    if (RUN(18)) { PHASE_IDS; moe_gemm2(args, 1, lds, bid, G, tid); }
    SEAM(18);
    if (RUN(19)) { PHASE_IDS; moe_combine<false>(args, nullptr, nullptr, gw, ngw, lane); }
#undef IN
#undef SEAM
}

extern "C" void kernel_launch(void* const* d_in, const int* in_sizes, int n_in, void* d_out, int out_size, void* d_ws, size_t ws_size, hipStream_t stream) {
    static int grid = 0;
    if (grid == 0) {
        if (n_in != 22 || in_sizes[0] != T * D || out_size != T * D || ws_size < WS_END) { fprintf(stderr, "kernel_launch: unexpected shapes / workspace (n_in %d, ws %zu, need %zu)\n", n_in, ws_size, (size_t)WS_END); grid = -1; return; }
        int dev = 0, cus = 0, per_cu = 0;
        (void)hipGetDevice(&dev); (void)hipDeviceGetAttribute(&cus, hipDeviceAttributeMultiprocessorCount, dev);
        if (hipFuncSetAttribute((const void*)fwd_kernel, hipFuncAttributeMaxDynamicSharedMemorySize, LDS_BYTES) != hipSuccess) { fprintf(stderr, "kernel_launch: hipFuncSetAttribute failed\n"); grid = -1; return; }
        if (hipOccupancyMaxActiveBlocksPerMultiprocessor(&per_cu, (const void*)fwd_kernel, NTHREADS, LDS_BYTES) != hipSuccess || per_cu < 1) { fprintf(stderr, "kernel_launch: occupancy query says %d\n", per_cu); grid = -1; return; }
        (void)hipGetLastError();
        grid = cus;
    }
    if (grid < 0) return;
    (void)hipMemsetAsync((char*)d_ws + WS_CTL, 0, 65536, stream);
    Args a{};
    for (int i = 0; i < 22; ++i) a.in[i] = (const float*)d_in[i];
    a.out = (float*)d_out; a.ws = (unsigned char*)d_ws; a.ph_lo = 0; a.ph_hi = PHHI;
    void* kargs[] = {&a};
    hipError_t e = hipLaunchCooperativeKernel((const void*)fwd_kernel, dim3(grid), dim3(NTHREADS), kargs, LDS_BYTES, stream);
    if (e != hipSuccess) fprintf(stderr, "kernel_launch: cooperative launch failed: %s (grid %d)\n", hipGetErrorString(e), grid);
}
```

```cpp
#include <hip/hip_runtime.h>
#include <utility>
#include <hip/hip_cooperative_groups.h>
#include <cstdio>
#include <cstdint>
namespace cg = cooperative_groups;

#define LAS __attribute__((address_space(3)))
typedef unsigned short bf16_t;
typedef short bf16x8 __attribute__((ext_vector_type(8)));
typedef float f32x4 __attribute__((ext_vector_type(4)));
typedef float f32x2 __attribute__((ext_vector_type(2)));
typedef unsigned u32x4 __attribute__((ext_vector_type(4)));
typedef unsigned u32x2 __attribute__((ext_vector_type(2)));

constexpr int NB = 8, SEQ = 4096, D = 1024, T = NB * SEQ;
constexpr int EVEN_IN = 2824, N0 = 2816;
constexpr int ODD_IN = 6144;
constexpr int NEXP = 32, DEXP = 512;
constexpr int ROWS_PAD = 73728;
constexpr float EPS = 1e-6f;
constexpr int NWAVES = 8, NTHREADS = 512;
constexpr int LDS_BYTES = 163840;

constexpr size_t MiB = 1u << 20;
constexpr size_t WS_CTL = 0;
constexpr size_t WS_WIN0 = 1 * MiB;
constexpr size_t WS_WOUT0 = 7 * MiB;
constexpr size_t WS_WIN1 = 9 * MiB;
constexpr size_t WS_WOUT1 = 21 * MiB;
constexpr size_t WS_X = 25 * MiB;
constexpr size_t WS_XB1 = WS_X;
constexpr size_t WS_XB2 = WS_X + 64 * MiB;
constexpr size_t WS_H1 = WS_X;
constexpr size_t WS_INNER = WS_X;
constexpr size_t WS_KZT = WS_X + 32 * MiB;
constexpr size_t WS_SM = 121 * MiB;
constexpr size_t WS_BAB = WS_SM;
constexpr size_t WS_RE = WS_SM + 1 * MiB;
constexpr size_t WS_RG = WS_RE + 256 * 1024;
constexpr size_t WS_RS = WS_RG + 256 * 1024;
constexpr size_t WS_RP = WS_RS + 256 * 1024;
constexpr size_t WS_SSQ = WS_SM + 2 * MiB;
constexpr size_t WS_GL = WS_SM + 6 * MiB;
constexpr size_t WS_ROWTOK = WS_SM + 7 * MiB + 65536;
constexpr size_t WS_WHL = WS_SM + 7 * MiB + 512 * 1024;
constexpr size_t WS_BC = WS_SM + 7 * MiB;
constexpr size_t WS_A = 129 * MiB;
constexpr size_t WS_PROJ0 = WS_A;
constexpr size_t WS_HMIX0 = WS_A + 176 * MiB;
constexpr size_t WS_GU = WS_A + 240 * MiB;
constexpr size_t WS_GW = WS_A + 272 * MiB;
constexpr size_t WS_GQD = WS_A + 304 * MiB;
constexpr size_t WS_GKDT = WS_A + 336 * MiB;
constexpr size_t WS_GA = WS_A + 368 * MiB;
constexpr size_t WS_XN = WS_A;
constexpr size_t WS_XROWS = WS_A + 64 * MiB;
constexpr size_t WS_HID = WS_A + 208 * MiB;
constexpr size_t WS_PROJ1 = WS_A;
constexpr size_t WS_XB2L1 = 513 * MiB;
constexpr size_t WS_END = 545 * MiB;

__device__ __forceinline__ float bf2f(unsigned b) { return __uint_as_float(b << 16); }
typedef __bf16 bf16x2_t __attribute__((ext_vector_type(2)));
__device__ __forceinline__ unsigned cvt_pk_bf16(float lo, float hi) { f32x2 v = {lo, hi}; bf16x2_t b = __builtin_convertvector(v, bf16x2_t); return __builtin_bit_cast(unsigned, b); }
__device__ __forceinline__ unsigned short f2bf(float f) { return (unsigned short)(cvt_pk_bf16(f, 0.f) & 0xffffu); }
__device__ __forceinline__ float lo_bf(unsigned w) { return __uint_as_float(w << 16); }
__device__ __forceinline__ float hi_bf(unsigned w) { return __uint_as_float(w & 0xffff0000u); }
__device__ __forceinline__ float silu_f(float x) { return x * __builtin_amdgcn_rcpf(1.0f + __expf(-x)); }
__device__ __forceinline__ float sigmoid_f(float x) { return __builtin_amdgcn_rcpf(1.0f + __expf(-x)); }
__device__ __forceinline__ f32x4 mfma16(bf16x8 a, bf16x8 b, f32x4 c) { return __builtin_amdgcn_mfma_f32_16x16x32_bf16(a, b, c, 0, 0, 0); }
__device__ __forceinline__ bf16x8 mk8(u32x2 lo, u32x2 hi) { u32x4 v; v.x = lo.x; v.y = lo.y; v.z = hi.x; v.w = hi.y; return __builtin_bit_cast(bf16x8, v); }
__device__ __forceinline__ bf16x8 mk8f(f32x4 a, f32x4 b) { u32x4 v; v.x = cvt_pk_bf16(a[0], a[1]); v.y = cvt_pk_bf16(a[2], a[3]); v.z = cvt_pk_bf16(b[0], b[1]); v.w = cvt_pk_bf16(b[2], b[3]); return __builtin_bit_cast(bf16x8, v); }
template <int J> __device__ __forceinline__ void fmac_bc(float& acc, int l, float u) {
    if constexpr (J == 0) asm("s_nop 1\n\tv_fmac_f32_dpp %0, %1, %2 row_newbcast:0 row_mask:0xf bank_mask:0xf" : "+v"(acc) : "v"(l), "v"(u));
    else asm("v_fmac_f32_dpp %0, %1, %2 row_newbcast:%3 row_mask:0xf bank_mask:0xf" : "+v"(acc) : "v"(l), "v"(u), "n"(J));
}
template <int... Js> __device__ __forceinline__ void solve_terms(float (&s)[4], const int (&lc)[4], const float (&U)[64], std::integer_sequence<int, Js...>) { (fmac_bc<(Js & 15)>(s[Js & 3], lc[Js >> 4], U[Js]), ...); }
template <int I> __device__ __forceinline__ void solve_row(float (&U)[64], int (&ln)[4], const LAS float* Lm, const LAS unsigned short* Rb, int l16, int c) {
    const int lc[4] = {ln[0], ln[1], ln[2], ln[3]};
    if constexpr (I + 1 < 64) {
#pragma unroll
        for (int k = 0; k < 4; ++k) if (16 * k < I + 1) ln[k] = __builtin_bit_cast(int, Lm[(I + 1) * 64 + 16 * k + l16]);
    }
    float s[4] = {__uint_as_float((unsigned)Rb[I * 264 + c] << 16), 0.f, 0.f, 0.f};
    solve_terms(s, lc, U, std::make_integer_sequence<int, I>{});
    U[I] = (s[0] + s[1]) + (s[2] + s[3]);
}
template <int... Is> __device__ __forceinline__ void solve_rows(float (&U)[64], int (&ln)[4], const LAS float* Lm, const LAS unsigned short* Rb, int l16, int c, std::integer_sequence<int, Is...>) { (solve_row<Is + 1>(U, ln, Lm, Rb, l16, c), ...); }
__device__ __forceinline__ float wave_sum(float v) {
#pragma unroll
    for (int o = 1; o < 64; o <<= 1) v += __shfl_xor(v, o);
    return v;
}
__device__ __forceinline__ void sincos_rev(float ang, float& s, float& c) {
    float r = ang * 0.15915494309189535f; r = r - floorf(r);
    s = __builtin_amdgcn_sinf(r); c = __builtin_amdgcn_cosf(r);
}

namespace pg8 {
constexpr int BM = 256, BK = 64, HALF = 128, HTB = HALF * BK * 2, STAGE_BYTES = 8 * HTB, NXCD = 8, WGM = 4;
__device__ __forceinline__ int lds_byte(int r, int c) { const int st = (r >> 4) * 2 + (c >> 5), rr = r & 15, cc = c & 31, ob = rr * 64 + cc * 2; return st * 1024 + (ob ^ (((ob >> 9) & 1) << 5)); }
__device__ __forceinline__ void stage_rc(int b, int& R, int& C) { const int st = b / 1024, sb = b % 1024, swz = sb ^ (((sb >> 9) & 1) << 5); R = (st >> 1) * 16 + swz / 64; C = (st & 1) * 32 + (swz % 64) / 2; }
__device__ __forceinline__ int perm32(int rho) { const int n = rho >> 4, i = rho & 15; return 8 * (i >> 2) + 4 * n + (i & 3); }

struct Unit { size_t aoff, boff; int pm, pn; };
struct Gemm { const bf16_t* A; const bf16_t* Bt; int lda, K; const int* rowtok; };

struct DenseOrder {
    int nM, nN, nwg, G, c, lda, K;
    __device__ void init(int M, int N, int G_, int c_, int lda_, int K_) { nM = M / BM; nN = N / BM; nwg = nM * nN; G = G_; c = c_; lda = lda_; K = K_; }
    __device__ bool next(int i, Unit& u) const {
        const long L = (long)i * G + c; if (L >= nwg) return false;
        int wgid = (int)L; { const int q = nwg / NXCD, r = nwg % NXCD, xcd = wgid % NXCD, off = wgid / NXCD; wgid = (xcd < r ? xcd * (q + 1) : r * (q + 1) + (xcd - r) * q) + off; }
        const int nig = WGM * nN, gid = wgid / nig, fm = gid * WGM, gsz = (nM - fm) < WGM ? (nM - fm) : WGM;
        u.pm = fm + ((wgid % nig) % gsz); u.pn = (wgid % nig) / gsz;
        u.aoff = (size_t)u.pm * BM * lda * 2; u.boff = (size_t)u.pn * BM * K * 2; return true;
    }
};
struct GroupedOrder {
    const LAS int* tile_e; int ntiles, G, c, lda, K; size_t estride;
    __device__ bool next(int i, Unit& u) const {
        const int L = i * G + c; if (L >= ntiles * 4) return false;
        const int rt = L >> 2, pn = L & 3; const int e = tile_e[rt];
        u.pm = rt; u.pn = pn; u.aoff = (size_t)rt * BM * lda * 2; u.boff = (size_t)e * estride + (size_t)pn * BM * K * 2; return true;
    }
};

struct DynGroupedOrder {
    const LAS int* tile_e; const LAS int* order; int ntiles; int* claim; const int* rdy; volatile LAS int* slot; int tid, lda, K; size_t estride;
    __device__ bool next(int, Unit& u) const {
        if (tid == 0) {
            const int q = __hip_atomic_fetch_add(claim, 1, __ATOMIC_RELAXED, __HIP_MEMORY_SCOPE_AGENT);
            int v = -1;
            if (q < ntiles * 4) {
                const int* f = rdy + order[q >> 2];
                bool acq = (slot[1] == 0); slot[1] = 1;
                while (__hip_atomic_load(f, __ATOMIC_RELAXED, __HIP_MEMORY_SCOPE_AGENT) < 4) { acq = true; __builtin_amdgcn_s_sleep(2); }
                if (acq) __builtin_amdgcn_fence(__ATOMIC_ACQUIRE, "agent");
                v = q;
            }
            *slot = v;
        }
        __syncthreads();
        const int q = *slot;
        if (q < 0) return false;
        const int rt = order[q >> 2], pn = q & 3; const int e = tile_e[rt];
        u.pm = rt; u.pn = pn; u.aoff = (size_t)rt * BM * lda * 2; u.boff = (size_t)e * estride + (size_t)pn * BM * K * 2; return true;
    }
};

struct EpiBf16 {
    static constexpr bool PERM = true;
    bf16_t* O; int ldc;
    __device__ __forceinline__ void operator()(const f32x4 (&acc)[2][2][4][2], const Unit& u, int wr, int wc, int fr, int fq) const {
        const int row0 = u.pm * BM + wr * 64 + fr; const int col0 = u.pn * BM + wc * 32 + 8 * fq;
#pragma unroll
        for (int ai = 0; ai < 2; ++ai)
#pragma unroll
            for (int m = 0; m < 4; ++m) { bf16_t* rowp = O + (size_t)(row0 + ai * HALF + m * 16) * ldc + col0;
#pragma unroll
                for (int bj = 0; bj < 2; ++bj) { const f32x4 v0 = acc[ai][bj][m][0], v1 = acc[ai][bj][m][1];
                    u32x4 w; w.x = cvt_pk_bf16(v0[0], v0[1]); w.y = cvt_pk_bf16(v0[2], v0[3]); w.z = cvt_pk_bf16(v1[0], v1[1]); w.w = cvt_pk_bf16(v1[2], v1[3]);
                    *(u32x4*)(rowp + bj * HALF) = w; } }
    }
};
struct EpiResF32 {
    static constexpr bool PERM = false;
    const float* base; float* out; int ldc; float* ssp;
    __device__ __forceinline__ void operator()(const f32x4 (&acc)[2][2][4][2], const Unit& u, int wr, int wc, int fr, int fq) const {
        const int row0 = u.pm * BM + wr * 64 + fr, col0 = u.pn * BM + wc * 32 + 4 * fq;
#pragma unroll
        for (int ai = 0; ai < 2; ++ai)
#pragma unroll
            for (int mp = 0; mp < 2; ++mp) {
                f32x4 bv[2][2][2];
#pragma unroll
                for (int m2 = 0; m2 < 2; ++m2) { const size_t off = (size_t)(row0 + ai * HALF + (2 * mp + m2) * 16) * ldc + col0;
#pragma unroll
                    for (int bj = 0; bj < 2; ++bj)
#pragma unroll
                        for (int n = 0; n < 2; ++n) bv[m2][bj][n] = *(const f32x4*)(base + off + bj * HALF + n * 16); }
#pragma unroll
                for (int m2 = 0; m2 < 2; ++m2) { const int m = 2 * mp + m2; const size_t off = (size_t)(row0 + ai * HALF + m * 16) * ldc + col0; float sq = 0.f;
#pragma unroll
                    for (int bj = 0; bj < 2; ++bj)
#pragma unroll
                        for (int n = 0; n < 2; ++n) { const f32x4 o = bv[m2][bj][n] + acc[ai][bj][m][n]; *(f32x4*)(out + off + bj * HALF + n * 16) = o; sq += (o[0] * o[0] + o[1] * o[1]) + (o[2] * o[2] + o[3] * o[3]); }
                    sq += __shfl_xor(sq, 16); sq += __shfl_xor(sq, 32);
                    if (fq == 0) ssp[(size_t)(row0 + ai * HALF + m * 16) * 16 + u.pn * 4 + wc] = sq; }
            }
    }
};
struct EpiSwiGLU {
    static constexpr bool PERM = false;
    bf16_t* H;
    __device__ __forceinline__ void operator()(const f32x4 (&acc)[2][2][4][2], const Unit& u, int wr, int wc, int fr, int fq) const {
        const int row0 = u.pm * BM + wr * 64 + fr;
        const __amdgpu_buffer_rsrc_t rs = __builtin_amdgcn_make_buffer_rsrc((void*)H, 0, 0xFFFFFFF0u, 0x00020000);
        const int pp = 128 * u.pn + 32 * wc + 8 * fq;
#pragma unroll
        for (int ai = 0; ai < 2; ++ai)
#pragma unroll
            for (int m = 0; m < 4; ++m) {
                const f32x4 g0 = acc[ai][0][m][0], u0 = acc[ai][0][m][1], g1 = acc[ai][1][m][0], u1 = acc[ai][1][m][1];
                u32x4 w;
                w.x = cvt_pk_bf16(silu_f(g0[0]) * u0[0], silu_f(g0[1]) * u0[1]); w.y = cvt_pk_bf16(silu_f(g0[2]) * u0[2], silu_f(g0[3]) * u0[3]);
                w.z = cvt_pk_bf16(silu_f(g1[0]) * u1[0], silu_f(g1[1]) * u1[1]); w.w = cvt_pk_bf16(silu_f(g1[2]) * u1[2], silu_f(g1[3]) * u1[3]);
                __builtin_amdgcn_raw_buffer_store_b128(w, rs, (int)(((unsigned)(row0 + ai * HALF + m * 16) * (unsigned)DEXP + (unsigned)pp) * 2u), 0, 16);
            }
    }
};

template <class Epi, class Sched, bool GATHER = false>
__device__ __forceinline__ void gemm_phase(LAS unsigned char* lds, const Gemm g, const Sched& S, const Epi& E) {
    const int tid = threadIdx.x, wid = __builtin_amdgcn_readfirstlane(tid >> 6), lane = tid & 63, wr = wid >> 2, wc = wid & 3, fr = lane & 15, fq = lane >> 4;
    const int K = g.K, nt = K / BK;
    unsigned voffA[2], voffB[2]; int gR[2]; unsigned gC[2];
#pragma unroll
    for (int i = 0; i < 2; ++i) { int R, C; stage_rc(tid * 16 + i * 8192, R, C); const int Rb = Epi::PERM ? ((R & ~31) + perm32(R & 31)) : R;
        voffA[i] = (unsigned)(R * g.lda + C) * 2u; voffB[i] = (unsigned)(Rb * K + C) * 2u; gR[i] = R; gC[i] = (unsigned)C * 2u; }
    unsigned gA[2][2], gN[2][2];
#define PG8_GLOAD(dst, pm_) do { _Pragma("unroll") for (int _h = 0; _h < 2; ++_h) _Pragma("unroll") for (int _i = 0; _i < 2; ++_i) \
        dst[_h][_i] = (unsigned)g.rowtok[(pm_) * BM + _h * HALF + gR[_i]] * (unsigned)(g.lda * 2) + gC[_i]; } while (0)
    const size_t kstep = (size_t)(BK * 2);
    const size_t hstepA = (size_t)HALF * g.lda * 2, hstepB = (size_t)HALF * K * 2;
    const unsigned ldsw = (unsigned)wid * 1024u;
    const int aoff = lds_byte(wr * 64 + fr, fq * 8), boff = lds_byte(wc * 32 + fr, fq * 8);
#define PG8_SA(b, h) (((b) * 2 + (h)) * HTB)
#define PG8_SB(b, h) ((4 + (b) * 2 + (h)) * HTB)
#define PG8_STAGE(bufoff, gbase, voff) do { _Pragma("unroll") for (int _i = 0; _i < 2; ++_i) \
        __builtin_amdgcn_global_load_lds((const unsigned*)((const char*)(gbase) + (voff)[_i]), (LAS unsigned*)(lds + (bufoff) + ldsw + _i * 8192), 16, 0, 0); } while (0)
#define PG8_STAGE_A(bufoff, gbase, h, OFFS) do { if constexpr (GATHER) { PG8_STAGE(bufoff, gbase, OFFS[h]); } else { PG8_STAGE(bufoff, (gbase) + (h) * hstepA, voffA); } } while (0)
#define PG8_LDA(dst, b, h) do { _Pragma("unroll") for (int m = 0; m < 4; ++m) _Pragma("unroll") for (int k = 0; k < 2; ++k) dst[m][k] = *(const LAS bf16x8*)(lds + PG8_SA(b, h) + aoff + m * 2048 + k * 1024); } while (0)
#define PG8_LDB(dst, b, h) do { _Pragma("unroll") for (int n = 0; n < 2; ++n) _Pragma("unroll") for (int k = 0; k < 2; ++k) dst[n][k] = *(const LAS bf16x8*)(lds + PG8_SB(b, h) + boff + n * 2048 + k * 1024); } while (0)
#define PG8_MMA(ai, bj, At, Bt) do { __builtin_amdgcn_s_setprio(1); _Pragma("unroll") for (int m = 0; m < 4; ++m) _Pragma("unroll") for (int n = 0; n < 2; ++n) _Pragma("unroll") for (int k = 0; k < 2; ++k) \
        acc[ai][bj][m][n] = __builtin_amdgcn_mfma_f32_16x16x32_bf16(Bt[n][k], At[m][k], acc[ai][bj][m][n], 0, 0, 0); __builtin_amdgcn_s_setprio(0); } while (0)
#define PG8_WAIT_V(n) asm volatile("s_waitcnt vmcnt(" #n ")" ::: "memory")
#define PG8_WAIT_L(n) asm volatile("s_waitcnt lgkmcnt(" #n ")" ::: "memory")
#define PG8_BAR __builtin_amdgcn_s_barrier()
#define PG8_SCHED __builtin_amdgcn_sched_barrier(0)
    Unit cur, nxt; int ui = 0;
    if (!S.next(0, cur)) return;
    f32x4 acc[2][2][4][2];
#pragma unroll
    for (int a = 0; a < 2; ++a)
#pragma unroll
        for (int b = 0; b < 2; ++b)
#pragma unroll
            for (int m = 0; m < 4; ++m)
#pragma unroll
                for (int n = 0; n < 2; ++n) acc[a][b][m][n] = (f32x4){0.f, 0.f, 0.f, 0.f};
    bf16x8 At[4][2], B0[2][2], B1[2][2];
    const char* cA = (const char*)g.A + cur.aoff; const char* cB = (const char*)g.Bt + cur.boff;
    if constexpr (GATHER) { PG8_GLOAD(gA, cur.pm); } else { gA[0][0] = gA[0][1] = gA[1][0] = gA[1][1] = 0u; }
#pragma unroll
    for (int _h = 0; _h < 2; ++_h) { gN[_h][0] = gA[_h][0]; gN[_h][1] = gA[_h][1]; }
    PG8_STAGE(PG8_SB(0, 0), cB, voffB); PG8_STAGE(PG8_SB(0, 1), cB + hstepB, voffB); PG8_STAGE_A(PG8_SA(0, 0), cA, 0, gA); PG8_STAGE_A(PG8_SA(0, 1), cA, 1, gA);
    if (wr == 1) PG8_BAR;
    PG8_WAIT_V(2); PG8_BAR;
    PG8_STAGE(PG8_SB(1, 0), cB + kstep, voffB); PG8_STAGE_A(PG8_SA(1, 0), cA + kstep, 0, gA); PG8_STAGE(PG8_SB(1, 1), cB + hstepB + kstep, voffB);
    PG8_WAIT_V(6); PG8_BAR;
    for (;;) {
        const bool has_next = S.next(ui + 1, nxt);
        const char* nA = has_next ? (const char*)g.A + nxt.aoff : cA; const char* nB = has_next ? (const char*)g.Bt + nxt.boff : cB;
        if constexpr (GATHER) { if (has_next) { PG8_GLOAD(gN, nxt.pm); } else {
#pragma unroll
            for (int _h = 0; _h < 2; ++_h) { gN[_h][0] = gA[_h][0]; gN[_h][1] = gA[_h][1]; } } }
        asm volatile(".p2align 6\n\ts_nop 0" ::: "memory");
        for (int t = 0; t < nt; t += 2) {
            const bool last = (t == nt - 2);
            const char* a1 = cA + (size_t)(t + 1) * kstep;
            const char* a2 = last ? nA : cA + (size_t)(t + 2) * kstep; const char* b2 = last ? nB : cB + (size_t)(t + 2) * kstep;
            const char* a3 = a2 + kstep; const char* b3 = b2 + kstep;
            unsigned g2[2][2];
#pragma unroll
            for (int _h = 0; _h < 2; ++_h) { g2[_h][0] = last ? gN[_h][0] : gA[_h][0]; g2[_h][1] = last ? gN[_h][1] : gA[_h][1]; }
            PG8_LDB(B0, 0, 0); PG8_LDB(B1, 0, 1); PG8_SCHED; PG8_LDA(At, 0, 0); PG8_STAGE_A(PG8_SA(1, 1), a1, 1, gA);
            PG8_WAIT_V(8); PG8_WAIT_L(0); PG8_BAR; PG8_MMA(0, 0, At, B0); PG8_MMA(0, 1, At, B1); PG8_BAR; PG8_SCHED;
            PG8_LDA(At, 0, 1); PG8_STAGE(PG8_SB(0, 0), b2, voffB); PG8_STAGE(PG8_SB(0, 1), b2 + hstepB, voffB); PG8_STAGE_A(PG8_SA(0, 0), a2, 0, g2);
            PG8_WAIT_V(8); PG8_WAIT_L(0); PG8_BAR; PG8_MMA(1, 0, At, B0); PG8_MMA(1, 1, At, B1); PG8_BAR; PG8_SCHED;
            PG8_LDB(B0, 1, 0); PG8_LDB(B1, 1, 1); PG8_SCHED; PG8_LDA(At, 1, 0); PG8_STAGE_A(PG8_SA(0, 1), a2, 1, g2);
            PG8_WAIT_V(8); PG8_WAIT_L(0); PG8_BAR; PG8_MMA(0, 0, At, B0); PG8_MMA(0, 1, At, B1); PG8_BAR; PG8_SCHED;
            PG8_LDA(At, 1, 1); PG8_STAGE(PG8_SB(1, 0), b3, voffB); PG8_STAGE(PG8_SB(1, 1), b3 + hstepB, voffB); PG8_STAGE_A(PG8_SA(1, 0), a3, 0, g2);
            PG8_WAIT_V(8); PG8_WAIT_L(0); PG8_BAR; PG8_MMA(1, 0, At, B0); PG8_MMA(1, 1, At, B1); PG8_BAR; PG8_SCHED;
        }
        if (wr == 0) PG8_BAR;
        E(acc, cur, wr, wc, fr, fq);
        if (!has_next) break;
#pragma unroll
        for (int a = 0; a < 2; ++a)
#pragma unroll
            for (int b = 0; b < 2; ++b)
#pragma unroll
                for (int m = 0; m < 4; ++m)
#pragma unroll
                    for (int n = 0; n < 2; ++n) acc[a][b][m][n] = (f32x4){0.f, 0.f, 0.f, 0.f};
        cur = nxt; cA = nA; cB = nB; ++ui;
#pragma unroll
        for (int _h = 0; _h < 2; ++_h) { gA[_h][0] = gN[_h][0]; gA[_h][1] = gN[_h][1]; }
        if (wr == 1) PG8_BAR;
    }
    PG8_WAIT_V(0);
    PG8_BAR;
#undef PG8_SA
#undef PG8_SB
#undef PG8_STAGE
#undef PG8_STAGE_A
#undef PG8_GLOAD
#undef PG8_LDA
#undef PG8_LDB
#undef PG8_MMA
#undef PG8_WAIT_V
#undef PG8_WAIT_L
#undef PG8_BAR
#undef PG8_SCHED
}
}

#define XB_TMO      128
#define XB_XCNT(j)  (256  + 64 * (j))
#define XB_XSUB(j)  (1280 + 64 * (j))
#define XB_XGEN(j)  (2304 + 64 * (j))
#define XB_TOP      3328
#define XB_TOPGEN   3392
#define XCD_BAR_WORDS 3456
#define XB_SPIN_CAP (1u << 18)
__device__ __forceinline__ unsigned xb_ld(unsigned* p)              { return __hip_atomic_load(p, __ATOMIC_RELAXED, __HIP_MEMORY_SCOPE_AGENT); }
__device__ __forceinline__ unsigned xb_add(unsigned* p, unsigned v) { return __hip_atomic_fetch_add(p, v, __ATOMIC_RELAXED, __HIP_MEMORY_SCOPE_AGENT); }
__device__ __forceinline__ unsigned xb_xcc_id() { return (unsigned)__builtin_amdgcn_s_getreg((3 << 11) | 20) & 0xFu; }
#define XB_SPIN(cond, bar) do { unsigned _sp = 0; while (cond) { __builtin_amdgcn_s_sleep(1); \
    if ((++_sp & 255u) == 0u) { if (xb_ld(&(bar)[XB_TMO])) break; if (_sp > XB_SPIN_CAP) { atomicAdd(&(bar)[XB_TMO], 1u); break; } } } } while (0)
struct XcdBarrier { unsigned* bar; unsigned x; volatile LAS unsigned* st; };
__device__ __forceinline__ XcdBarrier xcd_barrier_post(unsigned* bar, volatile LAS unsigned* st) {
    XcdBarrier b; b.bar = bar; b.x = xb_xcc_id(); b.st = st;
    if (threadIdx.x == 0) (void)xb_add(&bar[XB_XCNT(b.x)], 1u);
    return b;
}
__device__ __forceinline__ void xcd_barrier_complete(unsigned* bar, unsigned x, unsigned& nloc, unsigned& nx) {
    const unsigned G = gridDim.x * gridDim.y * gridDim.z;
    unsigned sum, cnt, mine, sp = 0u;
    for (;;) {
        sum = 0u; cnt = 0u; mine = 0u;
#pragma unroll
        for (unsigned j = 0; j < 16; ++j) { const unsigned c = xb_ld(&bar[XB_XCNT(j)]); sum += c; cnt += (c > 0u) ? 1u : 0u; mine = (j == x) ? c : mine; }
        if (sum == G) break;
        __builtin_amdgcn_s_sleep(1);
        if ((++sp & 255u) == 0u) { if (xb_ld(&bar[XB_TMO])) break; if (sp > XB_SPIN_CAP) { atomicAdd(&bar[XB_TMO], 1u); break; } }
    }
    nloc = mine > 0u ? mine : 1u; nx = cnt > 0u ? cnt : 1u;
}
__device__ __forceinline__ void xcd_barrier(const XcdBarrier& b) {
    asm volatile("s_waitcnt vmcnt(0)" ::: "memory");
    __syncthreads();
    if (threadIdx.x == 0) {
        unsigned* bar = b.bar;
        __builtin_amdgcn_s_waitcnt(0);
        unsigned nloc = b.st[0], nx = b.st[1];
        if (nloc == 0u) { xcd_barrier_complete(bar, b.x, nloc, nx); b.st[0] = nloc; b.st[1] = nx; }
        const unsigned old = xb_add(&bar[XB_XSUB(b.x)], 1u);
        const unsigned gen = old / nloc;
        if (old + 1u == (gen + 1u) * nloc) {
            __builtin_amdgcn_fence(__ATOMIC_RELEASE, "agent");
            asm volatile("s_waitcnt vmcnt(0)" ::: "memory");
            const unsigned og = xb_add(&bar[XB_TOP], 1u);
            const unsigned tg = og / nx;
            if (og + 1u == (tg + 1u) * nx) xb_add(&bar[XB_TOPGEN], 1u);
            else XB_SPIN(xb_ld(&bar[XB_TOPGEN]) == tg, bar);
            __builtin_amdgcn_fence(__ATOMIC_ACQUIRE, "agent");
            xb_add(&bar[XB_XGEN(b.x)], 1u);
            asm volatile("s_waitcnt vmcnt(0)" ::: "memory");
        } else {
            __builtin_amdgcn_fence(__ATOMIC_ACQUIRE, "agent");
            XB_SPIN(xb_ld(&bar[XB_XGEN(b.x)]) == gen, bar);
            asm volatile("s_waitcnt vmcnt(0)" ::: "memory");
        }
    }
    __syncthreads();
}

struct Args {
    const float* in[22];
    float* out; unsigned char* ws;
    int ph_lo, ph_hi;
};
enum { I_X = 0, I_LNE, I_WINE, I_CONVW, I_ALOG, I_DTB, I_QG, I_KG, I_SINK, I_GDNG, I_WOUTE, I_LNO, I_WINO, I_WOUTO, I_LNF, I_WRG, I_BRG, I_WRE, I_BRE, I_WG, I_WU, I_WD };

__device__ __forceinline__ void transpose_item(const float* W, int K, int ldw, int ncols, bf16_t* WT, int mode, LAS float* scr, int item, int lane) {
    const int nblk = ncols / 32, kb = item / nblk, nb = item % nblk, k0 = 64 * kb, n0 = 32 * nb;
#pragma unroll 8
    for (int i = 0; i < 32; ++i) { const int kk = 2 * i + (lane >> 5); scr[kk * 33 + (lane & 31)] = W[(size_t)(k0 + kk) * ldw + n0 + (lane & 31)]; }
    asm volatile("s_waitcnt lgkmcnt(0)" ::: "memory");
    const int c = lane & 7;
#pragma unroll
    for (int j = 0; j < 4; ++j) { const int n = (lane >> 3) + 8 * j; const LAS float* s = scr + (8 * c) * 33 + n;
        u32x4 o; o.x = cvt_pk_bf16(s[0 * 33], s[1 * 33]); o.y = cvt_pk_bf16(s[2 * 33], s[3 * 33]); o.z = cvt_pk_bf16(s[4 * 33], s[5 * 33]); o.w = cvt_pk_bf16(s[6 * 33], s[7 * 33]);
        const int ng = n0 + n; const int row = (mode == 0 || mode == 3) ? ng : (32 * (ng >> 4) + (ng & 15) + (mode == 2 ? 16 : 0));
        if (mode == 3) {
            const int k = k0 + 8 * c; bf16_t* d = WT + (size_t)row * K + 128 * (k >> 7) + 32 * ((k >> 4) & 3) + 8 * ((k >> 2) & 3) + 4 * ((k >> 6) & 1);
            *(u32x2*)d = (u32x2){o.x, o.y}; *(u32x2*)(d + 8) = (u32x2){o.z, o.w};
        } else *(u32x4*)(WT + (size_t)row * K + k0 + 8 * c) = o; }
    asm volatile("s_waitcnt lgkmcnt(0)" ::: "memory");
}
__device__ __forceinline__ void convert_moe(const Args& a, int layer, LAS float* scr, int gw, int ngw, int lane, int which = 3) {
    bf16_t* B1 = (bf16_t*)(a.ws + WS_XB1); bf16_t* B2 = (bf16_t*)(a.ws + (layer == 1 ? WS_XB2L1 : WS_XB2));
    const float* wg = a.in[I_WG] + (size_t)layer * NEXP * D * DEXP; const float* wu = a.in[I_WU] + (size_t)layer * NEXP * D * DEXP; const float* wd = a.in[I_WD] + (size_t)layer * NEXP * DEXP * D;
    constexpr int IG = (D / 64) * (DEXP / 32);
    constexpr int ID = (DEXP / 64) * (D / 32);
    constexpr int PER_E = 2 * IG + ID;
    for (int it = gw; it < NEXP * PER_E; it += ngw) {
        const int e = it / PER_E; int r = it % PER_E;
        if (((r < 2 * IG) ? 1 : 2) & ~which) continue;
        if (r < IG) { transpose_item(wg + (size_t)e * D * DEXP, D, DEXP, DEXP, B1 + (size_t)e * 1024 * 1024, 1, scr, r, lane); continue; } r -= IG;
        if (r < IG) { transpose_item(wu + (size_t)e * D * DEXP, D, DEXP, DEXP, B1 + (size_t)e * 1024 * 1024, 2, scr, r, lane); continue; } r -= IG;
        transpose_item(wd + (size_t)e * DEXP * D, DEXP, D, D, B2 + (size_t)e * 1024 * 512, 3, scr, r, lane);
    }
}

__device__ __forceinline__ void moe_route(const Args& a, int layer, LAS unsigned char* lds, int bid, int G, int tid, int lane, int wave) {
    LAS float* wT = (LAS float*)lds;
    LAS float* lng = (LAS float*)(lds + 147456);
    LAS float* bias = (LAS float*)(lds + 151552);
    LAS int* lcnt = (LAS int*)(lds + 151552 + 256);
    LAS int* lbase = lcnt + 32;
    LAS int* tokE = lbase + 32;
    LAS int* tokR = tokE + 256;
    const float* wrg = a.in[I_WRG] + (size_t)layer * D * 4; const float* wre = a.in[I_WRE] + (size_t)layer * D * 32;
    for (int i = tid; i < 4 * 1024; i += NTHREADS) { const int k = i >> 2, o = i & 3; wT[o * 1024 + k] = wrg[i]; }
    for (int i = tid; i < 32 * 1024; i += NTHREADS) { const int k = i >> 5, o = i & 31; wT[(4 + o) * 1024 + k] = wre[i]; }
    for (int i = tid; i < 1024; i += NTHREADS) lng[i] = a.in[I_LNF][layer * D + i];
    if (tid < 4) bias[tid] = a.in[I_BRG][layer * 4 + tid];
    if (tid >= 64 && tid < 96) bias[4 + tid - 64] = a.in[I_BRE][layer * 32 + tid - 64];
    const float* x = a.out;
    bf16_t* xn = (bf16_t*)(a.ws + WS_XN);
    int* RE = (int*)(a.ws + WS_RE); float* RG = (float*)(a.ws + WS_RG); int* RS = (int*)(a.ws + WS_RS);
    int* gcnt = (int*)(a.ws + WS_CTL) + layer * 32; int* BC = (int*)(a.ws + WS_BC);
    const int tsub = lane >> 4, l16 = lane & 15;
    for (int tile = bid; tile < T / 128; tile += G) {
        __syncthreads();
        if (tid < 32) lcnt[tid] = 0;
        __syncthreads();
        for (int iter = 0; iter < 4; ++iter) {
            const int tl = wave * 16 + iter * 4 + tsub, t = tile * 128 + tl;
            const f32x4* xr = (const f32x4*)(x + (size_t)t * D) + l16;
            f32x4 v[16]; float ss = 0.f;
#pragma unroll
            for (int j = 0; j < 16; ++j) { v[j] = xr[16 * j]; ss += (v[j][0] * v[j][0] + v[j][1] * v[j][1]) + (v[j][2] * v[j][2] + v[j][3] * v[j][3]); }
            ss += __shfl_xor(ss, 1); ss += __shfl_xor(ss, 2); ss += __shfl_xor(ss, 4); ss += __shfl_xor(ss, 8);
            const float rstd = rsqrtf(ss * (1.f / D) + EPS);
            unsigned long long* o8 = (unsigned long long*)(xn + (size_t)t * D) + l16;
#pragma unroll
            for (int j = 0; j < 16; ++j) { v[j] = v[j] * rstd * *((const LAS f32x4*)lng + l16 + 16 * j);
                o8[16 * j] = (unsigned long long)cvt_pk_bf16(v[j][0], v[j][1]) | ((unsigned long long)cvt_pk_bf16(v[j][2], v[j][3]) << 32); }
            LAS float* lgs = (LAS float*)(lds + 154624) + (wave * 4 + tsub) * 40;
#pragma unroll 2
            for (int o = 0; o < 36; ++o) { float acc = 0.f;
#pragma unroll
                for (int j = 0; j < 16; ++j) { const f32x4 w = *((const LAS f32x4*)(wT + o * 1024) + l16 + 16 * j); acc += (v[j][0] * w[0] + v[j][1] * w[1]) + (v[j][2] * w[2] + v[j][3] * w[3]); }
                acc += __shfl_xor(acc, 1); acc += __shfl_xor(acc, 2); acc += __shfl_xor(acc, 4); acc += __shfl_xor(acc, 8);
                if (l16 == 0) lgs[o] = acc + bias[o]; }
            asm volatile("s_waitcnt lgkmcnt(0)" ::: "memory");
            int gi = 0; float gm = lgs[0];
            for (int o = 1; o < 4; ++o) { const float lv = lgs[o]; if (lv > gm) { gm = lv; gi = o; } }
            float gs = 0.f;
            for (int o = 0; o < 4; ++o) gs += __expf(lgs[o] - gm);
            const float grp_p = 1.f / gs;
            const LAS float* le = lgs + 4 + 8 * gi;
            int e1 = 0; float m1 = le[0];
            for (int k = 1; k < 8; ++k) { const float lv = le[k]; if (lv > m1) { m1 = lv; e1 = k; } }
            int e2 = -1; float m2 = -3.0e38f;
            for (int k = 0; k < 8; ++k) { const float lv = le[k]; if (k != e1 && lv > m2) { m2 = lv; e2 = k; } }
            const float p2 = __expf(m2 - m1);
            const float g1 = grp_p / (1.f + p2), g2 = grp_p * p2 / (1.f + p2);
            if (l16 == 0) {
                const int ea = gi * 8 + e1, eb = gi * 8 + e2;
                RE[(size_t)t * 2] = ea; RE[(size_t)t * 2 + 1] = eb; RG[(size_t)t * 2] = g1; RG[(size_t)t * 2 + 1] = g2;
                tokE[tl * 2] = ea; tokE[tl * 2 + 1] = eb;
                atomicAdd((int*)(lcnt + ea), 1); atomicAdd((int*)(lcnt + eb), 1);
            }
        }
        __syncthreads();
        if (tid < 32) { const int c = lcnt[tid]; BC[tile * 32 + tid] = c; atomicAdd(gcnt + tid, c); }
        if (tid < 256) { const int e = tokE[tid]; int rank = 0; for (int j = 0; j < tid; ++j) rank += (tokE[j] == e) ? 1 : 0; RS[(size_t)tile * 256 + tid] = rank; }
    }
}
__device__ __forceinline__ void moe_route2(const Args& a, int layer, LAS unsigned char* lds, int bid, int G, int tid, int lane, int wave) {
    LAS bf16_t* wh = (LAS bf16_t*)lds;
    LAS bf16_t* wl = (LAS bf16_t*)(lds + 74304);
    LAS float* lng = (LAS float*)(lds + 148608);
    LAS float* bias = (LAS float*)(lds + 152704);
    LAS int* lcnt = (LAS int*)(lds + 152704 + 256);
    LAS int* tokE = lcnt + 64;
    LAS float* lgs = (LAS float*)lds;
    const float* wrg = a.in[I_WRG] + (size_t)layer * D * 4; const float* wre = a.in[I_WRE] + (size_t)layer * D * 32;
    const float* x = a.out;
    bf16_t* xn = (bf16_t*)(a.ws + WS_XN);
    int* RE = (int*)(a.ws + WS_RE); float* RG = (float*)(a.ws + WS_RG); int* RS = (int*)(a.ws + WS_RS);
    int* gcnt = (int*)(a.ws + WS_CTL) + layer * 32; int* BC = (int*)(a.ws + WS_BC);
    const int fr = lane & 15, fq = lane >> 4;
    { int* rowtok = (int*)(a.ws + WS_ROWTOK); for (int i = bid * NTHREADS + tid; i < ROWS_PAD; i += G * NTHREADS) rowtok[i] = 0; }
    for (int tile = bid; tile < T / 128; tile += G) {
        __syncthreads();
        {
            const u32x4* src = (const u32x4*)(a.ws + WS_WHL + (size_t)layer * 148608);
            u32x4 cv[19];
#pragma unroll
            for (int j = 0; j < 19; ++j) { const int i = tid + j * NTHREADS; cv[j] = (i < 9288) ? src[i] : (u32x4){0u, 0u, 0u, 0u}; }
#pragma unroll
            for (int j = 0; j < 19; ++j) { const int i = tid + j * NTHREADS; if (i < 9288) *(LAS u32x4*)(lds + 16 * i) = cv[j]; }
        }
        { const float l0 = a.in[I_LNF][layer * D + tid], l1 = a.in[I_LNF][layer * D + NTHREADS + tid]; lng[tid] = l0; lng[NTHREADS + tid] = l1; }
        if (tid < 32) bias[tid] = a.in[I_BRE][layer * 32 + tid];
        if (tid >= 64 && tid < 68) bias[32 + tid - 64] = a.in[I_BRG][layer * 4 + tid - 64];
        if (tid < 32) lcnt[tid] = 0;
        __syncthreads();
        const int t = tile * 128 + wave * 16 + fr;
        const f32x4* xr = (const f32x4*)(x + (size_t)t * D) + 2 * fq;
        float ss;
        { const f32x4 p4 = ((const f32x4*)((const float*)(a.ws + WS_SSQ) + (size_t)t * 16))[fq]; ss = (p4[0] + p4[1]) + (p4[2] + p4[3]); }
        ss += __shfl_xor(ss, 16); ss += __shfl_xor(ss, 32);
        const float rstd = rsqrtf(ss * (1.f / D) + EPS);
        f32x4 acc[3];
#pragma unroll
        for (int nt = 0; nt < 3; ++nt) acc[nt] = (f32x4){0.f, 0.f, 0.f, 0.f};
        const int brow2 = (32 + fr) < 36 ? (32 + fr) : 35;
        f32x4 xa[8], xb[8];
#define RT_LOAD(X, g) do { _Pragma("unroll") for (int i = 0; i < 4; ++i) { X[2 * i] = xr[8 * (4 * (g) + i)]; X[2 * i + 1] = xr[8 * (4 * (g) + i) + 1]; } } while (0)
#define RT_PROC(X, g) do { _Pragma("unroll") for (int i = 0; i < 4; ++i) { const int s = 4 * (g) + i; const f32x4 v0 = X[2 * i], v1 = X[2 * i + 1]; \
            const f32x4 g0 = *(const LAS f32x4*)(lng + 32 * s + 8 * fq), g1 = *(const LAS f32x4*)(lng + 32 * s + 8 * fq + 4); \
            float v[8] = {v0[0] * rstd * g0[0], v0[1] * rstd * g0[1], v0[2] * rstd * g0[2], v0[3] * rstd * g0[3], v1[0] * rstd * g1[0], v1[1] * rstd * g1[1], v1[2] * rstd * g1[2], v1[3] * rstd * g1[3]}; \
            u32x4 hw; hw.x = cvt_pk_bf16(v[0], v[1]); hw.y = cvt_pk_bf16(v[2], v[3]); hw.z = cvt_pk_bf16(v[4], v[5]); hw.w = cvt_pk_bf16(v[6], v[7]); \
            *(u32x4*)(xn + (size_t)t * D + 32 * s + 8 * fq) = hw; \
            u32x4 lw; lw.x = cvt_pk_bf16(v[0] - lo_bf(hw.x), v[1] - hi_bf(hw.x)); lw.y = cvt_pk_bf16(v[2] - lo_bf(hw.y), v[3] - hi_bf(hw.y)); lw.z = cvt_pk_bf16(v[4] - lo_bf(hw.z), v[5] - hi_bf(hw.z)); lw.w = cvt_pk_bf16(v[6] - lo_bf(hw.w), v[7] - hi_bf(hw.w)); \
            const bf16x8 ah = __builtin_bit_cast(bf16x8, hw), al = __builtin_bit_cast(bf16x8, lw); \
            _Pragma("unroll") for (int nt = 0; nt < 3; ++nt) { const int row = (nt < 2) ? (16 * nt + fr) : brow2; \
                const bf16x8 bh = *(const LAS bf16x8*)(wh + row * 1032 + 32 * s + 8 * fq), bl = *(const LAS bf16x8*)(wl + row * 1032 + 32 * s + 8 * fq); \
                acc[nt] = mfma16(ah, bh, acc[nt]); acc[nt] = mfma16(al, bh, acc[nt]); acc[nt] = mfma16(ah, bl, acc[nt]); } } } while (0)
        RT_LOAD(xa, 0);
        for (int gp = 0; gp < 4; ++gp) {
            RT_LOAD(xb, 2 * gp + 1);
            RT_PROC(xa, 2 * gp);
            if (gp < 3) RT_LOAD(xa, 2 * gp + 2);
            RT_PROC(xb, 2 * gp + 1);
        }
#undef RT_LOAD
#undef RT_PROC
        __syncthreads();
        {
            LAS float* lw_ = lgs + wave * (16 * 40);
#pragma unroll
            for (int nt = 0; nt < 3; ++nt) { const int o = 16 * nt + fr; if (o < 36) { const float bo = bias[o];
#pragma unroll
                for (int rg = 0; rg < 4; ++rg) lw_[(4 * fq + rg) * 40 + o] = acc[nt][rg] + bo; } }
        }
        asm volatile("s_waitcnt lgkmcnt(0)" ::: "memory");
        if (lane < 16) {
            const LAS float* lg = lgs + wave * (16 * 40) + lane * 40;
            const int tl = wave * 16 + lane, tt = tile * 128 + tl;
            int gi = 0; float gm = lg[32];
            for (int o = 1; o < 4; ++o) { const float lv = lg[32 + o]; if (lv > gm) { gm = lv; gi = o; } }
            float gs = 0.f;
            for (int o = 0; o < 4; ++o) gs += __expf(lg[32 + o] - gm);
            const float grp_p = 1.f / gs;
            const LAS float* le = lg + 8 * gi;
            int e1 = 0; float m1 = le[0];
            for (int k = 1; k < 8; ++k) { const float lv = le[k]; if (lv > m1) { m1 = lv; e1 = k; } }
            int e2 = (e1 == 0) ? 1 : 0; float m2 = le[e2];
            for (int k = 0; k < 8; ++k) { const float lv = le[k]; if (k != e1 && lv > m2) { m2 = lv; e2 = k; } }
            const float p2 = __expf(m2 - m1);
            const float g1 = grp_p / (1.f + p2), g2 = grp_p * p2 / (1.f + p2);
            const int ea = gi * 8 + e1, eb = gi * 8 + e2;
            RE[(size_t)tt * 2] = ea; RE[(size_t)tt * 2 + 1] = eb; RG[(size_t)tt * 2] = g1; RG[(size_t)tt * 2 + 1] = g2;
            tokE[tl * 2] = ea; tokE[tl * 2 + 1] = eb;
            atomicAdd((int*)(lcnt + ea), 1); atomicAdd((int*)(lcnt + eb), 1);
        }
        __syncthreads();
        if (tid < 32) { const int c = lcnt[tid]; BC[tile * 32 + tid] = c; atomicAdd(gcnt + tid, c); }
        if (tid < 256) { const int e = tokE[tid]; int rank = 0; for (int j = 0; j < tid; ++j) rank += (tokE[j] == e) ? 1 : 0; RS[(size_t)tile * 256 + tid] = rank; }
    }
}
__device__ __forceinline__ void moe_tables(const Args& a, int layer, LAS int* tab, int tid) {
    __syncthreads();
    if (tid < 64) {
        const int* gcnt = (const int*)(a.ws + WS_CTL) + layer * 32;
        const int c = (tid < 32) ? __hip_atomic_load(gcnt + tid, __ATOMIC_RELAXED, __HIP_MEMORY_SCOPE_AGENT) : 0;
        const int nt = (c + 255) >> 8;
        int incl = nt;
#pragma unroll
        for (int o = 1; o < 32; o <<= 1) { const int y = __shfl_up(incl, o); if (tid >= o) incl += y; }
        const int excl = incl - nt;
        if (tid < 32) { tab[tid] = excl * 256; for (int i = 0; i < nt; ++i) tab[64 + excl + i] = tid; }
        if (tid == 31) tab[32] = incl;
    }
    __syncthreads();
}
__device__ __forceinline__ void moe_scatter(const Args& a, int layer, LAS unsigned char* lds, int bid, int G, int tid, int lane, int wave) {
    LAS int* tab = (LAS int*)(lds + 131072);
    LAS int* psum = (LAS int*)(lds + 131072 + 4096);
    moe_tables(a, layer, tab, tid);
    int* rowtok = (int*)(a.ws + WS_ROWTOK);
    const int* RE = (const int*)(a.ws + WS_RE); const int* RS = (const int*)(a.ws + WS_RS); int* RP = (int*)(a.ws + WS_RP); const int* BC = (const int*)(a.ws + WS_BC);
    for (int tile = bid; tile < T / 128; tile += G) {
        __syncthreads();
        { const int e = tid & 31, part = tid >> 5; int bc[16];
#pragma unroll
            for (int i = 0; i < 16; ++i) bc[i] = BC[(part * 16 + i) * 32 + e];
            int sacc = 0;
#pragma unroll
            for (int i = 0; i < 16; ++i) sacc += (part * 16 + i < tile) ? bc[i] : 0;
            psum[part * 32 + e] = sacc; }
        __syncthreads();
        if (tid < 32) { int sacc = 0; for (int p2 = 0; p2 < 16; ++p2) sacc += psum[p2 * 32 + tid]; psum[512 + tid] = sacc + tab[tid]; }
        __syncthreads();
        if (tid < 128) {
            const int t = tile * 128 + tid;
            const int e0 = RE[(size_t)t * 2], e1 = RE[(size_t)t * 2 + 1];
            const int r0 = psum[512 + e0] + RS[(size_t)t * 2], r1 = psum[512 + e1] + RS[(size_t)t * 2 + 1];
            RP[(size_t)t * 2] = r0; RP[(size_t)t * 2 + 1] = r1; rowtok[r0] = t; rowtok[r1] = t;
        }
    }
}
__device__ __forceinline__ void moe_gemm1(const Args& a, int layer, LAS unsigned char* lds, int bid, int G, int tid) {
    LAS int* tab = (LAS int*)(lds + 131072);
    __syncthreads();
    pg8::Gemm g{(const bf16_t*)(a.ws + WS_XN), (const bf16_t*)(a.ws + WS_XB1), D, D, (const int*)(a.ws + WS_ROWTOK)};
    pg8::GroupedOrder S{tab + 64, tab[32], G, bid, 0, D, (size_t)1024 * 1024 * 2};
    pg8::EpiSwiGLU E{(bf16_t*)(a.ws + WS_HID)};
    pg8::gemm_phase<pg8::EpiSwiGLU, pg8::GroupedOrder, true>(lds, g, S, E);
    asm volatile("s_waitcnt vmcnt(0)" ::: "memory");
    __syncthreads();
    if (tid == 0) {
        int* rdy = (int*)(a.ws + WS_CTL + 1024) + layer * 320;
        const int nu = tab[32] * 4;
        for (int L = bid; L < nu; L += G) (void)__hip_atomic_fetch_add(rdy + (L >> 2), 1, __ATOMIC_RELAXED, __HIP_MEMORY_SCOPE_AGENT);
    }
}
__device__ __forceinline__ void moe_gemm2(const Args& a, int layer, LAS unsigned char* lds, int bid, int G, int tid) {
    LAS int* tab = (LAS int*)(lds + 131072);
    __syncthreads();
    pg8::Gemm g{(const bf16_t*)(a.ws + WS_HID), (const bf16_t*)(a.ws + (layer == 1 ? WS_XB2L1 : WS_XB2)), DEXP, DEXP, nullptr};
    LAS int* order = tab + 512;
    { const int nt = tab[32], r1 = (nt * 4) % G, per = G >> 2, e0 = (r1 + 3) >> 2;
        const int pn_ = nt / per, on_ = nt % per, NE = pn_ * (per - e0) + (on_ > e0 ? on_ - e0 : 0);
        for (int rt = tid; rt < nt; rt += NTHREADS) { const int p = rt / per, o = rt % per;
            if (o >= e0) order[p * (per - e0) + (o - e0)] = rt; else order[NE + p * e0 + o] = rt; } }
    if (tid == 0) tab[901] = 0;
    __syncthreads();
    pg8::DynGroupedOrder S{tab + 64, order, tab[32], (int*)(a.ws + WS_CTL + 512) + layer, (const int*)(a.ws + WS_CTL + 1024) + layer * 320, (volatile LAS int*)(tab + 900), tid, DEXP, DEXP, (size_t)1024 * 512 * 2};
    pg8::EpiBf16 E{(bf16_t*)(a.ws + WS_XROWS), D};
    pg8::gemm_phase(lds, g, S, E);
}
template <bool NORM>
__device__ __forceinline__ void moe_combine(const Args& a, const float* gain, bf16_t* hout, int gw, int ngw, int lane) {
    const bf16_t* y = (const bf16_t*)(a.ws + WS_XROWS);
    const int* RP = (const int*)(a.ws + WS_RP); const float* RG = (const float*)(a.ws + WS_RG);
    f32x4 gn[4];
    if (NORM) {
#pragma unroll
        for (int j = 0; j < 4; ++j) gn[j] = *((const f32x4*)gain + lane + 64 * j);
    }
    const int ntok = (T - gw + ngw - 1) / ngw;
    int lp0 = 0, lp1 = 0; float lg0 = 0.f, lg1 = 0.f;
    if (lane < ntok) { const size_t tt = (size_t)(gw + lane * ngw); lp0 = RP[tt * 2]; lp1 = RP[tt * 2 + 1]; lg0 = RG[tt * 2]; lg1 = RG[tt * 2 + 1]; }
    f32x4 xv[4], xn_[4]; u32x2 ya[4], yb[4], yan[4], ybn[4];
#define CMB_LOAD(k, XV, YA, YB) do { const int _p0 = __builtin_amdgcn_readlane(lp0, (k)), _p1 = __builtin_amdgcn_readlane(lp1, (k)); \
        const f32x4* _xr = (const f32x4*)(a.out + (size_t)(gw + (k) * ngw) * D) + lane; const u32x2* _y0 = (const u32x2*)(y + (size_t)_p0 * D) + lane; const u32x2* _y1 = (const u32x2*)(y + (size_t)_p1 * D) + lane; \
        _Pragma("unroll") for (int j = 0; j < 4; ++j) { XV[j] = _xr[64 * j]; YA[j] = _y0[64 * j]; YB[j] = _y1[64 * j]; } } while (0)
    if (ntok > 0) CMB_LOAD(0, xv, ya, yb);
    for (int k = 0; k < ntok; ++k) {
        const int t = gw + k * ngw;
        if (k + 1 < ntok) CMB_LOAD(k + 1, xn_, yan, ybn);
        const float g0 = __builtin_bit_cast(float, __builtin_amdgcn_readlane(__builtin_bit_cast(int, lg0), k)), g1 = __builtin_bit_cast(float, __builtin_amdgcn_readlane(__builtin_bit_cast(int, lg1), k));
        f32x4* xr = (f32x4*)(a.out + (size_t)t * D) + lane;
        f32x4 v[4]; float s = 0.f;
#pragma unroll
        for (int j = 0; j < 4; ++j) { v[j] = xv[j]; const u32x2 a0 = ya[j], a1 = yb[j];
            v[j][0] += g0 * lo_bf(a0.x) + g1 * lo_bf(a1.x); v[j][1] += g0 * hi_bf(a0.x) + g1 * hi_bf(a1.x); v[j][2] += g0 * lo_bf(a0.y) + g1 * lo_bf(a1.y); v[j][3] += g0 * hi_bf(a0.y) + g1 * hi_bf(a1.y);
            xr[64 * j] = v[j]; s += (v[j][0] * v[j][0] + v[j][1] * v[j][1]) + (v[j][2] * v[j][2] + v[j][3] * v[j][3]); }
        if (NORM) {
            const float rstd = rsqrtf(wave_sum(s) * (1.f / D) + EPS);
            unsigned long long* o8 = (unsigned long long*)(hout + (size_t)t * D) + lane;
#pragma unroll
            for (int j = 0; j < 4; ++j) { const f32x4 w = v[j] * rstd * gn[j]; o8[64 * j] = (unsigned long long)cvt_pk_bf16(w[0], w[1]) | ((unsigned long long)cvt_pk_bf16(w[2], w[3]) << 32); }
        }
#pragma unroll
        for (int j = 0; j < 4; ++j) { xv[j] = xn_[j]; ya[j] = yan[j]; yb[j] = ybn[j]; }
    }
#undef CMB_LOAD
}


__device__ __forceinline__ Args load_args() {
#if defined(__HIP_DEVICE_COMPILE__)
    const __attribute__((address_space(4))) Args* kap = (const __attribute__((address_space(4))) Args*)__builtin_amdgcn_kernarg_segment_ptr(); asm volatile("" : "+s"(kap));
    Args a;
#pragma unroll
    for (int i = 0; i < 22; ++i) a.in[i] = kap->in[i];
    a.out = kap->out; a.ws = kap->ws; a.ph_lo = kap->ph_lo; a.ph_hi = kap->ph_hi; return a;
#else
    return Args{};
#endif
}
constexpr int NPHASE = 20;
#define PHASE_IDS int tid_o = threadIdx.x; asm volatile("" : "+v"(tid_o)); const int tid = tid_o, lane = tid & 63, wave = __builtin_amdgcn_readfirstlane(tid >> 6); const int gw = bid * NWAVES + wave; (void)gw; (void)lane; \
    const Args args = load_args(); unsigned char* const ws = args.ws; (void)ws
#ifndef PHHI
#define PHHI NPHASE
#endif

__global__ void __launch_bounds__(NTHREADS, 2) fwd_kernel(Args args_) {
    extern __shared__ __attribute__((aligned(16))) unsigned char lds_raw[];
    LAS unsigned char* lds = (LAS unsigned char*)lds_raw;
    const int tid = threadIdx.x, lane = tid & 63, wave = __builtin_amdgcn_readfirstlane(tid >> 6);
    const int G = gridDim.x, bid = blockIdx.x;
    const int gw = bid * NWAVES + wave, ngw = G * NWAVES;
    unsigned char* ws = args_.ws;
    const int lo = args_.ph_lo, hi = args_.ph_hi;
    cg::grid_group grid = cg::this_grid();
    if (tid < 4) ((LAS unsigned*)(lds + LDS_BYTES - 16))[tid] = 0u;
    __syncthreads();
    const XcdBarrier xbar = xcd_barrier_post((unsigned*)(ws + WS_CTL) + 1024, (volatile LAS unsigned*)(lds + LDS_BYTES - 16));
    if (lo < 0) grid.sync();
#ifndef ONLYP
#define ONLYP -1
#endif
#define IN(k) ((ONLYP < 0 || ONLYP == (k)) && lo <= (k) && (k) < hi)
#ifndef SKIPLO
#define SKIPLO 100
#define SKIPHI 100
#endif
#define RUN(k) (IN(k) && !((k) >= SKIPLO && (k) <= SKIPHI))
#define SEAM(k) do { if (IN(k) && IN((k) + 1)) xcd_barrier(xbar); else __syncthreads(); } while (0)

    if (RUN(0)) { PHASE_IDS;
        LAS float* scr = (LAS float*)(lds + wave * 8448);
        {
            constexpr int I0 = (D / 64) * (N0 / 32);
            for (int it = gw; it < I0; it += ngw) transpose_item(args.in[I_WINE], D, EVEN_IN, N0, (bf16_t*)(ws + WS_WIN0), 0, scr, it, lane);
        }
        LAS float* wab = (LAS float*)(lds + 72 * 1024);
        __syncthreads();
        { float wv[16];
#pragma unroll
            for (int j = 0; j < 16; ++j) { const int i = tid + j * NTHREADS; wv[j] = args.in[I_WINE][(size_t)(i >> 3) * EVEN_IN + N0 + (i & 7)]; }
#pragma unroll
            for (int j = 0; j < 16; ++j) { const int i = tid + j * NTHREADS; wab[(i & 7) * 1024 + (i >> 3)] = wv[j]; } }
        __syncthreads();
        {
            const int gi = bid * NTHREADS + tid;
            if (gi < 2 * 36864) { const int layer = gi / 36864, r = gi % 36864; int k, o; float w;
                if (r < 32768) { k = r >> 5; o = r & 31; w = args.in[I_WRE][(size_t)layer * D * 32 + r]; } else { const int r2 = r - 32768; k = r2 >> 2; o = 32 + (r2 & 3); w = args.in[I_WRG][(size_t)layer * D * 4 + r2]; }
                bf16_t* whg = (bf16_t*)(ws + WS_WHL + (size_t)layer * 148608);
                const unsigned short hpart = f2bf(w); whg[o * 1032 + k] = hpart; whg[37152 + o * 1032 + k] = f2bf(w - bf2f(hpart)); }
        }
        const float* x = args.in[I_X]; const float* gain = args.in[I_LNE];
        bf16_t* h0 = (bf16_t*)(ws + WS_HMIX0); float* bab = (float*)(ws + WS_BAB);
        f32x4 gn[4];
#pragma unroll
        for (int j = 0; j < 4; ++j) gn[j] = *((const f32x4*)gain + lane + 64 * j);
        for (int m = gw; m < T; m += ngw) {
            const f32x4* xr = (const f32x4*)(x + (size_t)m * D) + lane;
            f32x4 v[4]; float s = 0.f;
#pragma unroll
            for (int j = 0; j < 4; ++j) { v[j] = xr[64 * j]; s += (v[j][0] * v[j][0] + v[j][1] * v[j][1]) + (v[j][2] * v[j][2] + v[j][3] * v[j][3]); }
            const float rstd = rsqrtf(wave_sum(s) * (1.f / D) + EPS);
            float p[8];
#pragma unroll
            for (int o = 0; o < 8; ++o) p[o] = 0.f;
            unsigned long long* o8 = (unsigned long long*)(h0 + (size_t)m * D) + lane;
#pragma unroll
            for (int j = 0; j < 4; ++j) { v[j] = v[j] * rstd * gn[j];
                o8[64 * j] = (unsigned long long)cvt_pk_bf16(v[j][0], v[j][1]) | ((unsigned long long)cvt_pk_bf16(v[j][2], v[j][3]) << 32);
#pragma unroll
                for (int o = 0; o < 8; ++o) { const f32x4 w = *((const LAS f32x4*)(wab + o * 1024) + lane + 64 * j); p[o] += (v[j][0] * w[0] + v[j][1] * w[1]) + (v[j][2] * w[2] + v[j][3] * w[3]); } }
#pragma unroll
            for (int o = 0; o < 8; ++o) p[o] = wave_sum(p[o]);
            if (lane == 0) { *(f32x4*)(bab + (size_t)m * 8) = (f32x4){p[0], p[1], p[2], p[3]}; *(f32x4*)(bab + (size_t)m * 8 + 4) = (f32x4){p[4], p[5], p[6], p[7]}; }
        }
    }
    SEAM(0);

    if (RUN(1)) { PHASE_IDS;
        pg8::Gemm g{(const bf16_t*)(ws + WS_HMIX0), (const bf16_t*)(ws + WS_WIN0), D, D, nullptr};
        pg8::DenseOrder S; S.init(T, N0, G, bid, D, D);
        pg8::EpiBf16 E{(bf16_t*)(ws + WS_PROJ0), N0};
        pg8::gemm_phase(lds, g, S, E);
        {
            const int nfull = ((T / 256) * (N0 / 256)) % G;
            if (bid >= nfull) {
                asm volatile("s_waitcnt vmcnt(0) lgkmcnt(0)" ::: "memory"); __syncthreads();
                convert_moe(args, 1, (LAS float*)(lds + wave * 8448), (bid - nfull) * NWAVES + wave, (G - nfull) * NWAVES, lane, 2);
            }
        }
    }
    SEAM(1);

    if (RUN(2)) { PHASE_IDS;
        const bf16_t* proj0 = (const bf16_t*)(ws + WS_PROJ0);
        const float* bab = (const float*)(ws + WS_BAB);
        bf16_t* gUT = (bf16_t*)(ws + WS_GU); bf16_t* gW = (bf16_t*)(ws + WS_GW); bf16_t* gQD = (bf16_t*)(ws + WS_GQD); bf16_t* gKDT = (bf16_t*)(ws + WS_GKDT); bf16_t* gA = (bf16_t*)(ws + WS_GA);
        float* gGL = (float*)(ws + WS_GL);
        LAS bf16_t* Kb = (LAS bf16_t*)(lds);
        LAS bf16_t* Qb = (LAS bf16_t*)(lds + 17408);
        LAS bf16_t* Rb = (LAS bf16_t*)(lds + 34816);
        LAS float* Lm = (LAS float*)(lds + 68608);
        LAS bf16_t* raw = (LAS bf16_t*)(lds + 84992);
        LAS float* cw = (LAS float*)(lds + 137520);
        LAS float* gcs = (LAS float*)(lds + 162096);
        LAS float* bts = gcs + 64;
        const int fr = lane & 15, fq = lane >> 4;
        { float wv[12];
#pragma unroll
            for (int j = 0; j < 12; ++j) wv[j] = args.in[I_CONVW][tid + j * NTHREADS];
#pragma unroll
            for (int j = 0; j < 12; ++j) cw[tid + j * NTHREADS] = wv[j]; }
        const float alog_e[4] = {-__expf(args.in[I_ALOG][0]), -__expf(args.in[I_ALOG][1]), -__expf(args.in[I_ALOG][2]), -__expf(args.in[I_ALOG][3])};
        const float dtb[4] = {args.in[I_DTB][0], args.in[I_DTB][1], args.in[I_DTB][2], args.in[I_DTB][3]};
        u32x4 praw[7]; float pa_ = 0.f, pb_ = 0.f;
#define P2_PREFETCH(itm) do { const int _b = (itm) >> 8, _n = ((itm) >> 2) & 63, _h = (itm) & 3; \
            _Pragma("unroll") for (int i7 = 0; i7 < 7; ++i7) { const int idx = tid + NTHREADS * i7; const int row = idx / 48, rem = idx - row * 48, part = rem >> 4, ch = rem & 15; const int srow = _n * 64 - 3 + row; \
                praw[i7] = (u32x4){0u, 0u, 0u, 0u}; \
                if (idx < 67 * 48 && srow >= 0) praw[i7] = *(const u32x4*)(proj0 + (size_t)(_b * SEQ + srow) * N0 + 768 + part * 512 + _h * 128 + ch * 8); } \
            if (wave == 0) { const int t = _b * SEQ + _n * 64 + lane; pa_ = bab[(size_t)t * 8 + _h]; pb_ = bab[(size_t)t * 8 + 4 + _h]; } } while (0)
        const int npb = G - 32;
        int* ready = (int*)(ws + WS_CTL + 32768);
#define P2_ITEM(q) ((((((q) & 31) >> 2) * 64 + ((q) >> 5)) * 4) + ((q) & 3))
        if (bid >= 32) P2_PREFETCH(P2_ITEM(bid - 32));
        __syncthreads();
        int pend = -1, pend2 = -1, held = -1;
        for (int q = bid - 32; bid >= 32 && q < 2048; q += npb) {
            const int item = P2_ITEM(q);
            const int h = item & 3;
#pragma unroll
            for (int i7 = 0; i7 < 7; ++i7) { const int idx = tid + NTHREADS * i7; const int row = idx / 48, rem = idx - row * 48; if (idx < 67 * 48) *(LAS u32x4*)(raw + row * 392 + rem * 8) = praw[i7]; }
            if (wave == 0) {
                const float a = pa_ + (h == 0 ? dtb[0] : h == 1 ? dtb[1] : h == 2 ? dtb[2] : dtb[3]);
                const float sp = fmaxf(a, 0.f) + log1pf(__expf(-fabsf(a)));
                float gv = (h == 0 ? alog_e[0] : h == 1 ? alog_e[1] : h == 2 ? alog_e[2] : alog_e[3]) * sp;
#pragma unroll
                for (int o = 1; o < 64; o <<= 1) { const float y = __shfl_up(gv, o); if (lane >= o) gv += y; }
                gcs[lane] = gv; bts[lane] = sigmoid_f(pb_);
            }
            __syncthreads();
            if (q + npb < 2048) P2_PREFETCH(P2_ITEM(q + npb));
            {
                const int r = tid >> 3, d0 = (tid & 7) * 16;
                const float gc = gcs[r], beta = bts[r], glast = gcs[63];
                const float eg = __expf(gc), ekd = __expf(glast - gc);
#define P2_CONV(P, OUT) do { float acc[16]; _Pragma("unroll") for (int d = 0; d < 16; ++d) acc[d] = 0.f; \
                    _Pragma("unroll") for (int j = 0; j < 4; ++j) { \
                        const LAS u32x4* px = (const LAS u32x4*)(raw + (r + j) * 392 + (P) * 128 + d0); const u32x4 x0 = px[0], x1 = px[1]; \
                        const LAS f32x4* pw = (const LAS f32x4*)(cw + j * 1536 + (P) * 512 + h * 128 + d0); const f32x4 w0 = pw[0], w1 = pw[1], w2 = pw[2], w3 = pw[3]; \
                        acc[0] += w0[0] * lo_bf(x0.x); acc[1] += w0[1] * hi_bf(x0.x); acc[2] += w0[2] * lo_bf(x0.y); acc[3] += w0[3] * hi_bf(x0.y); \
                        acc[4] += w1[0] * lo_bf(x0.z); acc[5] += w1[1] * hi_bf(x0.z); acc[6] += w1[2] * lo_bf(x0.w); acc[7] += w1[3] * hi_bf(x0.w); \
                        acc[8] += w2[0] * lo_bf(x1.x); acc[9] += w2[1] * hi_bf(x1.x); acc[10] += w2[2] * lo_bf(x1.y); acc[11] += w2[3] * hi_bf(x1.y); \
                        acc[12] += w3[0] * lo_bf(x1.z); acc[13] += w3[1] * hi_bf(x1.z); acc[14] += w3[2] * lo_bf(x1.w); acc[15] += w3[3] * hi_bf(x1.w); } \
                    _Pragma("unroll") for (int d = 0; d < 16; ++d) OUT[d] = silu_f(acc[d]); } while (0)
#define P2_PACK(W0, W1, X, SC) do { W0.x = cvt_pk_bf16(X[0] * (SC), X[1] * (SC)); W0.y = cvt_pk_bf16(X[2] * (SC), X[3] * (SC)); W0.z = cvt_pk_bf16(X[4] * (SC), X[5] * (SC)); W0.w = cvt_pk_bf16(X[6] * (SC), X[7] * (SC)); \
                    W1.x = cvt_pk_bf16(X[8] * (SC), X[9] * (SC)); W1.y = cvt_pk_bf16(X[10] * (SC), X[11] * (SC)); W1.z = cvt_pk_bf16(X[12] * (SC), X[13] * (SC)); W1.w = cvt_pk_bf16(X[14] * (SC), X[15] * (SC)); } while (0)
                u32x4 w0_, w1_;
                {
                    float kk[16]; P2_CONV(1, kk);
                    float sk = 0.f;
#pragma unroll
                    for (int d = 0; d < 16; ++d) sk += kk[d] * kk[d];
                    sk += __shfl_xor(sk, 1); sk += __shfl_xor(sk, 2); sk += __shfl_xor(sk, 4);
                    const float kinv = rsqrtf(sk + EPS);
                    P2_PACK(w0_, w1_, kk, kinv); *(LAS u32x4*)(Kb + r * 136 + d0) = w0_; *(LAS u32x4*)(Kb + r * 136 + d0 + 8) = w1_;
                    P2_PACK(w0_, w1_, kk, kinv * beta * eg); *(LAS u32x4*)(Rb + r * 264 + 128 + d0) = w0_; *(LAS u32x4*)(Rb + r * 264 + 128 + d0 + 8) = w1_;
                    const float ks = kinv * ekd;
#pragma unroll
                    for (int d = 0; d < 16; ++d) gKDT[((size_t)item * 128 + d0 + d) * 64 + ((r & 32) | pg8::perm32(r & 31))] = f2bf(kk[d] * ks);
                }
                __builtin_amdgcn_sched_barrier(0);
                {
                    float qq[16]; P2_CONV(0, qq);
                    float sq = 0.f;
#pragma unroll
                    for (int d = 0; d < 16; ++d) sq += qq[d] * qq[d];
                    sq += __shfl_xor(sq, 1); sq += __shfl_xor(sq, 2); sq += __shfl_xor(sq, 4);
                    const float qinv = rsqrtf(sq + EPS) * 0.08838834764831845f;
                    P2_PACK(w0_, w1_, qq, qinv); *(LAS u32x4*)(Qb + r * 136 + d0) = w0_; *(LAS u32x4*)(Qb + r * 136 + d0 + 8) = w1_;
                    P2_PACK(w0_, w1_, qq, qinv * eg); { bf16_t* pqd = gQD + ((size_t)item * 64 + r) * 128 + (d0 & ~31) + 4 * ((d0 >> 4) & 1); *(u32x2*)(pqd) = (u32x2){w0_.x, w0_.y}; *(u32x2*)(pqd + 8) = (u32x2){w0_.z, w0_.w}; *(u32x2*)(pqd + 16) = (u32x2){w1_.x, w1_.y}; *(u32x2*)(pqd + 24) = (u32x2){w1_.z, w1_.w}; }
                }
                __builtin_amdgcn_sched_barrier(0);
                {
                    float vv[16]; P2_CONV(2, vv);
                    P2_PACK(w0_, w1_, vv, beta); *(LAS u32x4*)(Rb + r * 264 + d0) = w0_; *(LAS u32x4*)(Rb + r * 264 + d0 + 8) = w1_;
                }
#undef P2_CONV
#undef P2_PACK
                if (tid == 0) gGL[(size_t)item * 32] = __expf(glast);
            }
            __syncthreads();
            u32x4 gz0, gz1;
            bf16_t* const pgz = (bf16_t*)(ws + WS_PROJ0) + (size_t)((item >> 8) * SEQ + ((item >> 2) & 63) * 64 + (tid >> 3)) * N0 + 2304 + h * 128 + (tid & 7) * 16;
            { const u32x4* pz = (const u32x4*)pgz; gz0 = pz[0]; gz1 = pz[1]; }
            {
                const int which = wave >> 2, mt = wave & 3;
                const LAS bf16_t* X = which ? Qb : Kb;
                for (int nt = 0; nt < 4; ++nt) {
                    f32x4 acc = (f32x4){0.f, 0.f, 0.f, 0.f};
                    if (nt <= mt) {
#pragma unroll
                        for (int s4 = 0; s4 < 4; ++s4) {
                            const bf16x8 af = *(const LAS bf16x8*)(X + (16 * mt + fr) * 136 + 32 * s4 + 8 * fq);
                            const bf16x8 bfr = *(const LAS bf16x8*)(Kb + (16 * nt + fr) * 136 + 32 * s4 + 8 * fq);
                            acc = mfma16(af, bfr, acc);
                        }
                    }
                    const int j = 16 * nt + fr; const float gj = gcs[j];
#pragma unroll
                    for (int rg = 0; rg < 4; ++rg) {
                        const int i = 16 * mt + 4 * fq + rg;
                        const float dec = __expf(fminf(gcs[i] - gj, 0.f));
                        if (which == 0) Lm[i * 64 + j] = (i > j) ? -(bts[i] * acc[rg] * dec) : 0.f;
                        else gA[((size_t)item * 64 + i) * 64 + ((j & 32) | pg8::perm32(j & 31))] = f2bf((i >= j) ? acc[rg] * dec : 0.f);
                    }
                }
            }
            {
                const float* gng = args.in[I_GDNG] + (tid & 7) * 16;
                unsigned zw[8] = {gz0.x, gz0.y, gz0.z, gz0.w, gz1.x, gz1.y, gz1.z, gz1.w};
#pragma unroll
                for (int d = 0; d < 8; ++d) zw[d] = cvt_pk_bf16(gng[2 * d] * silu_f(lo_bf(zw[d])), gng[2 * d + 1] * silu_f(hi_bf(zw[d])));
                u32x4* po = (u32x4*)pgz; po[0] = (u32x4){zw[0], zw[1], zw[2], zw[3]}; po[1] = (u32x4){zw[4], zw[5], zw[6], zw[7]};
            }
            __syncthreads();
            if (tid < 256) {
                const int c = tid, l16 = lane & 15;
                float U[64];
                int ln[4] = {0, 0, 0, 0};
                ln[0] = __builtin_bit_cast(int, Lm[64 + l16]);
                U[0] = bf2f((unsigned)Rb[c]);
                solve_rows(U, ln, Lm, (const LAS unsigned short*)Rb, l16, c, std::make_integer_sequence<int, 63>{});
                if (c < 128) {
                    u32x4* pu = (u32x4*)(gUT + ((size_t)item * 128 + c) * 64);
#pragma unroll
                    for (int i8 = 0; i8 < 8; ++i8) { u32x4 o; o.x = cvt_pk_bf16(U[8 * i8], U[8 * i8 + 1]); o.y = cvt_pk_bf16(U[8 * i8 + 2], U[8 * i8 + 3]); o.z = cvt_pk_bf16(U[8 * i8 + 4], U[8 * i8 + 5]); o.w = cvt_pk_bf16(U[8 * i8 + 6], U[8 * i8 + 7]); pu[i8] = o; }
                } else {
#pragma unroll
                    for (int i = 0; i < 64; ++i) gW[((size_t)item * 64 + i) * 128 + (((c - 128) & ~31) | pg8::perm32((c - 128) & 31))] = f2bf(U[i]);
                }
            }
            else if (tid == 448 && pend >= 0) {
                asm volatile("s_waitcnt vmcnt(0)" ::: "memory");
                __hip_atomic_store(ready + pend, 1, __ATOMIC_RELAXED, __HIP_MEMORY_SCOPE_AGENT);
                if (pend2 >= 0) __hip_atomic_store(ready + pend2, 1, __ATOMIC_RELAXED, __HIP_MEMORY_SCOPE_AGENT);
            }
            pend = -1; pend2 = -1;
            asm volatile("s_waitcnt vmcnt(0)" ::: "memory");
            __syncthreads();
            if (held >= 0 || q + npb >= 2048 || q < npb) { if (tid == 448) asm volatile("buffer_wbl2 sc1" ::: "memory"); pend = item; pend2 = held; held = -1; }
            else held = item;
        }
        if (tid == 448 && pend >= 0) { asm volatile("s_waitcnt vmcnt(0)" ::: "memory"); __hip_atomic_store(ready + pend, 1, __ATOMIC_RELAXED, __HIP_MEMORY_SCOPE_AGENT); if (pend2 >= 0) __hip_atomic_store(ready + pend2, 1, __ATOMIC_RELAXED, __HIP_MEMORY_SCOPE_AGENT); }
#undef P2_PREFETCH
#undef P2_ITEM
    }
    __syncthreads();

    if (RUN(3)) { PHASE_IDS;
        const bf16_t* proj0 = (const bf16_t*)(ws + WS_PROJ0);
        bf16_t* mix0 = (bf16_t*)(ws + WS_HMIX0);
        const int fr = lane & 15, fq = lane >> 4;
        if (bid < 32) {
            const bf16_t* gUT = (const bf16_t*)(ws + WS_GU); const bf16_t* gW = (const bf16_t*)(ws + WS_GW); const bf16_t* gQD = (const bf16_t*)(ws + WS_GQD); const bf16_t* gKDT = (const bf16_t*)(ws + WS_GKDT); const bf16_t* gA = (const bf16_t*)(ws + WS_GA);
            const float* gGL = (const float*)(ws + WS_GL);
            const int b = bid >> 2, h = bid & 3;
            constexpr int BUFB = 62464;
            LAS bf16_t* Obuf0 = (LAS bf16_t*)(lds + 2 * BUFB);
            const int wrow0 = tid >> 4, wch = tid & 15;
            const int krow0 = tid >> 3, kch = tid & 7;
            u32x4 pw[2], pq[2], pk[2], pa;
            u32x2 pu[4], pun[4]; u32x4 pz0, pz1; float glv, glvn = 0.f;
            f32x4 Sacc[8];
#pragma unroll
            for (int k = 0; k < 8; ++k) Sacc[k] = (f32x4){0.f, 0.f, 0.f, 0.f};
            LAS float* gnl = (LAS float*)(lds + 2 * BUFB + 2 * 17408);
            if (tid < 128) gnl[tid] = args.in[I_GDNG][tid];
#define GDN_LOAD(itm) do { const size_t _it = (size_t)(itm); \
                pw[0] = *(const u32x4*)(gW + (_it * 64 + wrow0) * 128 + wch * 8); pw[1] = *(const u32x4*)(gW + (_it * 64 + wrow0 + 32) * 128 + wch * 8); \
                pq[0] = *(const u32x4*)(gQD + (_it * 64 + wrow0) * 128 + wch * 8); pq[1] = *(const u32x4*)(gQD + (_it * 64 + wrow0 + 32) * 128 + wch * 8); \
                pk[0] = *(const u32x4*)(gKDT + (_it * 128 + krow0) * 64 + kch * 8); pk[1] = *(const u32x4*)(gKDT + (_it * 128 + krow0 + 64) * 64 + kch * 8); \
                pa = *(const u32x4*)(gA + (_it * 64 + krow0) * 64 + kch * 8); } while (0)
#define GDN_LOAD2(itm, U, GLV) do { const size_t _it = (size_t)(itm); \
                _Pragma("unroll") for (int mt = 0; mt < 4; ++mt) U[mt] = *(const u32x2*)(gUT + (_it * 128 + 16 * wave + fr) * 64 + 16 * mt + 4 * fq); \
                GLV = gGL[_it * 32]; } while (0)
#define GDN_STORE(bufi) do { LAS bf16_t* _W = (LAS bf16_t*)(lds + (bufi) * BUFB); LAS bf16_t* _Q = _W + 64 * 136; LAS bf16_t* _K = _Q + 64 * 136; LAS bf16_t* _A = _K + 128 * 72; \
                *(LAS u32x4*)(_W + wrow0 * 136 + wch * 8) = pw[0]; *(LAS u32x4*)(_W + (wrow0 + 32) * 136 + wch * 8) = pw[1]; \
                *(LAS u32x4*)(_Q + wrow0 * 136 + wch * 8) = pq[0]; *(LAS u32x4*)(_Q + (wrow0 + 32) * 136 + wch * 8) = pq[1]; \
                *(LAS u32x4*)(_K + krow0 * 72 + kch * 8) = pk[0]; *(LAS u32x4*)(_K + (krow0 + 64) * 72 + kch * 8) = pk[1]; \
                *(LAS u32x4*)(_A + krow0 * 72 + kch * 8) = pa; } while (0)
            const int* ready = (const int*)(ws + WS_CTL + 32768);
#define GDN_WAIT(c0, cnt) do { if (wave == 0) { if (lane < (cnt)) { const int* f = ready + (((b * 64 + (c0) + lane) * 4) + h); while (__hip_atomic_load(f, __ATOMIC_RELAXED, __HIP_MEMORY_SCOPE_AGENT) == 0) __builtin_amdgcn_s_sleep(4); } \
                __builtin_amdgcn_fence(__ATOMIC_ACQUIRE, "agent"); asm volatile("s_waitcnt vmcnt(0)" ::: "memory"); } __syncthreads(); } while (0)
            GDN_WAIT(0, 5);
            GDN_LOAD((b * 64 + 0) * 4 + h); GDN_STORE(0);
            GDN_LOAD2((b * 64 + 0) * 4 + h, pu, glv);
            __syncthreads();
            for (int n = 0; n < 64; ++n) {
                if (n > 0 && (n & 3) == 0 && n + 1 < 64) GDN_WAIT(n + 1, (n + 5 <= 64) ? 4 : (63 - n));
                const int item = (b * 64 + n) * 4 + h, cur = n & 1;
                const int t0 = b * SEQ + n * 64;
                const LAS bf16_t* Wl = (const LAS bf16_t*)(lds + cur * BUFB); const LAS bf16_t* Ql = Wl + 64 * 136; const LAS bf16_t* Kl = Ql + 64 * 136; const LAS bf16_t* Al = Kl + 128 * 72;
                LAS bf16_t* Obuf = Obuf0 + cur * (64 * 136);
                if (n + 1 < 64) { GDN_LOAD(item + 4); GDN_LOAD2(item + 4, pun, glvn); }
                { const u32x4* pz = (const u32x4*)(proj0 + (size_t)(t0 + (tid >> 3)) * N0 + 2304 + h * 128 + (tid & 7) * 16); pz0 = pz[0]; pz1 = pz[1]; }
                bf16x8 Sb[4];
#pragma unroll
                for (int s = 0; s < 4; ++s) Sb[s] = mk8f(Sacc[2 * s], Sacc[2 * s + 1]);
                f32x4 WS[4], QS[4];
#pragma unroll
                for (int mt = 0; mt < 4; ++mt) { WS[mt] = (f32x4){0.f, 0.f, 0.f, 0.f}; QS[mt] = (f32x4){0.f, 0.f, 0.f, 0.f}; }
                {
                    bf16x8 wfr[2][4], qfr[2][4];
#define GDN_FRAGS(bufi, mt_) do { _Pragma("unroll") for (int s = 0; s < 4; ++s) { wfr[bufi][s] = *(const LAS bf16x8*)(Wl + (16 * (mt_) + fr) * 136 + 32 * s + 8 * fq); \
                        qfr[bufi][s] = *(const LAS bf16x8*)(Ql + (16 * (mt_) + fr) * 136 + 32 * s + 8 * fq); } } while (0)
                    GDN_FRAGS(0, 0);
#pragma unroll
                    for (int mt = 0; mt < 4; ++mt) {
                        if (mt + 1 < 4) GDN_FRAGS((mt + 1) & 1, mt + 1);
                        __builtin_amdgcn_sched_barrier(0);
#pragma unroll
                        for (int s = 0; s < 4; ++s) { WS[mt] = mfma16(wfr[mt & 1][s], Sb[s], WS[mt]); QS[mt] = mfma16(qfr[mt & 1][s], Sb[s], QS[mt]); }
                        __builtin_amdgcn_sched_barrier(0);
                    }
#undef GDN_FRAGS
                }
                bf16x8 afr[8], kfa[8], kfb[8];
#define GDN_KFR(dst, kt0) do { _Pragma("unroll") for (int k4 = 0; k4 < 4; ++k4) _Pragma("unroll") for (int s2 = 0; s2 < 2; ++s2) dst[k4 * 2 + s2] = *(const LAS bf16x8*)(Kl + (16 * ((kt0) + k4) + fr) * 72 + 32 * s2 + 8 * fq); } while (0)
#pragma unroll
                for (int mt = 0; mt < 4; ++mt)
#pragma unroll
                    for (int s2 = 0; s2 < 2; ++s2) afr[mt * 2 + s2] = *(const LAS bf16x8*)(Al + (16 * mt + fr) * 72 + 32 * s2 + 8 * fq);
                GDN_KFR(kfa, 0);
                __builtin_amdgcn_sched_barrier(0);
                f32x4 vn[4];
#pragma unroll
                for (int mt = 0; mt < 4; ++mt) { vn[mt][0] = lo_bf(pu[mt].x) - WS[mt][0]; vn[mt][1] = hi_bf(pu[mt].x) - WS[mt][1]; vn[mt][2] = lo_bf(pu[mt].y) - WS[mt][2]; vn[mt][3] = hi_bf(pu[mt].y) - WS[mt][3]; }
                bf16x8 Vb[2];
                Vb[0] = mk8f(vn[0], vn[1]); Vb[1] = mk8f(vn[2], vn[3]);
#pragma unroll
                for (int kt = 0; kt < 8; ++kt) Sacc[kt] = Sacc[kt] * glv;
                __builtin_amdgcn_sched_barrier(0);
#pragma unroll
                for (int k4 = 0; k4 < 4; ++k4)
#pragma unroll
                    for (int s2 = 0; s2 < 2; ++s2) Sacc[k4] = mfma16(kfa[k4 * 2 + s2], Vb[s2], Sacc[k4]);
                GDN_KFR(kfb, 4);
                __builtin_amdgcn_sched_barrier(0);
#pragma unroll
                for (int mt = 0; mt < 4; ++mt)
#pragma unroll
                    for (int s2 = 0; s2 < 2; ++s2) QS[mt] = mfma16(afr[mt * 2 + s2], Vb[s2], QS[mt]);
                __builtin_amdgcn_sched_barrier(0);
#pragma unroll
                for (int k4 = 0; k4 < 4; ++k4)
#pragma unroll
                    for (int s2 = 0; s2 < 2; ++s2) Sacc[4 + k4] = mfma16(kfb[k4 * 2 + s2], Vb[s2], Sacc[4 + k4]);
#undef GDN_KFR
#pragma unroll
                for (int mt = 0; mt < 4; ++mt)
#pragma unroll
                    for (int rg = 0; rg < 4; ++rg) Obuf[(16 * mt + 4 * fq + rg) * 136 + 16 * wave + fr] = f2bf(QS[mt][rg]);
                if (n + 1 < 64) GDN_STORE(cur ^ 1);
                __syncthreads();
                {
                    const int r = tid >> 3, c0 = (tid & 7) * 16;
                    const u32x4 o0 = *(const LAS u32x4*)(Obuf + r * 136 + c0), o1 = *(const LAS u32x4*)(Obuf + r * 136 + c0 + 8);
                    float ov[16], zv[16];
                    ov[0] = lo_bf(o0.x); ov[1] = hi_bf(o0.x); ov[2] = lo_bf(o0.y); ov[3] = hi_bf(o0.y); ov[4] = lo_bf(o0.z); ov[5] = hi_bf(o0.z); ov[6] = lo_bf(o0.w); ov[7] = hi_bf(o0.w);
                    ov[8] = lo_bf(o1.x); ov[9] = hi_bf(o1.x); ov[10] = lo_bf(o1.y); ov[11] = hi_bf(o1.y); ov[12] = lo_bf(o1.z); ov[13] = hi_bf(o1.z); ov[14] = lo_bf(o1.w); ov[15] = hi_bf(o1.w);
                    float ss = 0.f;
#pragma unroll
                    for (int d = 0; d < 16; ++d) ss += ov[d] * ov[d];
                    ss += __shfl_xor(ss, 1); ss += __shfl_xor(ss, 2); ss += __shfl_xor(ss, 4);
                    const float rstd = rsqrtf(ss * (1.f / 128.f) + EPS);
                    zv[0] = lo_bf(pz0.x); zv[1] = hi_bf(pz0.x); zv[2] = lo_bf(pz0.y); zv[3] = hi_bf(pz0.y); zv[4] = lo_bf(pz0.z); zv[5] = hi_bf(pz0.z); zv[6] = lo_bf(pz0.w); zv[7] = hi_bf(pz0.w);
                    zv[8] = lo_bf(pz1.x); zv[9] = hi_bf(pz1.x); zv[10] = lo_bf(pz1.y); zv[11] = hi_bf(pz1.y); zv[12] = lo_bf(pz1.z); zv[13] = hi_bf(pz1.z); zv[14] = lo_bf(pz1.w); zv[15] = hi_bf(pz1.w);
#pragma unroll
                    for (int d = 0; d < 16; ++d) ov[d] = ov[d] * rstd * zv[d];
                    u32x4 w0, w1;
                    w0.x = cvt_pk_bf16(ov[0], ov[1]); w0.y = cvt_pk_bf16(ov[2], ov[3]); w0.z = cvt_pk_bf16(ov[4], ov[5]); w0.w = cvt_pk_bf16(ov[6], ov[7]);
                    w1.x = cvt_pk_bf16(ov[8], ov[9]); w1.y = cvt_pk_bf16(ov[10], ov[11]); w1.z = cvt_pk_bf16(ov[12], ov[13]); w1.w = cvt_pk_bf16(ov[14], ov[15]);
                    u32x4* po = (u32x4*)(mix0 + (size_t)(t0 + r) * D + 512 + h * 128 + c0); po[0] = w0; po[1] = w1;
                }
#pragma unroll
                for (int mt = 0; mt < 4; ++mt) pu[mt] = pun[mt];
                glv = glvn;
            }
#undef GDN_LOAD2
#undef GDN_WAIT
#undef GDN_LOAD
#undef GDN_STORE
        } else {
            LAS bf16_t* Ks = (LAS bf16_t*)(lds);
            LAS bf16_t* Vt = (LAS bf16_t*)(lds + 27648);
            const float* qgain = args.in[I_QG]; const float* kgain = args.in[I_KG];
            const int nbk = G - 32;
            for (int it = bid - 32; it < 1024; it += nbk) {
                const int b = it >> 7, qb = (it >> 1) & 63, hk = it & 1;
                const int t0 = b * SEQ + qb * 64;
                __syncthreads();
#pragma unroll
                for (int i3 = 0; i3 < 3; ++i3) {
                    const int task = tid + NTHREADS * i3, key = task >> 3, dg = task & 7;
                    const int kp = qb * 64 - 128 + key;
                    u32x4 kr = (u32x4){0u, 0u, 0u, 0u}, vr = (u32x4){0u, 0u, 0u, 0u};
                    if (kp >= 0) { const bf16_t* pr = proj0 + (size_t)(b * SEQ + kp) * N0 + hk * 64 + 8 * dg; kr = *(const u32x4*)(pr + 512); vr = *(const u32x4*)(pr + 640); }
                    float kv[8];
                    kv[0] = lo_bf(kr.x); kv[1] = hi_bf(kr.x); kv[2] = lo_bf(kr.y); kv[3] = hi_bf(kr.y); kv[4] = lo_bf(kr.z); kv[5] = hi_bf(kr.z); kv[6] = lo_bf(kr.w); kv[7] = hi_bf(kr.w);
                    float ss = 0.f;
#pragma unroll
                    for (int i = 0; i < 8; ++i) ss += kv[i] * kv[i];
                    ss += __shfl_xor(ss, 1); ss += __shfl_xor(ss, 2); ss += __shfl_xor(ss, 4);
                    const float rstd = rsqrtf(ss * (1.f / 64.f) + EPS);
                    const f32x4 g0 = *(const f32x4*)(kgain + 8 * dg), g1 = *(const f32x4*)(kgain + 8 * dg + 4);
                    kv[0] *= rstd * g0[0]; kv[1] *= rstd * g0[1]; kv[2] *= rstd * g0[2]; kv[3] *= rstd * g0[3]; kv[4] *= rstd * g1[0]; kv[5] *= rstd * g1[1]; kv[6] *= rstd * g1[2]; kv[7] *= rstd * g1[3];
                    float pv[8];
#pragma unroll
                    for (int i = 0; i < 8; ++i) pv[i] = __shfl_xor(kv[i], 1);
                    if (dg < 2) {
#pragma unroll
                        for (int i = 0; i < 8; ++i) { float sn, cs; sincos_rev((float)kp * exp2f(-2.36644607f * (float)i), sn, cs);
                            kv[i] = (dg == 0) ? (kv[i] * cs - pv[i] * sn) : (kv[i] * cs + pv[i] * sn); }
                    }
                    u32x4 kw; kw.x = cvt_pk_bf16(kv[0], kv[1]); kw.y = cvt_pk_bf16(kv[2], kv[3]); kw.z = cvt_pk_bf16(kv[4], kv[5]); kw.w = cvt_pk_bf16(kv[6], kv[7]);
                    *(LAS u32x4*)(Ks + key * 72 + 8 * dg) = kw;
                    const int kpm = (key & ~31) | pg8::perm32(key & 31);
                    Vt[(8 * dg + 0) * 200 + kpm] = (bf16_t)(vr.x & 0xffffu); Vt[(8 * dg + 1) * 200 + kpm] = (bf16_t)(vr.x >> 16);
                    Vt[(8 * dg + 2) * 200 + kpm] = (bf16_t)(vr.y & 0xffffu); Vt[(8 * dg + 3) * 200 + kpm] = (bf16_t)(vr.y >> 16);
                    Vt[(8 * dg + 4) * 200 + kpm] = (bf16_t)(vr.z & 0xffffu); Vt[(8 * dg + 5) * 200 + kpm] = (bf16_t)(vr.z >> 16);
                    Vt[(8 * dg + 6) * 200 + kpm] = (bf16_t)(vr.w & 0xffffu); Vt[(8 * dg + 7) * 200 + kpm] = (bf16_t)(vr.w >> 16);
                }
                __syncthreads();
                const int g = wave >> 1, qs = wave & 1, hq = hk * 4 + g;
                const float sinkv = args.in[I_SINK][hq];
#pragma unroll
                for (int j2 = 0; j2 < 2; ++j2) {
                    const int qrow = 32 * qs + 16 * j2 + fr;
                    const int tq = t0 + qrow, qpos = qb * 64 + qrow;
                    bf16x8 Qf[2];
                    {
                        const u32x4 r0 = *(const u32x4*)(proj0 + (size_t)tq * N0 + hq * 64 + 8 * fq), r1 = *(const u32x4*)(proj0 + (size_t)tq * N0 + hq * 64 + 32 + 8 * fq);
                        float q0[8], q1[8];
                        q0[0] = lo_bf(r0.x); q0[1] = hi_bf(r0.x); q0[2] = lo_bf(r0.y); q0[3] = hi_bf(r0.y); q0[4] = lo_bf(r0.z); q0[5] = hi_bf(r0.z); q0[6] = lo_bf(r0.w); q0[7] = hi_bf(r0.w);
                        q1[0] = lo_bf(r1.x); q1[1] = hi_bf(r1.x); q1[2] = lo_bf(r1.y); q1[3] = hi_bf(r1.y); q1[4] = lo_bf(r1.z); q1[5] = hi_bf(r1.z); q1[6] = lo_bf(r1.w); q1[7] = hi_bf(r1.w);
                        float ss = 0.f;
#pragma unroll
                        for (int i = 0; i < 8; ++i) ss += q0[i] * q0[i] + q1[i] * q1[i];
                        ss += __shfl_xor(ss, 16); ss += __shfl_xor(ss, 32);
                        const float rstd = rsqrtf(ss * (1.f / 64.f) + EPS) * 0.125f;
#pragma unroll
                        for (int i = 0; i < 8; ++i) { q0[i] *= rstd * qgain[8 * fq + i]; q1[i] *= rstd * qgain[32 + 8 * fq + i]; }
                        float pv[8];
#pragma unroll
                        for (int i = 0; i < 8; ++i) pv[i] = __shfl_xor(q0[i], 16);
                        if (fq < 2) {
#pragma unroll
                            for (int i = 0; i < 8; ++i) { float sn, cs; sincos_rev((float)qpos * exp2f(-2.36644607f * (float)i), sn, cs);
                                q0[i] = (fq == 0) ? (q0[i] * cs - pv[i] * sn) : (q0[i] * cs + pv[i] * sn); }
                        }
                        u32x4 w0, w1;
                        w0.x = cvt_pk_bf16(q0[0], q0[1]); w0.y = cvt_pk_bf16(q0[2], q0[3]); w0.z = cvt_pk_bf16(q0[4], q0[5]); w0.w = cvt_pk_bf16(q0[6], q0[7]);
                        w1.x = cvt_pk_bf16(q1[0], q1[1]); w1.y = cvt_pk_bf16(q1[2], q1[3]); w1.z = cvt_pk_bf16(q1[4], q1[5]); w1.w = cvt_pk_bf16(q1[6], q1[7]);
                        Qf[0] = __builtin_bit_cast(bf16x8, w0); Qf[1] = __builtin_bit_cast(bf16x8, w1);
                    }
                    float mrun = sinkv, lrun = (fq == 0) ? 1.f : 0.f;
                    f32x4 Oa[4];
#pragma unroll
                    for (int dt = 0; dt < 4; ++dt) Oa[dt] = (f32x4){0.f, 0.f, 0.f, 0.f};
#pragma unroll
                    for (int kt = 0; kt < 3; ++kt) {
                        f32x4 sc[4];
                        float tmax = -1e30f;
#pragma unroll
                        for (int mt = 0; mt < 4; ++mt) { sc[mt] = (f32x4){0.f, 0.f, 0.f, 0.f};
#pragma unroll
                            for (int s = 0; s < 2; ++s) sc[mt] = mfma16(*(const LAS bf16x8*)(Ks + (64 * kt + 16 * mt + fr) * 72 + 32 * s + 8 * fq), Qf[s], sc[mt]);
#pragma unroll
                            for (int rg = 0; rg < 4; ++rg) { const int key = 64 * kt + 16 * mt + 4 * fq + rg; const int rel = 128 + qrow - key; const int kp = qb * 64 - 128 + key;
                                const bool ok = (rel >= 0) && (rel < 128) && (kp >= 0);
                                sc[mt][rg] = ok ? sc[mt][rg] : -1e30f; tmax = fmaxf(tmax, sc[mt][rg]); } }
                        tmax = fmaxf(tmax, __shfl_xor(tmax, 16)); tmax = fmaxf(tmax, __shfl_xor(tmax, 32));
                        const float mnew = fmaxf(mrun, tmax), alpha = __expf(mrun - mnew);
                        float ps = 0.f;
#pragma unroll
                        for (int mt = 0; mt < 4; ++mt)
#pragma unroll
                            for (int rg = 0; rg < 4; ++rg) { const float p = (sc[mt][rg] > -1e29f) ? __expf(sc[mt][rg] - mnew) : 0.f; sc[mt][rg] = p; ps += p; }
                        lrun = lrun * alpha + ps; mrun = mnew;
                        bf16x8 Pb[2]; Pb[0] = mk8f(sc[0], sc[1]); Pb[1] = mk8f(sc[2], sc[3]);
#pragma unroll
                        for (int dt = 0; dt < 4; ++dt) { Oa[dt] = Oa[dt] * alpha;
#pragma unroll
                            for (int s2 = 0; s2 < 2; ++s2) Oa[dt] = mfma16(*(const LAS bf16x8*)(Vt + (16 * dt + fr) * 200 + 64 * kt + 32 * s2 + 8 * fq), Pb[s2], Oa[dt]); }
                    }
                    lrun += __shfl_xor(lrun, 16); lrun += __shfl_xor(lrun, 32);
                    const float inv = 1.f / lrun;
#pragma unroll
                    for (int dt = 0; dt < 4; ++dt) { u32x2 w; w.x = cvt_pk_bf16(Oa[dt][0] * inv, Oa[dt][1] * inv); w.y = cvt_pk_bf16(Oa[dt][2] * inv, Oa[dt][3] * inv);
                        *(u32x2*)(mix0 + (size_t)tq * D + hq * 64 + 16 * dt + 4 * fq) = w; }
                }
            }
            __syncthreads();
            {
                LAS float* scr = (LAS float*)(lds + wave * 8448);
                const int gw2 = (bid - 32) * NWAVES + wave, ngw2 = nbk * NWAVES;
                constexpr int I1 = (D / 64) * (D / 32), I2 = (D / 64) * (ODD_IN / 32), I3 = (2048 / 64) * (D / 32);
                for (int it = gw2; it < I1 + I2 + I3; it += ngw2) {
                    int r = it;
                    if (r < I1) { transpose_item(args.in[I_WOUTE], D, D, D, (bf16_t*)(ws + WS_WOUT0), 0, scr, r, lane); continue; } r -= I1;
                    if (r < I2) { transpose_item(args.in[I_WINO], D, ODD_IN, ODD_IN, (bf16_t*)(ws + WS_WIN1), 0, scr, r, lane); continue; } r -= I2;
                    transpose_item(args.in[I_WOUTO], 2048, D, D, (bf16_t*)(ws + WS_WOUT1), 0, scr, r, lane);
                }
                convert_moe(args, 0, scr, gw2, ngw2, lane);
            }
        }
    }
    SEAM(3);

    if (RUN(4)) { PHASE_IDS;
        pg8::Gemm g{(const bf16_t*)(ws + WS_HMIX0), (const bf16_t*)(ws + WS_WOUT0), D, D, nullptr};
        pg8::DenseOrder S; S.init(T, D, G, bid, D, D);
        pg8::EpiResF32 E{args.in[I_X], args.out, D, (float*)(ws + WS_SSQ)};
        pg8::gemm_phase(lds, g, S, E);
    }
    SEAM(4);

    if (RUN(5)) { PHASE_IDS; moe_route2(args, 0, lds, bid, G, tid, lane, wave); }
    SEAM(5);
    if (RUN(6)) { PHASE_IDS; moe_scatter(args, 0, lds, bid, G, tid, lane, wave); }
    SEAM(6);
    if (RUN(7)) { PHASE_IDS; moe_gemm1(args, 0, lds, bid, G, tid); }
    __syncthreads();
    if (RUN(8)) { PHASE_IDS; moe_gemm2(args, 0, lds, bid, G, tid); }
    SEAM(8);
    if (RUN(9)) { PHASE_IDS; moe_combine<true>(args, args.in[I_LNO], (bf16_t*)(ws + WS_H1), gw, ngw, lane); }
    SEAM(9);

    if (RUN(10)) { PHASE_IDS;
        pg8::Gemm g{(const bf16_t*)(ws + WS_H1), (const bf16_t*)(ws + WS_WIN1), D, D, nullptr};
        pg8::DenseOrder S; S.init(T, ODD_IN, G, bid, D, D);
        pg8::EpiBf16 E{(bf16_t*)(ws + WS_PROJ1), ODD_IN};
        pg8::gemm_phase(lds, g, S, E);
    }
    SEAM(10);

    if (RUN(11)) { PHASE_IDS;
        bf16_t* proj1 = (bf16_t*)(ws + WS_PROJ1); bf16_t* inner = (bf16_t*)(ws + WS_INNER); bf16_t* kzT = (bf16_t*)(ws + WS_KZT);
        LAS bf16_t* Qs = (LAS bf16_t*)lds;
        LAS bf16_t* Ks = (LAS bf16_t*)(lds + 67584);
        const int fr = lane & 15, fq = lane >> 4;
        LAS float* gtab = (LAS float*)(lds + 135168);
        float frq[4];
#pragma unroll
        for (int pp = 0; pp < 4; ++pp) frq[pp] = exp2f(-0.10462765655f * (float)(4 * (lane & 31) + pp));
        for (int item = bid; item < 1024; item += G) {
            const int b = item >> 7, n = (item >> 2) & 31, h = item & 3;
            const int t0 = b * SEQ + n * 128;
            const float l2g = logf(1.0f - exp2f(-5.0f - (float)h)) * 1.4426950408889634f;
            __syncthreads();
            if (tid < 128) gtab[tid] = exp2f((float)tid * l2g);
            {
                const int p = lane & 31;
#pragma unroll
                for (int c = 0; c < 8; ++c) {
                    const int r = 16 * wave + 2 * c + (lane >> 5);
                    const float pos = (float)(n * 128 + r);
                    const bf16_t* pq = proj1 + (size_t)(t0 + r) * ODD_IN + h * 256 + 8 * p;
                    const u32x4 qr = *(const u32x4*)pq, kr = *(const u32x4*)(pq + 1024);
                    unsigned qw[4] = {qr.x, qr.y, qr.z, qr.w}, kw[4] = {kr.x, kr.y, kr.z, kr.w};
#pragma unroll
                    for (int pp = 0; pp < 4; ++pp) {
                        float sn, cs; sincos_rev(pos * frq[pp], sn, cs);
                        const float q1 = lo_bf(qw[pp]), q2 = hi_bf(qw[pp]), k1 = lo_bf(kw[pp]) * 0.0625f, k2 = hi_bf(kw[pp]) * 0.0625f;
                        qw[pp] = cvt_pk_bf16(q1 * cs - q2 * sn, q2 * cs + q1 * sn);
                        kw[pp] = cvt_pk_bf16(k1 * cs - k2 * sn, k2 * cs + k1 * sn);
                    }
                    *(LAS u32x4*)(Qs + r * 264 + 8 * p) = (u32x4){qw[0], qw[1], qw[2], qw[3]};
                    *(LAS u32x4*)(Ks + r * 264 + 8 * p) = (u32x4){kw[0], kw[1], kw[2], kw[3]};
                }
            }
            __syncthreads();
            {
#pragma unroll
                for (int s8 = 0; s8 < 8; ++s8) {
                    const u32x4 v = *(const LAS u32x4*)(Qs + (16 * wave + fr) * 264 + 32 * s8 + 8 * fq);
                    *(u32x4*)(proj1 + (size_t)(t0 + 16 * wave + 2 * s8 + (lane >> 5)) * ODD_IN + h * 256 + 8 * (lane & 31)) = v;
                }
            }
            {
                for (int t = wave; t < 64; t += 8) {
                    int it, jt;
                    if (t < 36) { it = 0; int rem = t; while (rem > it) { rem -= it + 1; ++it; } jt = rem; }
                    else { const int u = t - 36; it = 0; int rem = u; while (rem >= 7 - it) { rem -= 7 - it; ++it; } jt = it + 1 + rem; }
                    f32x4 acc = (f32x4){0.f, 0.f, 0.f, 0.f};
                    if (t < 36) {
#pragma unroll
                        for (int s8 = 0; s8 < 8; ++s8)
                            acc = mfma16(*(const LAS bf16x8*)(Ks + (16 * jt + fr) * 264 + 32 * s8 + 8 * fq), *(const LAS bf16x8*)(Qs + (16 * it + fr) * 264 + 32 * s8 + 8 * fq), acc);
                    }
                    const int i = 16 * it + fr;
                    float vv[4];
#pragma unroll
                    for (int rg = 0; rg < 4; ++rg) { const int j = 16 * jt + 4 * fq + rg; vv[rg] = (i >= j) ? acc[rg] * gtab[i - j] : 0.f; }
                    u32x2 w; w.x = cvt_pk_bf16(vv[0], vv[1]); w.y = cvt_pk_bf16(vv[2], vv[3]);
                    *(u32x2*)(inner + (size_t)item * 16384 + (((it * 4 + (jt >> 1)) * 64 + ((jt & 1) * 2 + (fq >> 1)) * 16 + fr) * 8 + 4 * (fq & 1))) = w;
                }
            }
            {
                const int d = tid >> 1, half = tid & 1;
                bf16_t* po = kzT + (size_t)item * 32768 + ((size_t)(((d >> 5) * 2 + ((d >> 4) & 1)) * 4 + 2 * half) * 64 + (d & 15)) * 8;
#pragma unroll
                for (int i8 = 0; i8 < 8; ++i8) {
                    float kv[8];
#pragma unroll
                    for (int e = 0; e < 8; ++e) { const int r = 64 * half + 8 * i8 + e; kv[e] = bf2f((unsigned)Ks[r * 264 + d]) * gtab[127 - r]; }
                    u32x4 o; o.x = cvt_pk_bf16(kv[0], kv[1]); o.y = cvt_pk_bf16(kv[2], kv[3]); o.z = cvt_pk_bf16(kv[4], kv[5]); o.w = cvt_pk_bf16(kv[6], kv[7]);
                    *(u32x4*)(po + ((i8 >> 2) * 64 + (i8 & 3) * 16) * 8) = o;
                }
            }
        }
    }
    SEAM(11);

    if (RUN(12)) { PHASE_IDS;
        bf16_t* proj1 = (bf16_t*)(ws + WS_PROJ1); const bf16_t* inner = (const bf16_t*)(ws + WS_INNER); const bf16_t* kzT = (const bf16_t*)(ws + WS_KZT);
        float* SSQ = (float*)(ws + WS_SSQ);
        LAS bf16_t* Vt0 = (LAS bf16_t*)lds;
        LAS bf16_t* St0 = (LAS bf16_t*)(lds + 2 * 17408);
        const int fr = lane & 15, fq = lane >> 4;
        for (int wi = bid; wi < 256; wi += G) {
            const int xcd = wi & 7, jj = wi >> 3, bh = xcd * 4 + (jj >> 3), sl = jj & 7, b = bh >> 2, h = bh & 3;
            const float l2g = logf(1.0f - exp2f(-5.0f - (float)h)) * 1.4426950408889634f;
            const float gC = exp2f(128.0f * l2g);
            const float xi = exp2f((float)(16 * wave + fr + 1) * l2g);
            f32x4 Sacc[2][4];
#pragma unroll
            for (int mt = 0; mt < 2; ++mt)
#pragma unroll
                for (int nt = 0; nt < 4; ++nt) Sacc[mt][nt] = (f32x4){0.f, 0.f, 0.f, 0.f};
            __syncthreads();
            for (int i = tid; i < 64 * 264 / 2; i += NTHREADS) ((LAS unsigned*)St0)[i] = 0u;
            LAS bf16_t* Vt = Vt0; LAS bf16_t* St = St0;
            const int vr = tid >> 2, vcs = tid & 3;
            const size_t vcol = 2048 + h * 512 + 64 * sl;
            u32x4 pv0, pv1;
            { const u32x4* pvp = (const u32x4*)(proj1 + (size_t)(b * SEQ + vr) * ODD_IN + vcol + 16 * vcs); pv0 = pvp[0]; pv1 = pvp[1]; }
#define RET_VSTORE_TO(VD) do { const unsigned _w[8] = {pv0.x, pv0.y, pv0.z, pv0.w, pv1.x, pv1.y, pv1.z, pv1.w}; \
                _Pragma("unroll") for (int _e = 0; _e < 8; ++_e) { (VD)[(16 * vcs + 2 * _e) * 136 + (vr ^ (16 * vcs))] = (bf16_t)(_w[_e] & 0xffffu); (VD)[(16 * vcs + 2 * _e + 1) * 136 + (vr ^ (16 * vcs))] = (bf16_t)(_w[_e] >> 16); } } while (0)
#define RET_VSTORE() RET_VSTORE_TO(Vt)
            RET_VSTORE();
            __syncthreads();
            bf16x8 qf[8], nf[4], kf[2][4];
            {
                const int item0 = (b * 32) * 4 + h;
                const bf16_t* pq = proj1 + (size_t)(b * SEQ + 16 * wave + (lane >> 5)) * ODD_IN + h * 256 + 8 * (lane & 31);
#pragma unroll
                for (int s = 0; s < 8; ++s) qf[s] = *(const bf16x8*)(pq + (size_t)(2 * s) * ODD_IN);
                const bf16_t* pin = inner + (size_t)item0 * 16384 + ((wave * 4) * 64 + lane) * 8;
#pragma unroll
                for (int s = 0; s < 4; ++s) nf[s] = *(const bf16x8*)(pin + s * 512);
                const bf16_t* pk = kzT + (size_t)item0 * 32768 + ((wave * 8) * 64 + lane) * 8;
#pragma unroll
                for (int mt = 0; mt < 2; ++mt)
#pragma unroll
                    for (int s = 0; s < 4; ++s) kf[mt][s] = *(const bf16x8*)(pk + (mt * 4 + s) * 512);
            }
            for (int n = 0; n < 32; ++n) {
                Vt = Vt0 + (n & 1) * (64 * 136); St = St0 + (n & 1) * (64 * 264);
                LAS bf16_t* Vtn = Vt0 + ((n + 1) & 1) * (64 * 136); LAS bf16_t* Stn = St0 + ((n + 1) & 1) * (64 * 264);
                const int item = (b * 32 + n) * 4 + h, t0 = b * SEQ + n * 128;
                const int ti = t0 + 16 * wave + fr;
                const bool more = (n + 1 < 32);
                if (more) { const u32x4* pvp = (const u32x4*)(proj1 + (size_t)(t0 + 128 + vr) * ODD_IN + vcol + 16 * vcs); pv0 = pvp[0]; pv1 = pvp[1]; }
                f32x4 ac[4], ai[4];
#pragma unroll
                for (int ct = 0; ct < 4; ++ct) { ac[ct] = (f32x4){0.f, 0.f, 0.f, 0.f}; ai[ct] = (f32x4){0.f, 0.f, 0.f, 0.f}; }
                {
                    bf16x8 sf[3][4];
#pragma unroll
                    for (int ct = 0; ct < 4; ++ct) { sf[0][ct] = *(const LAS bf16x8*)(St + (16 * ct + fr) * 264 + 8 * fq); sf[1][ct] = *(const LAS bf16x8*)(St + (16 * ct + fr) * 264 + 32 + 8 * fq); }
#pragma unroll
                    for (int s = 0; s < 8; ++s) {
                        if (s + 2 < 8) {
#pragma unroll
                            for (int ct = 0; ct < 4; ++ct) sf[(s + 2) % 3][ct] = *(const LAS bf16x8*)(St + (16 * ct + fr) * 264 + 32 * (s + 2) + 8 * fq); }
                        __builtin_amdgcn_sched_barrier(0);
#pragma unroll
                        for (int ct = 0; ct < 4; ++ct) ac[ct] = mfma16(sf[s % 3][ct], qf[s], ac[ct]);
                        __builtin_amdgcn_sched_barrier(0);
                    }
                }
                if (more) { const bf16_t* pq = proj1 + (size_t)(t0 + 128 + 16 * wave + (lane >> 5)) * ODD_IN + h * 256 + 8 * (lane & 31);
#pragma unroll
                    for (int s = 0; s < 8; ++s) qf[s] = *(const bf16x8*)(pq + (size_t)(2 * s) * ODD_IN); }
#pragma unroll
                for (int s = 0; s < 4; ++s)
#pragma unroll
                    for (int ct = 0; ct < 4; ++ct) ai[ct] = mfma16(*(const LAS bf16x8*)(Vt + (16 * ct + fr) * 136 + ((32 * s + 8 * fq) ^ (16 * ct))), nf[s], ai[ct]);
                if (more) { const bf16_t* pin = inner + (size_t)(item + 4) * 16384 + ((wave * 4) * 64 + lane) * 8;
#pragma unroll
                    for (int s = 0; s < 4; ++s) nf[s] = *(const bf16x8*)(pin + s * 512); }
                {
                    float ssq = 0.f;
                    LAS bf16_t* Ow = (LAS bf16_t*)(lds + 102400 + wave * 2304);
#pragma unroll
                    for (int ct = 0; ct < 4; ++ct) {
                        f32x4 o = ai[ct] + ac[ct] * xi;
                        ssq += (o[0] * o[0] + o[1] * o[1]) + (o[2] * o[2] + o[3] * o[3]);
                        u32x2 w; w.x = cvt_pk_bf16(o[0], o[1]); w.y = cvt_pk_bf16(o[2], o[3]);
                        *(LAS u32x2*)(Ow + fr * 72 + 16 * ct + 4 * fq) = w;
                    }
                    {
                        const int rr = lane >> 3, pc = lane & 7;
                        const u32x4 w0 = *(const LAS u32x4*)(Ow + rr * 72 + 8 * pc), w1 = *(const LAS u32x4*)(Ow + (rr + 8) * 72 + 8 * pc);
                        bf16_t* po = proj1 + (size_t)(t0 + 16 * wave + rr) * ODD_IN + vcol + 8 * pc;
                        *(u32x4*)po = w0; *(u32x4*)(po + (size_t)8 * ODD_IN) = w1;
                    }
                    ssq += __shfl_xor(ssq, 16); ssq += __shfl_xor(ssq, 32);
                    if (fq == 0) SSQ[((size_t)(h * 8 + sl)) * T + ti] = ssq;
                }
#pragma unroll
                for (int mt = 0; mt < 2; ++mt)
#pragma unroll
                    for (int nt = 0; nt < 4; ++nt) { Sacc[mt][nt] = Sacc[mt][nt] * gC;
#pragma unroll
                        for (int s = 0; s < 4; ++s) Sacc[mt][nt] = mfma16(kf[mt][s], *(const LAS bf16x8*)(Vt + (16 * nt + fr) * 136 + ((32 * s + 8 * fq) ^ (16 * nt))), Sacc[mt][nt]); }
                if (more) { const bf16_t* pk = kzT + (size_t)(item + 4) * 32768 + ((wave * 8) * 64 + lane) * 8;
#pragma unroll
                    for (int mt = 0; mt < 2; ++mt)
#pragma unroll
                        for (int s = 0; s < 4; ++s) kf[mt][s] = *(const bf16x8*)(pk + (mt * 4 + s) * 512); }
#pragma unroll
                for (int mt = 0; mt < 2; ++mt)
#pragma unroll
                    for (int nt = 0; nt < 4; ++nt) { u32x2 w; w.x = cvt_pk_bf16(Sacc[mt][nt][0], Sacc[mt][nt][1]); w.y = cvt_pk_bf16(Sacc[mt][nt][2], Sacc[mt][nt][3]);
                        *(LAS u32x2*)(Stn + (16 * nt + fr) * 264 + 32 * wave + 16 * mt + 4 * fq) = w; }
                if (more) RET_VSTORE_TO(Vtn);
                __syncthreads();
            }
#undef RET_VSTORE
#undef RET_VSTORE_TO
        }
    }
    SEAM(12);

    if (RUN(13)) { PHASE_IDS;
        bf16_t* proj1 = (bf16_t*)(ws + WS_PROJ1); const float* SSQ = (const float*)(ws + WS_SSQ);
        {
            u32x4 vv[4], zz[4], vn_[4], zn_[4]; float sq = 0.f, sqn = 0.f;
#define FIN_LOAD(tt, V, Z, SQ) do { _Pragma("unroll") for (int j = 0; j < 4; ++j) { const u32x4* _p = (const u32x4*)(proj1 + (size_t)(tt) * ODD_IN + 2048 + j * 512) + lane; V[j] = _p[0]; Z[j] = _p[256]; } \
                SQ = (lane < 32) ? SSQ[(size_t)lane * T + (tt)] : 0.f; } while (0)
            if (gw < T) FIN_LOAD(gw, vv, zz, sq);
            for (int t = gw; t < T; t += ngw) {
                if (t + ngw < T) FIN_LOAD(t + ngw, vn_, zn_, sqn);
                float s8 = sq; s8 += __shfl_xor(s8, 1); s8 += __shfl_xor(s8, 2); s8 += __shfl_xor(s8, 4);
#pragma unroll
                for (int j = 0; j < 4; ++j) {
                    const float rstd = rsqrtf(__builtin_bit_cast(float, __builtin_amdgcn_readlane(__builtin_bit_cast(int, s8), 8 * j)) * (1.f / 512.f) + EPS);
                    const u32x4 v = vv[j], z = zz[j]; u32x4 o;
                    o.x = cvt_pk_bf16(lo_bf(v.x) * rstd * silu_f(lo_bf(z.x)), hi_bf(v.x) * rstd * silu_f(hi_bf(z.x))); o.y = cvt_pk_bf16(lo_bf(v.y) * rstd * silu_f(lo_bf(z.y)), hi_bf(v.y) * rstd * silu_f(hi_bf(z.y)));
                    o.z = cvt_pk_bf16(lo_bf(v.z) * rstd * silu_f(lo_bf(z.z)), hi_bf(v.z) * rstd * silu_f(hi_bf(z.z))); o.w = cvt_pk_bf16(lo_bf(v.w) * rstd * silu_f(lo_bf(z.w)), hi_bf(v.w) * rstd * silu_f(hi_bf(z.w)));
                    *((u32x4*)(proj1 + (size_t)t * ODD_IN + 2048 + j * 512) + lane) = o;
                }
#pragma unroll
                for (int j = 0; j < 4; ++j) { vv[j] = vn_[j]; zz[j] = zn_[j]; }
                sq = sqn;
            }
#undef FIN_LOAD
        }
        convert_moe(args, 1, (LAS float*)(lds + wave * 8448), gw, ngw, lane, 1);
    }
    SEAM(13);

    if (RUN(14)) { PHASE_IDS;
        pg8::Gemm g{(const bf16_t*)(ws + WS_PROJ1) + 2048, (const bf16_t*)(ws + WS_WOUT1), ODD_IN, 2048, nullptr};
        pg8::DenseOrder S; S.init(T, D, G, bid, ODD_IN, 2048);
        pg8::EpiResF32 E{args.out, args.out, D, (float*)(ws + WS_SSQ)};
        pg8::gemm_phase(lds, g, S, E);
    }
    SEAM(14);

    if (RUN(15)) { PHASE_IDS; moe_route2(args, 1, lds, bid, G, tid, lane, wave); }
    SEAM(15);
    if (RUN(16)) { PHASE_IDS; moe_scatter(args, 1, lds, bid, G, tid, lane, wave); }
    SEAM(16);
    if (RUN(17)) { PHASE_IDS; moe_gemm1(args, 1, lds, bid, G, tid); }
    __syncthreads();
    if (RUN(18)) { PHASE_IDS; moe_gemm2(args, 1, lds, bid, G, tid); }
    SEAM(18);
    if (RUN(19)) { PHASE_IDS; moe_combine<false>(args, nullptr, nullptr, gw, ngw, lane); }
#undef IN
#undef SEAM
}

extern "C" void kernel_launch(void* const* d_in, const int* in_sizes, int n_in, void* d_out, int out_size, void* d_ws, size_t ws_size, hipStream_t stream) {
    static int grid = 0;
    if (grid == 0) {
        if (n_in != 22 || in_sizes[0] != T * D || out_size != T * D || ws_size < WS_END) { fprintf(stderr, "kernel_launch: unexpected shapes / workspace (n_in %d, ws %zu, need %zu)\n", n_in, ws_size, (size_t)WS_END); grid = -1; return; }
        int dev = 0, cus = 0, per_cu = 0;
        (void)hipGetDevice(&dev); (void)hipDeviceGetAttribute(&cus, hipDeviceAttributeMultiprocessorCount, dev);
        if (hipFuncSetAttribute((const void*)fwd_kernel, hipFuncAttributeMaxDynamicSharedMemorySize, LDS_BYTES) != hipSuccess) { fprintf(stderr, "kernel_launch: hipFuncSetAttribute failed\n"); grid = -1; return; }
        if (hipOccupancyMaxActiveBlocksPerMultiprocessor(&per_cu, (const void*)fwd_kernel, NTHREADS, LDS_BYTES) != hipSuccess || per_cu < 1) { fprintf(stderr, "kernel_launch: occupancy query says %d\n", per_cu); grid = -1; return; }
        (void)hipGetLastError();
        grid = cus;
    }
    if (grid < 0) return;
    (void)hipMemsetAsync((char*)d_ws + WS_CTL, 0, 65536, stream);
    Args a{};
    for (int i = 0; i < 22; ++i) a.in[i] = (const float*)d_in[i];
    a.out = (float*)d_out; a.ws = (unsigned char*)d_ws; a.ph_lo = 0; a.ph_hi = PHHI;
    void* kargs[] = {&a};
    hipError_t e = hipLaunchCooperativeKernel((const void*)fwd_kernel, dim3(grid), dim3(NTHREADS), kargs, LDS_BYTES, stream);
    if (e != hipSuccess) fprintf(stderr, "kernel_launch: cooperative launch failed: %s (grid %d)\n", hipGetErrorString(e), grid);
}
```
